# Optimizing an MI355X kernel written in HIP

```python
import math
import jax, jax.numpy as jnp
from jax import lax
import numpy as np

D_MODEL = 2048
BATCH = 4
SEQ = 4096
DEPTH = 4

CONV_CH = D_MODEL // 2
CONV_K = 3
N_HEADS = 8
HEAD_DIM = 128
ATT_WIDTH = N_HEADS * HEAD_DIM
MOBA_BLOCK = 256
MOBA_TOPK = 3
Q_CHUNK = 32
NUM_BUCKETS = 32
MAX_DISTANCE = 128
D_FF = -(-8 * D_MODEL // (3 * 256)) * 256
EPS = 1e-6
IN_COLS = 3 * CONV_CH + 3 * ATT_WIDTH + 2 * D_MODEL
SPLIT_POINTS = (CONV_CH, 2 * CONV_CH, 3 * CONV_CH,
                3 * CONV_CH + ATT_WIDTH, 3 * CONV_CH + 2 * ATT_WIDTH,
                3 * CONV_CH + 3 * ATT_WIDTH, 3 * CONV_CH + 3 * ATT_WIDTH + D_MODEL)

kernel_name = 'hybrid_shortconv_moba_block'


def rms_norm(x, g):
    xf = x.astype(jnp.float32)
    y = xf * lax.rsqrt(jnp.mean(xf * xf, axis=-1, keepdims=True) + EPS)
    return (y * g.astype(jnp.float32)).astype(x.dtype)


def causal_short_conv(u, w):
    s = u.shape[1]
    up = jnp.pad(u, ((0, 0), (CONV_K - 1, 0), (0, 0)))
    y = w[0] * up[:, 0:s]
    for j in range(1, CONV_K):
        y = y + w[j] * up[:, j:j + s]
    return y


def t5_bucket(dist):
    n = jnp.maximum(dist, 0)
    max_exact = NUM_BUCKETS // 2
    nf = jnp.maximum(n, 1).astype(jnp.float32)
    large = max_exact + (jnp.log(nf / max_exact) / math.log(MAX_DISTANCE / max_exact)
                         * (NUM_BUCKETS - max_exact)).astype(jnp.int32)
    large = jnp.minimum(large, NUM_BUCKETS - 1)
    return jnp.where(n < max_exact, n, large)


def moba_attention(q, k, v, rel_bias):
    b, s, h, dh = q.shape
    nb = max(-(-s // MOBA_BLOCK), MOBA_TOPK)
    sp = nb * MOBA_BLOCK
    q = q.transpose(0, 2, 1, 3)
    k = jnp.pad(k.transpose(0, 2, 1, 3), ((0, 0), (0, 0), (0, sp - s), (0, 0)))
    v = jnp.pad(v.transpose(0, 2, 1, 3), ((0, 0), (0, 0), (0, sp - s), (0, 0)))
    kblk = k.reshape(b, h, nb, MOBA_BLOCK, dh)
    vblk = v.reshape(b, h, nb, MOBA_BLOCK, dh)
    kmean = jnp.mean(kblk.astype(jnp.float32), axis=3)
    table_t = rel_bias.astype(jnp.float32).T
    scale = dh ** -0.5
    b_idx = jnp.arange(b)[:, None, None, None]
    h_idx = jnp.arange(h)[None, :, None, None]
    h_idx5 = jnp.arange(h)[None, :, None, None, None]
    offs = jnp.arange(MOBA_BLOCK)
    blk_ids = jnp.arange(nb)
    sel_slot = jnp.arange(MOBA_TOPK)

    def chunk(c):
        start = c * Q_CHUNK
        blk = start // MOBA_BLOCK
        qc = lax.dynamic_slice_in_dim(q, start, Q_CHUNK, axis=2)
        qpos = start + jnp.arange(Q_CHUNK)
        k_own = lax.dynamic_slice_in_dim(k, blk * MOBA_BLOCK, MOBA_BLOCK, axis=2)
        v_own = lax.dynamic_slice_in_dim(v, blk * MOBA_BLOCK, MOBA_BLOCK, axis=2)
        dist_own = qpos[:, None] - (blk * MOBA_BLOCK + offs)[None, :]
        l_own = (jnp.einsum('bhqd,bhkd->bhqk', qc, k_own, preferred_element_type=jnp.float32) * scale
                 + table_t[:, t5_bucket(dist_own)][None])
        l_own = jnp.where(dist_own >= 0, l_own, -jnp.inf)
        gate = jnp.einsum('bhqd,bhnd->bhqn', qc.astype(jnp.float32), kmean)
        gate = jnp.where(blk_ids < blk, gate, -jnp.inf)
        _, sel = lax.top_k(gate, MOBA_TOPK)
        valid = sel_slot < blk
        k_sel = kblk[b_idx, h_idx, sel]
        v_sel = vblk[b_idx, h_idx, sel]
        dist_sel = qpos[None, None, :, None, None] - (sel[..., None] * MOBA_BLOCK + offs)
        l_sel = (jnp.einsum('bhqd,bhqjkd->bhqjk', qc, k_sel, preferred_element_type=jnp.float32) * scale
                 + table_t[h_idx5, t5_bucket(dist_sel)])
        l_sel = jnp.where(valid[:, None], l_sel, -jnp.inf)
        logits = jnp.concatenate(
            [l_own, l_sel.reshape(b, h, Q_CHUNK, MOBA_TOPK * MOBA_BLOCK)], axis=-1)
        p = jax.nn.softmax(logits, axis=-1).astype(v.dtype)
        p_own = p[..., :MOBA_BLOCK]
        p_sel = p[..., MOBA_BLOCK:].reshape(b, h, Q_CHUNK, MOBA_TOPK, MOBA_BLOCK)
        return (jnp.einsum('bhqk,bhkd->bhqd', p_own, v_own)
                + jnp.einsum('bhqjk,bhqjkd->bhqd', p_sel, v_sel))

    out = lax.map(chunk, jnp.arange(s // Q_CHUNK))
    return out.transpose(1, 0, 3, 2, 4).reshape(b, s, h, dh)


def hybrid_mixer(xn, w_in, conv_w, w_conv_out, w_attn_out, w_mix_out, rel_bias):
    b, s, _ = xn.shape
    proj = xn @ w_in
    h_in, g_b, g_c, q, k, v, gate_conv, gate_att = jnp.split(proj, SPLIT_POINTS, axis=-1)
    y_conv = (g_b * causal_short_conv(g_c * h_in, conv_w)) @ w_conv_out
    att = moba_attention(q.reshape(b, s, N_HEADS, HEAD_DIM),
                         k.reshape(b, s, N_HEADS, HEAD_DIM),
                         v.reshape(b, s, N_HEADS, HEAD_DIM), rel_bias)
    y_att = att.reshape(b, s, ATT_WIDTH) @ w_attn_out
    merged = jax.nn.sigmoid(gate_conv) * y_conv + jax.nn.sigmoid(gate_att) * y_att
    return merged @ w_mix_out


def swiglu(xn, w_gate, w_up, w_down):
    return (jax.nn.silu(xn @ w_gate) * (xn @ w_up)) @ w_down


def setup_inputs(seed: int = 0) -> dict:
    key = jax.random.key(seed)
    ks = jax.random.split(key, 14)

    def normal(k, shape, scale):
        return jax.random.normal(k, shape, jnp.float32) * scale

    return {
        'x': normal(ks[0], (BATCH, SEQ, D_MODEL), 1.0),
        'w_in': normal(ks[1], (DEPTH, D_MODEL, IN_COLS), D_MODEL ** -0.5),
        'conv_w': normal(ks[2], (DEPTH, CONV_K, CONV_CH), CONV_K ** -0.5),
        'w_conv_out': normal(ks[3], (DEPTH, CONV_CH, D_MODEL), CONV_CH ** -0.5),
        'w_attn_out': normal(ks[4], (DEPTH, ATT_WIDTH, D_MODEL), ATT_WIDTH ** -0.5),
        'w_mix_out': normal(ks[5], (DEPTH, D_MODEL, D_MODEL), D_MODEL ** -0.5),
        'rel_bias': normal(ks[6], (NUM_BUCKETS, N_HEADS), 0.5),
        'norm_mix': 1.0 + normal(ks[7], (DEPTH, D_MODEL), 0.02),
        'norm_ffn': 1.0 + normal(ks[8], (DEPTH, D_MODEL), 0.02),
        'w_ffn_gate': normal(ks[9], (DEPTH, D_MODEL, D_FF), D_MODEL ** -0.5),
        'w_ffn_up': normal(ks[10], (DEPTH, D_MODEL, D_FF), D_MODEL ** -0.5),
        'w_ffn_down': normal(ks[11], (DEPTH, D_FF, D_MODEL), D_FF ** -0.5),
        'norm_final': 1.0 + normal(ks[12], (D_MODEL,), 0.02),
    }


def reference(x, w_in, conv_w, w_conv_out, w_attn_out, w_mix_out, rel_bias,
              norm_mix, norm_ffn, w_ffn_gate, w_ffn_up, w_ffn_down, norm_final):
    for l in range(DEPTH):
        x = x + hybrid_mixer(rms_norm(x, norm_mix[l]), w_in[l], conv_w[l],
                             w_conv_out[l], w_attn_out[l], w_mix_out[l], rel_bias)
        x = x + swiglu(rms_norm(x, norm_ffn[l]), w_ffn_gate[l], w_ffn_up[l], w_ffn_down[l])
    return rms_norm(x, norm_final)
```

```cpp
#include <hip/hip_runtime.h>
#include <cstdio>
#include <cstdint>

#ifndef REP_ATT
#define REP_ATT 1
#endif
#ifndef REP_BIG
#define REP_BIG 1
#endif
#ifndef REP_IN
#define REP_IN 1
#endif
#ifndef REP_GU
#define REP_GU 1
#endif
#ifndef REP_EF
#define REP_EF 1
#endif
#ifndef REP_G
#define REP_G 1
#endif
#ifndef REP_J
#define REP_J 1
#endif
#ifndef SPLIT_IN
#define SPLIT_IN 0
#endif
#ifndef REP_MISC
#define REP_MISC 1
#endif
constexpr int BATCH = 4, SEQ = 4096, DM = 2048, DEPTH = 4, CCH = 1024, AW = 1024, NH = 8, HD = 128, FF = 5632, INC = 10240;
constexpr int M = BATCH * SEQ;
constexpr int C_H = 0, C_B = 1024, C_C = 2048, C_Q = 3072, C_K = 4096, C_V = 5120, C_GC = 6144, C_GA = 8192;
constexpr float RMS_EPS = 1e-6f;
constexpr int NWAVES = 8;

#define GAS __attribute__((address_space(1)))
#define LAS __attribute__((address_space(3)))
typedef unsigned short bf16;
typedef unsigned v4u __attribute__((ext_vector_type(4)));
typedef float f32x4 __attribute__((ext_vector_type(4)));
typedef float f32x2 __attribute__((ext_vector_type(2)));
typedef float f32x16 __attribute__((ext_vector_type(16)));
typedef short bf16x8 __attribute__((ext_vector_type(8)));
typedef short s16x4 __attribute__((ext_vector_type(4)));
typedef unsigned u32x4 __attribute__((ext_vector_type(4)));
typedef unsigned u32x2 __attribute__((ext_vector_type(2)));
typedef GAS unsigned gu32;
#define RLX_AGENT __ATOMIC_RELAXED, __HIP_MEMORY_SCOPE_AGENT
#define LDS_WAIT() asm volatile("s_waitcnt lgkmcnt(0)" ::: "memory")
#define VM_WAIT() asm volatile("s_waitcnt vmcnt(0)" ::: "memory")

__device__ __forceinline__ int fresh_tid() { int t = threadIdx.x; asm volatile("" : "+v"(t)); return t; }
__device__ __forceinline__ int fresh_bid() { int b = blockIdx.x; asm volatile("" : "+s"(b)); return b; }
__device__ __forceinline__ unsigned cvt_pk_bf16(float lo, float hi) { unsigned r; asm volatile("v_cvt_pk_bf16_f32 %0, %1, %2" : "=v"(r) : "v"(lo), "v"(hi)); return r; }
__device__ __forceinline__ float bf_lo(unsigned w) { return __uint_as_float(w << 16); }
__device__ __forceinline__ float bf_hi(unsigned w) { return __uint_as_float(w & 0xffff0000u); }
__device__ __forceinline__ unsigned q8(float s) { return (unsigned)(s * 255.0f + 0.5f); }
__device__ __forceinline__ unsigned pack4(unsigned a, unsigned b, unsigned c, unsigned d) { return a | (b << 8) | (c << 16) | (d << 24); }
__device__ __forceinline__ float ub0(unsigned w) { return (float)(w & 0xffu); }
__device__ __forceinline__ float ub1(unsigned w) { return (float)((w >> 8) & 0xffu); }
__device__ __forceinline__ float ub2(unsigned w) { return (float)((w >> 16) & 0xffu); }
__device__ __forceinline__ float ub3(unsigned w) { return (float)(w >> 24); }
__device__ __forceinline__ float fast_sigmoid(float x) { return __builtin_amdgcn_rcpf(1.0f + __builtin_amdgcn_exp2f(-1.4426950408889634f * x)); }

constexpr int LDS_RB_OFF = 132096, LDS_RB_BYTES = 8192;
constexpr int LDS_XT_OFF = LDS_RB_OFF + 2 * LDS_RB_BYTES;
constexpr int LDS_TOTAL = 163840;
static_assert(LDS_XT_OFF + 4096 <= LDS_TOTAL, "LDS map");
namespace pg8 {
constexpr int BM = 256, BK = 64, HALF = 128, HTB = HALF * BK * 2  , STAGE_BYTES = 8 * HTB, NXCD = 8, WGM = 8;

__host__ __device__ __forceinline__ int lds_byte(int r, int c) { const int st = (r >> 4) * 2 + (c >> 5), rr = r & 15, cc = c & 31, ob = rr * 64 + cc * 2; return st * 1024 + (ob ^ (((ob >> 9) & 1) << 5)); }
__host__ __device__ __forceinline__ void stage_rc(int b, int& R, int& C) { const int st = b / 1024, sb = b % 1024, swz = sb ^ (((sb >> 9) & 1) << 5); R = (st >> 1) * 16 + swz / 64; C = (st & 1) * 32 + (swz % 64) / 2; }
__host__ __device__ __forceinline__ int perm32(int rho) { const int n = rho >> 4, i = rho & 15; return 8 * (i >> 2) + 4 * n + (i & 3); }

struct Unit { int pm, pn; };
struct Gemm { const bf16* A; const bf16* Bt; int M, N, K, lda, ldb; int kstepA = 0; long tstepA = 0; bool snake = false; bool splitA = false; };

struct StaticOrder {
    int nM, nN, nwg, G, c;
    __host__ __device__ void init(int M_, int N_, int G_, int c_) { nM = M_ / BM; nN = N_ / BM; nwg = nM * nN; G = G_; c = c_; }
    __host__ __device__ bool next(int i, Unit& u) const {
        const long L = (long)i * G + c; if (L >= nwg) return false;
        int wgid = (int)L; { const int q = nwg / NXCD, r = nwg % NXCD, xcd = wgid % NXCD, off = wgid / NXCD; wgid = (xcd < r ? xcd * (q + 1) : r * (q + 1) + (xcd - r) * q) + off; }
        const int nig = WGM * nN, gid = wgid / nig, fm = gid * WGM, gsz = (nM - fm) < WGM ? (nM - fm) : WGM;
        u.pm = fm + ((wgid % nig) % gsz); u.pn = (wgid % nig) / gsz; return true;
    }
};

struct WrapOrder : StaticOrder { int wrapN; int i0 = 0, i1 = 1 << 30;
    __host__ __device__ bool next(int i, Unit& u) const { if (i + i0 >= i1) return false; if (!StaticOrder::next(i + i0, u)) return false; u.pn %= wrapN; return true; } };

__device__ __forceinline__ void rs_prefetch(LAS unsigned char* lds, const float* SS8, const Unit& u, int ui, int wid, int lane) {
    const float* src = SS8 + ((size_t)u.pm * BM + 32 * wid) * 8 + lane * 4;
    __builtin_amdgcn_global_load_lds((const unsigned*)src, (LAS unsigned*)(lds + LDS_RB_OFF + (ui & 1) * LDS_RB_BYTES + wid * 1024), 16, 0, 0);
}
__device__ __forceinline__ void row_scales(LAS unsigned char* lds, int ui, int wr, int fr, float (&rs)[2][4]) {
    const LAS f32x4* rb = (const LAS f32x4*)(lds + LDS_RB_OFF + (ui & 1) * LDS_RB_BYTES);
#pragma unroll
    for (int ai = 0; ai < 2; ++ai)
#pragma unroll
        for (int m = 0; m < 4; ++m) { const int r = ai * HALF + wr * 64 + m * 16 + fr; const f32x4 x = rb[2 * r], y = rb[2 * r + 1];
            const float s = ((x[0] + x[1]) + (x[2] + x[3])) + ((y[0] + y[1]) + (y[2] + y[3]));
            rs[ai][m] = __builtin_amdgcn_rsqf(s * (1.0f / DM) + RMS_EPS); }
}
__device__ __forceinline__ float row_scale1(LAS unsigned char* lds, int ui, int r) {
    const LAS f32x4* rb = (const LAS f32x4*)(lds + LDS_RB_OFF + (ui & 1) * LDS_RB_BYTES);
    const f32x4 x = rb[2 * r], y = rb[2 * r + 1];
    return __builtin_amdgcn_rsqf((((x[0] + x[1]) + (x[2] + x[3])) + ((y[0] + y[1]) + (y[2] + y[3]))) * (1.0f / DM) + RMS_EPS);
}
struct RsPipe { f32x4 x, y;
    __device__ __forceinline__ void load(LAS unsigned char* lds, int ui, int r) { const LAS f32x4* rb = (const LAS f32x4*)(lds + LDS_RB_OFF + (ui & 1) * LDS_RB_BYTES); x = rb[2 * r]; y = rb[2 * r + 1]; }
    __device__ __forceinline__ float msq() const { return (((x[0] + x[1]) + (x[2] + x[3])) + ((y[0] + y[1]) + (y[2] + y[3]))) * (1.0f / DM) + RMS_EPS; }
};
#define RS_PIPE_BEGIN() RsPipe rs_nxt; rs_nxt.load(lds, ui, rl0)
#define RS_PIPE_STEP(cur_) const RsPipe cur_ = rs_nxt; { const int gn_ = ai * 4 + m + 1; if (gn_ < 8) rs_nxt.load(lds, ui, rl0 + (gn_ >> 2) * HALF + (gn_ & 3) * 16); } __builtin_amdgcn_sched_barrier(0)
struct EpiProj {
    static constexpr bool PERM = true, PREFETCH = true;
    bf16* O; int ldc; int sig_from; const float* SS; float* KP;
    __device__ __forceinline__ void prefetch(LAS unsigned char* lds, const Unit& u, int ui, int wid, int lane) const { rs_prefetch(lds, SS, u, ui, wid, lane); }
    __device__ __forceinline__ void operator()(const f32x4 (&acc)[2][2][4][2], const Unit& u, int wr, int wc, int fr, int fq, LAS unsigned char* lds, int ui) const {
        int row0 = u.pm * BM + wr * 64 + fr; const int colt = u.pn * BM;
        const bool sig = colt >= sig_from; const bool isk = colt >= C_K && colt < C_V; const bool isch = colt < C_B || (colt >= C_C && colt < C_Q);
        int col0 = colt + wc * 32 + 8 * fq;
        asm volatile("" : "+v"(row0), "+v"(col0));
        const int rl0 = wr * 64 + fr;
        RS_PIPE_BEGIN();
        if (sig) {
            const int gc0 = ((colt - sig_from) >> 1) + wc * 32 + 8 * fq;
#pragma unroll
            for (int ai = 0; ai < 2; ++ai)
#pragma unroll
                for (int m = 0; m < 4; ++m) { RS_PIPE_STEP(rsc); bf16* rowp = O + (size_t)(row0 + ai * HALF + m * 16) * ldc + gc0; const float k1 = -1.4426950408889634f * __builtin_amdgcn_rsqf(rsc.msq());
                    unsigned qc[8], qa[8];
#define SG8(A_) ((unsigned)(__builtin_amdgcn_rcpf(__builtin_fmaf(__builtin_amdgcn_exp2f((A_) * k1), 1.0f / 255.0f, 1.0f / 255.0f)) + 0.5f))
#pragma unroll
                    for (int e = 0; e < 4; ++e) { qc[e] = SG8(acc[ai][0][m][0][e]); qc[4 + e] = SG8(acc[ai][0][m][1][e]);
                        const unsigned a0 = SG8(acc[ai][1][m][0][e]), a1 = SG8(acc[ai][1][m][1][e]);
                        qa[e] = a0 < 1u ? 1u : a0; qa[4 + e] = a1 < 1u ? 1u : a1; }
                    u32x4 w; w.x = pack4(qc[0], qc[1], qc[2], qc[3]); w.y = pack4(qc[4], qc[5], qc[6], qc[7]); w.z = pack4(qa[0], qa[1], qa[2], qa[3]); w.w = pack4(qa[4], qa[5], qa[6], qa[7]);
                    *(u32x4*)(rowp + C_GC) = w; }
#undef SG8
            return;
        }
        if (isch) {
            const int pk = u.pn < 4 ? u.pn : u.pn - 4, cc0 = 128 * pk + wc * 32 + 8 * fq;
#pragma unroll
            for (int ai = 0; ai < 2; ++ai)
#pragma unroll
                for (int m = 0; m < 4; ++m) { RS_PIPE_STEP(rsc); const float r2 = __builtin_amdgcn_rcpf(rsc.msq());
                    const f32x4 p0 = acc[ai][0][m][0] * acc[ai][1][m][0] * r2, p1 = acc[ai][0][m][1] * acc[ai][1][m][1] * r2;
                    u32x4 w; w.x = cvt_pk_bf16(p0[0], p0[1]); w.y = cvt_pk_bf16(p0[2], p0[3]); w.z = cvt_pk_bf16(p1[0], p1[1]); w.w = cvt_pk_bf16(p1[2], p1[3]);
                    *(u32x4*)(O + (size_t)(row0 + ai * HALF + m * 16) * ldc + C_H + cc0) = w; }
            return;
        }
#pragma unroll
        for (int ai = 0; ai < 2; ++ai)
#pragma unroll
            for (int m = 0; m < 4; ++m) { RS_PIPE_STEP(rsc); bf16* rowp = O + (size_t)(row0 + ai * HALF + m * 16) * ldc + col0; const float rsv = __builtin_amdgcn_rsqf(rsc.msq());
#pragma unroll
                for (int bj = 0; bj < 2; ++bj) { f32x4 v0 = acc[ai][bj][m][0] * rsv, v1 = acc[ai][bj][m][1] * rsv;
                    u32x4 w; w.x = cvt_pk_bf16(v0[0], v0[1]); w.y = cvt_pk_bf16(v0[2], v0[3]); w.z = cvt_pk_bf16(v1[0], v1[1]); w.w = cvt_pk_bf16(v1[2], v1[3]);
                    *(u32x4*)(rowp + bj * HALF) = w; }
                __builtin_amdgcn_sched_barrier(0); }
        if (isk) {
            f32x4 cs[2][2];
#pragma unroll
            for (int bj = 0; bj < 2; ++bj)
#pragma unroll
                for (int n = 0; n < 2; ++n) { f32x4 t = (f32x4){0.f, 0.f, 0.f, 0.f};
#pragma unroll
                    for (int ai = 0; ai < 2; ++ai)
#pragma unroll
                        for (int m = 0; m < 4; ++m) t += acc[ai][bj][m][n] * row_scale1(lds, ui, rl0 + ai * HALF + m * 16);
                    cs[bj][n] = t; }
#pragma unroll
            for (int bj = 0; bj < 2; ++bj)
#pragma unroll
                for (int n = 0; n < 2; ++n)
#pragma unroll
                    for (int e = 0; e < 4; ++e) { float x = cs[bj][n][e]; x += __shfl_xor(x, 1); x += __shfl_xor(x, 2); x += __shfl_xor(x, 4); x += __shfl_xor(x, 8); cs[bj][n][e] = x; }
            if (fr == 0) { float* kp = KP + (size_t)(u.pm * 2 + wr) * 1024 + (colt - C_K) + wc * 32 + 8 * fq;
#pragma unroll
                for (int bj = 0; bj < 2; ++bj) { *(f32x4*)(kp + bj * HALF) = cs[bj][0]; *(f32x4*)(kp + bj * HALF + 4) = cs[bj][1]; } }
        }
    }
};
struct MidGateRatio {
    static constexpr bool ENABLED = true;
    const bf16* R; int ldg;
    __device__ __forceinline__ void operator()(f32x4 (&acc)[2][2][4][2], const Unit& u, int wr, int wc, int fr, int fq) const {
        int row0 = u.pm * BM + wr * 64 + fr; int col0 = u.pn * BM + wc * 32 + 8 * fq;
        asm volatile("" : "+v"(row0), "+v"(col0));
        const char* base = (const char*)R + ((size_t)row0 * ldg + col0) * 2;
        const size_t rstep = (size_t)ldg * 32;
        u32x4 rr[2][4][2];
#pragma unroll
        for (int ai = 0; ai < 2; ++ai)
#pragma unroll
            for (int m = 0; m < 4; ++m) { const char* p = base + (size_t)(ai * 8 + m) * rstep;
#pragma unroll
                for (int bj = 0; bj < 2; ++bj) rr[ai][m][bj] = *(const u32x4*)(p + bj * 256); }
        __builtin_amdgcn_sched_barrier(0);
#pragma unroll
        for (int ai = 0; ai < 2; ++ai)
#pragma unroll
            for (int m = 0; m < 4; ++m)
#pragma unroll
                for (int bj = 0; bj < 2; ++bj) { const u32x4 c = rr[ai][m][bj];
                    acc[ai][bj][m][0] *= (f32x4){ub0(c.x) * __builtin_amdgcn_rcpf(ub0(c.z)), ub1(c.x) * __builtin_amdgcn_rcpf(ub1(c.z)), ub2(c.x) * __builtin_amdgcn_rcpf(ub2(c.z)), ub3(c.x) * __builtin_amdgcn_rcpf(ub3(c.z))};
                    acc[ai][bj][m][1] *= (f32x4){ub0(c.y) * __builtin_amdgcn_rcpf(ub0(c.w)), ub1(c.y) * __builtin_amdgcn_rcpf(ub1(c.w)), ub2(c.y) * __builtin_amdgcn_rcpf(ub2(c.w)), ub3(c.y) * __builtin_amdgcn_rcpf(ub3(c.w))}; }
        __builtin_amdgcn_sched_barrier(0);
    }
};
struct EpiGateBf16 {
    static constexpr bool PERM = true, PREFETCH = false;
    bf16* O; int ldc; const bf16* G; int ldg;
    __device__ __forceinline__ void operator()(const f32x4 (&acc)[2][2][4][2], const Unit& u, int wr, int wc, int fr, int fq, LAS unsigned char* lds, int ui) const {
        const int row0 = u.pm * BM + wr * 64 + fr; const int col0 = u.pn * BM + wc * 32 + 8 * fq;
        u32x2 gg[2][4][2];
#pragma unroll
        for (int ai = 0; ai < 2; ++ai)
#pragma unroll
            for (int m = 0; m < 4; ++m)
#pragma unroll
                for (int bj = 0; bj < 2; ++bj) gg[ai][m][bj] = *(const u32x2*)((const char*)(G + (size_t)(row0 + ai * HALF + m * 16) * ldg + col0 + bj * HALF) + 8);
        __builtin_amdgcn_sched_barrier(0);
        const float k = 1.0f / 255.0f;
#pragma unroll
        for (int ai = 0; ai < 2; ++ai)
#pragma unroll
            for (int m = 0; m < 4; ++m) { const size_t r = (size_t)(row0 + ai * HALF + m * 16);
#pragma unroll
                for (int bj = 0; bj < 2; ++bj) { const u32x2 g = gg[ai][m][bj];
                    f32x4 v0 = acc[ai][bj][m][0] * k, v1 = acc[ai][bj][m][1] * k;
                    v0[0] *= ub0(g.x); v0[1] *= ub1(g.x); v0[2] *= ub2(g.x); v0[3] *= ub3(g.x);
                    v1[0] *= ub0(g.y); v1[1] *= ub1(g.y); v1[2] *= ub2(g.y); v1[3] *= ub3(g.y);
                    u32x4 w; w.x = cvt_pk_bf16(v0[0], v0[1]); w.y = cvt_pk_bf16(v0[2], v0[3]); w.z = cvt_pk_bf16(v1[0], v1[1]); w.w = cvt_pk_bf16(v1[2], v1[3]);
                    *(u32x4*)(O + r * ldc + col0 + bj * HALF) = w; } }
    }
};
struct EpiResBf16 {
    static constexpr bool PERM = true, PREFETCH = false;
    const bf16* X; bf16* XO; int ldc; float* SS;
    __device__ __forceinline__ void operator()(const f32x4 (&acc)[2][2][4][2], const Unit& u, int wr, int wc, int fr, int fq, LAS unsigned char* lds, int ui) const {
        const int row0 = u.pm * BM + wr * 64 + fr; const int col0 = u.pn * BM + wc * 32 + 8 * fq;
        LAS float* XT = (LAS float*)(lds + LDS_XT_OFF);
        u32x4 xx[2][4][2];
#pragma unroll
        for (int ai = 0; ai < 2; ++ai)
#pragma unroll
            for (int m = 0; m < 4; ++m)
#pragma unroll
                for (int bj = 0; bj < 2; ++bj) xx[ai][m][bj] = *(const u32x4*)(X + (size_t)(row0 + ai * HALF + m * 16) * ldc + col0 + bj * HALF);
        __builtin_amdgcn_sched_barrier(0);
#pragma unroll
        for (int ai = 0; ai < 2; ++ai)
#pragma unroll
            for (int m = 0; m < 4; ++m) { const size_t r = (size_t)(row0 + ai * HALF + m * 16); float ss = 0.f;
#pragma unroll
                for (int bj = 0; bj < 2; ++bj) { bf16* xp = XO + r * ldc + col0 + bj * HALF; const u32x4 xo = xx[ai][m][bj];
                    f32x4 v0 = acc[ai][bj][m][0], v1 = acc[ai][bj][m][1];
                    v0[0] += bf_lo(xo.x); v0[1] += bf_hi(xo.x); v0[2] += bf_lo(xo.y); v0[3] += bf_hi(xo.y);
                    v1[0] += bf_lo(xo.z); v1[1] += bf_hi(xo.z); v1[2] += bf_lo(xo.w); v1[3] += bf_hi(xo.w);
                    ss += ((v0[0] * v0[0] + v0[1] * v0[1]) + (v0[2] * v0[2] + v0[3] * v0[3])) + ((v1[0] * v1[0] + v1[1] * v1[1]) + (v1[2] * v1[2] + v1[3] * v1[3]));
                    u32x4 w; w.x = cvt_pk_bf16(v0[0], v0[1]); w.y = cvt_pk_bf16(v0[2], v0[3]); w.z = cvt_pk_bf16(v1[0], v1[1]); w.w = cvt_pk_bf16(v1[2], v1[3]);
                    *(u32x4*)xp = w; }
                ss += __shfl_xor(ss, 16); ss += __shfl_xor(ss, 32);
                if (fq == 0) XT[(ai * HALF + wr * 64 + m * 16 + fr) * 4 + wc] = ss; }
        asm volatile("s_waitcnt lgkmcnt(0)" ::: "memory"); __builtin_amdgcn_s_barrier(); asm volatile("" ::: "memory");
        const int t = fresh_tid();
        if (t < 256) { const f32x4 p = *(const LAS f32x4*)(XT + t * 4); SS[((size_t)u.pm * BM + t) * 8 + u.pn] = (p[0] + p[1]) + (p[2] + p[3]); }
        asm volatile("s_waitcnt lgkmcnt(0)" ::: "memory");
    }
};
struct EpiSwiGLU {
    static constexpr bool PERM = true, PREFETCH = true;
    bf16* O; long pstep; const float* SS;
    __device__ __forceinline__ void prefetch(LAS unsigned char* lds, const Unit& u, int ui, int wid, int lane) const { rs_prefetch(lds, SS, u, ui, wid, lane); }
    __device__ __forceinline__ void operator()(const f32x4 (&acc)[2][2][4][2], const Unit& u, int wr, int wc, int fr, int fq, LAS unsigned char* lds, int ui) const {
        bf16* tbase = O + (size_t)u.pm * pstep + ((size_t)(u.pn * 4 + wc) * BM + wr * 64 + fr) * 32 + 8 * fq;
        const int rl0 = wr * 64 + fr;
        RS_PIPE_BEGIN();
#pragma unroll
        for (int ai = 0; ai < 2; ++ai)
#pragma unroll
            for (int m = 0; m < 4; ++m) { RS_PIPE_STEP(rsc); bf16* rowp = tbase + (ai * HALF + m * 16) * 32;
                const float irs2 = rsc.msq();
                const float k1 = -1.4426950408889634f * __builtin_amdgcn_rsqf(irs2);
                f32x4 v0, v1;
#pragma unroll
                for (int e = 0; e < 4; ++e) { const float a0 = acc[ai][0][m][0][e], a1 = acc[ai][0][m][1][e];
                    const float d0 = __builtin_fmaf(__builtin_amdgcn_exp2f(a0 * k1), irs2, irs2), d1 = __builtin_fmaf(__builtin_amdgcn_exp2f(a1 * k1), irs2, irs2);
                    v0[e] = (a0 * acc[ai][1][m][0][e]) * __builtin_amdgcn_rcpf(d0); v1[e] = (a1 * acc[ai][1][m][1][e]) * __builtin_amdgcn_rcpf(d1); }
                u32x4 w; w.x = cvt_pk_bf16(v0[0], v0[1]); w.y = cvt_pk_bf16(v0[2], v0[3]); w.z = cvt_pk_bf16(v1[0], v1[1]); w.w = cvt_pk_bf16(v1[2], v1[3]);
                *(u32x4*)rowp = w; }
    }
};

struct NoMid { static constexpr bool ENABLED = false; __device__ __forceinline__ void operator()(f32x4 (&)[2][2][4][2], const Unit&, int, int, int, int) const {} };
template <class Epi, class Sched, bool ALIGN_EPI, class Mid = NoMid>
__device__ __forceinline__ void gemm_phase(LAS unsigned char* lds, const Gemm g, const Sched& S, const Epi& E, const Mid& MH = Mid()) {
    int tid = fresh_tid(); const int wid = __builtin_amdgcn_readfirstlane(tid >> 6); int lane = tid & 63; const int wr = wid >> 2, wc = wid & 3; int fr = lane & 15, fq = lane >> 4;
    const int K = g.K, nt = K / BK;
    unsigned voffA[2], voffB[2]; int aoff, boff;
#define PG8_LANE_CONSTS() do { _Pragma("unroll") for (int i_ = 0; i_ < 2; ++i_) { int R_, C_; stage_rc(tid * 16 + i_ * 8192, R_, C_); const int Rb_ = Epi::PERM ? ((R_ & ~31) + perm32(R_ & 31)) : R_; \
        voffA[i_] = g.splitA ? (unsigned)((C_ >> 5) * 256 * 32 + R_ * 32 + (C_ & 31)) * 2u : (unsigned)(R_ * g.lda + C_) * 2u; voffB[i_] = (unsigned)(Rb_ * g.ldb + C_) * 2u; } \
        aoff = lds_byte(wr * 64 + fr, fq * 8); boff = lds_byte(wc * 32 + fr, fq * 8); } while (0)
    PG8_LANE_CONSTS();
    const size_t kstep = (size_t)(BK * 2);
    const size_t kstepA = g.kstepA ? (size_t)g.kstepA : kstep;
    const size_t hstepA = g.splitA ? (size_t)HALF * 32 * 2 : (size_t)HALF * g.lda * 2, hstepB = (size_t)HALF * g.ldb * 2;
    const size_t tstepA = g.tstepA ? (size_t)g.tstepA : 2 * hstepA, tstepB = 2 * hstepB;
    const unsigned ldsw = (unsigned)wid * 1024u;
#define PG8_SA(b, h) (((b) * 2 + (h)) * HTB)
#define PG8_SB(b, h) ((4 + (b) * 2 + (h)) * HTB)
#define PG8_STAGE(bufoff, gbase, voff) do { _Pragma("unroll") for (int _i = 0; _i < 2; ++_i) \
        __builtin_amdgcn_global_load_lds((const unsigned*)((const char*)(gbase) + (voff)[_i]), (LAS unsigned*)(lds + (bufoff) + ldsw + _i * 8192), 16, 0, 0); } while (0)
#define PG8_LDA(dst, b, h) do { _Pragma("unroll") for (int m = 0; m < 4; ++m) _Pragma("unroll") for (int k = 0; k < 2; ++k) dst[m][k] = *(const LAS bf16x8*)(lds + PG8_SA(b, h) + aoff + m * 2048 + k * 1024); } while (0)
#define PG8_LDB(dst, b, h) do { _Pragma("unroll") for (int n = 0; n < 2; ++n) _Pragma("unroll") for (int k = 0; k < 2; ++k) dst[n][k] = *(const LAS bf16x8*)(lds + PG8_SB(b, h) + boff + n * 2048 + k * 1024); } while (0)
#define PG8_MMA(ai, bj, At, Bt) do { __builtin_amdgcn_s_setprio(1); _Pragma("unroll") for (int m = 0; m < 4; ++m) _Pragma("unroll") for (int n = 0; n < 2; ++n) _Pragma("unroll") for (int k = 0; k < 2; ++k) \
        acc[ai][bj][m][n] = __builtin_amdgcn_mfma_f32_16x16x32_bf16(Bt[n][k], At[m][k], acc[ai][bj][m][n], 0, 0, 0); __builtin_amdgcn_s_setprio(0); } while (0)
#define PG8_WAIT_V(n) asm volatile("s_waitcnt vmcnt(" #n ")" ::: "memory")
#define PG8_WAIT_L(n) asm volatile("s_waitcnt lgkmcnt(" #n ")" ::: "memory")
#define PG8_BAR __builtin_amdgcn_s_barrier()
#define PG8_SCHED __builtin_amdgcn_sched_barrier(0)
    Unit cur, nxt; int ui = 0;
    if (!S.next(0, cur)) return;
    const bool snake = g.snake;
    const size_t spanA = (size_t)(nt - 1) * kstepA, spanB = (size_t)(nt - 1) * kstep;
    long sA = snake ? -(long)kstepA : (long)kstepA, sB = snake ? -(long)kstep : (long)kstep;
    f32x4 acc[2][2][4][2];
#pragma unroll
    for (int a = 0; a < 2; ++a)
#pragma unroll
        for (int b = 0; b < 2; ++b)
#pragma unroll
            for (int m = 0; m < 4; ++m)
#pragma unroll
                for (int n = 0; n < 2; ++n) acc[a][b][m][n] = (f32x4){0.f, 0.f, 0.f, 0.f};
    bf16x8 At[4][2], B0[2][2], B1[2][2];
    const char* cA = (const char*)g.A + (size_t)cur.pm * tstepA + (snake ? spanA : 0); const char* cB = (const char*)g.Bt + (size_t)cur.pn * tstepB + (snake ? spanB : 0);
    if constexpr (Epi::PREFETCH) E.prefetch(lds, cur, 0, wid, lane);
    PG8_STAGE(PG8_SB(0, 0), cB, voffB); PG8_STAGE(PG8_SB(0, 1), cB + hstepB, voffB); PG8_STAGE(PG8_SA(0, 0), cA, voffA); PG8_STAGE(PG8_SA(0, 1), cA + hstepA, voffA);
    if (wr == 1) PG8_BAR;
    PG8_WAIT_V(2); PG8_BAR;
    PG8_STAGE(PG8_SB(1, 0), cB + sB, voffB); PG8_STAGE(PG8_SA(1, 0), cA + sA, voffA); PG8_STAGE(PG8_SB(1, 1), cB + hstepB + sB, voffB);
    PG8_WAIT_V(6); PG8_BAR;
    for (;;) {
        if (ui > 0) { tid = fresh_tid(); lane = tid & 63; fr = lane & 15; fq = lane >> 4; PG8_LANE_CONSTS(); }
        const bool has_next = S.next(ui + 1, nxt);
        const long nsA = has_next ? (snake ? -sA : sA) : 0, nsB = has_next ? (snake ? -sB : sB) : 0;
        const char* nA = has_next ? (const char*)g.A + (size_t)nxt.pm * tstepA + (nsA < 0 ? spanA : 0) : cA; const char* nB = has_next ? (const char*)g.Bt + (size_t)nxt.pn * tstepB + (nsB < 0 ? spanB : 0) : cB;
        for (int t = 0; t < nt; t += 2) {
            if constexpr (Mid::ENABLED) { if (t == (nt >> 1)) MH(acc, cur, wr, wc, fr, fq); }
            const bool last = (t == nt - 2);
            const char* a1 = cA + (long)(t + 1) * sA;
            const char* a2 = last ? nA : cA + (long)(t + 2) * sA; const char* b2 = last ? nB : cB + (long)(t + 2) * sB;
            const char* a3 = a2 + (last ? nsA : sA); const char* b3 = b2 + (last ? nsB : sB);
            PG8_LDB(B0, 0, 0); PG8_LDB(B1, 0, 1); PG8_SCHED; PG8_LDA(At, 0, 0); PG8_STAGE(PG8_SA(1, 1), a1 + hstepA, voffA);
            PG8_WAIT_V(8); PG8_WAIT_L(0); PG8_BAR; PG8_MMA(0, 0, At, B0); PG8_MMA(0, 1, At, B1); PG8_BAR; PG8_SCHED;
            PG8_LDA(At, 0, 1); PG8_STAGE(PG8_SB(0, 0), b2, voffB); PG8_STAGE(PG8_SB(0, 1), b2 + hstepB, voffB); PG8_STAGE(PG8_SA(0, 0), a2, voffA);
            PG8_WAIT_V(8); PG8_WAIT_L(0); PG8_BAR; PG8_MMA(1, 0, At, B0); PG8_MMA(1, 1, At, B1); PG8_BAR; PG8_SCHED;
            PG8_LDB(B0, 1, 0); PG8_LDB(B1, 1, 1); PG8_SCHED; PG8_LDA(At, 1, 0); PG8_STAGE(PG8_SA(0, 1), a2 + hstepA, voffA);
            PG8_WAIT_V(8); PG8_WAIT_L(0); PG8_BAR; PG8_MMA(0, 0, At, B0); PG8_MMA(0, 1, At, B1); PG8_BAR; PG8_SCHED;
            PG8_LDA(At, 1, 1); PG8_STAGE(PG8_SB(1, 0), b3, voffB); PG8_STAGE(PG8_SB(1, 1), b3 + hstepB, voffB); PG8_STAGE(PG8_SA(1, 0), a3, voffA);
            PG8_WAIT_V(8); PG8_WAIT_L(0); PG8_BAR; PG8_MMA(1, 0, At, B0); PG8_MMA(1, 1, At, B1); PG8_BAR; PG8_SCHED;
        }
        if constexpr (ALIGN_EPI) { if (wr == 0) PG8_BAR; }
        E(acc, cur, wr, wc, fr, fq, lds, ui);
        if (!has_next) break;
#pragma unroll
        for (int a = 0; a < 2; ++a)
#pragma unroll
            for (int b = 0; b < 2; ++b)
#pragma unroll
                for (int m = 0; m < 4; ++m)
#pragma unroll
                    for (int n = 0; n < 2; ++n) acc[a][b][m][n] = (f32x4){0.f, 0.f, 0.f, 0.f};
        cur = nxt; cA = nA; cB = nB; sA = nsA; sB = nsB; ++ui;
        if constexpr (Epi::PREFETCH) E.prefetch(lds, cur, ui, wid, lane);
        if constexpr (ALIGN_EPI) { if (wr == 1) PG8_BAR; }
    }
    PG8_WAIT_V(0);
    if constexpr (!ALIGN_EPI) { if (wr == 0) PG8_BAR; }
    PG8_BAR;
#undef PG8_LANE_CONSTS
#undef PG8_SA
#undef PG8_SB
#undef PG8_STAGE
#undef PG8_LDA
#undef PG8_LDB
#undef PG8_MMA
#undef PG8_WAIT_V
#undef PG8_WAIT_L
#undef PG8_BAR
#undef PG8_SCHED
}
}

namespace att {
constexpr int D = 128, NW = 8, QBLK = 32, KVBLK = 64, QB = NW * QBLK;
constexpr int PQ = INC;
constexpr int PO = 2048;
constexpr int SHM_V = KVBLK * D * 2, SHM_K = KVBLK * D * 2;
constexpr int LDS_WS = 2 * SHM_V + 2 * SHM_K;
constexpr int LDS_KM = LDS_WS + NW * 64 * 4;
constexpr int LDS_LUT = LDS_KM + 16 * 128 * 4;
constexpr int LDS_BYTES = LDS_LUT + 128 * 4;
constexpr float SCALE = 0.08838834764831845f;
constexpr float THR = 8.f;

#define KSWZ(row, colB) ((row) * 256 + ((colB) ^ (((row) & 15) << 4)))
#define SBAR() __builtin_amdgcn_sched_barrier(0)
__device__ __forceinline__ int v_st(int k, int c) { const int kk = (k & ~0xC) | ((k & 4) << 1) | ((k & 8) >> 1); return ((kk >> 3) * 4 + (c >> 5)) * 512 + ((kk & 7) * 32 + (c & 31)) * 2; }
__device__ __forceinline__ int v_rd_base(int lane) { return ((lane & 3) << 3) | (((lane >> 2) & 3) << 6) | (((lane >> 4) & 1) << 5) | (((lane >> 5) & 1) << 8); }
constexpr int v_rd_off(int d0, int ks, int half) { return d0 * 512 + ks * 4096 + half * 2048; }
__device__ __forceinline__ int crow(int r, int hi) { return (r & 3) + 8 * (r >> 2) + 4 * hi; }
__device__ __forceinline__ unsigned cvtpk(float lo, float hi) { unsigned r; asm volatile("v_cvt_pk_bf16_f32 %0, %1, %2" : "=v"(r) : "v"(lo), "v"(hi)); return r; }
__device__ __forceinline__ bf16x8 load8(const bf16* p) { return *reinterpret_cast<const bf16x8*>(p); }

__device__ __forceinline__ bool moba_mask(f32x16& p0, f32x16& p1, int kb, int ib, int qm, unsigned selmask, const float* LUT, int qlo) {
    const float NEG = -__builtin_inff();
    const int jb = kb >> 8;
    if (kb + 63 + 113 <= qlo) {
        return jb != ib && ((selmask >> jb) & 1u) == 0u;
    } else {
        const bool ok = (jb == ib) || ((selmask >> jb) & 1u);
        const int dq = qm - kb;
#pragma unroll
        for (int g = 0; g < 4; ++g) {
#pragma unroll
            for (int e = 0; e < 4; ++e) { const int r = 4 * g + e;
                const int c = (r & 3) + 8 * (r >> 2);
                const int d0 = dq - c, d1 = d0 - 32;
                const int i0 = d0 < 0 ? 0 : (d0 > 127 ? 127 : d0), i1 = d1 < 0 ? 0 : (d1 > 127 ? 127 : d1);
                const float b0 = LUT[i0], b1 = LUT[i1];
                p0[r] = (ok && d0 >= 0) ? p0[r] + b0 : NEG;
                p1[r] = (ok && d1 >= 0) ? p1[r] + b1 : NEG; }
            SBAR();
        }
    }
    return false;
}
__device__ __forceinline__ void partialSM(f32x16& p0, f32x16& p1, float& m_reg, float& mn, float& alpha, bool dead) {
    float pmax;
    { float ma = p0[0], mb = p1[0];
#pragma unroll
      for (int r = 1; r < 16; ++r) { ma = fmaxf(ma, p0[r]); mb = fmaxf(mb, p1[r]); }
      pmax = fmaxf(ma, mb); }
    { auto rr = __builtin_amdgcn_permlane32_swap(__float_as_uint(pmax), __float_as_uint(pmax), false, false);
      pmax = fmaxf(__uint_as_float(rr[0]), __uint_as_float(rr[1])); }
    constexpr float C2 = 1.4426950408889634f * SCALE;
    if (__builtin_expect(__all((pmax - m_reg) * SCALE <= THR), 1)) { mn = m_reg; alpha = 1.f; }
    else { mn = fmaxf(m_reg, pmax); alpha = __builtin_amdgcn_exp2f((m_reg - mn) * C2); m_reg = mn; }
    const float mnL = dead ? -__builtin_inff() : -mn * C2;
    for (int r = 0; r < 16; ++r) p0[r] = fmaf(p0[r], C2, mnL); for (int r = 0; r < 16; ++r) p1[r] = fmaf(p1[r], C2, mnL);
    for (int r = 0; r < 16; ++r) p0[r] = __builtin_amdgcn_exp2f(p0[r]);
}
__device__ __forceinline__ void finishSM(f32x16& p0, f32x16& p1, float alpha, float& l_reg, bf16x8& pa0, bf16x8& pa1, bf16x8& pa2, bf16x8& pa3) {
    for (int r = 0; r < 16; ++r) p1[r] = __builtin_amdgcn_exp2f(p1[r]);
    float ps;
    { float s0 = p0[0], s1 = p0[1], s2 = p0[2], s3 = p0[3];
#define ADDF(a_, b_) asm("v_add_f32 %0, %0, %1" : "+v"(a_) : "v"(b_))
#pragma unroll
      for (int r = 4; r < 16; r += 4) { ADDF(s0, p0[r]); ADDF(s1, p0[r + 1]); ADDF(s2, p0[r + 2]); ADDF(s3, p0[r + 3]); }
#pragma unroll
      for (int r = 0; r < 16; r += 4) { ADDF(s0, p1[r]); ADDF(s1, p1[r + 1]); ADDF(s2, p1[r + 2]); ADDF(s3, p1[r + 3]); }
      ADDF(s0, s1); ADDF(s2, s3); ADDF(s0, s2); ps = s0; }
#undef ADDF
    { auto rr = __builtin_amdgcn_permlane32_swap(__float_as_uint(ps), __float_as_uint(ps), false, false);
      ps = __uint_as_float(rr[0]) + __uint_as_float(rr[1]); }
    l_reg = l_reg * alpha + ps;
#define PK4(P, B_, OUT) do { unsigned a0 = cvtpk(P[B_+0], P[B_+1]), a1 = cvtpk(P[B_+2], P[B_+3]);                          \
        unsigned b0 = cvtpk(P[B_+4], P[B_+5]), b1 = cvtpk(P[B_+6], P[B_+7]);                                             \
        auto r0 = __builtin_amdgcn_permlane32_swap(a0, b0, false, false); auto r1 = __builtin_amdgcn_permlane32_swap(a1, b1, false, false); \
        u32x4 w = {r0[0], r1[0], r0[1], r1[1]}; OUT = *reinterpret_cast<bf16x8*>(&w); } while (0)
    PK4(p0, 0, pa0); PK4(p0, 8, pa1); PK4(p1, 0, pa2); PK4(p1, 8, pa3);
#undef PK4
}
template <int KB>
__device__ __forceinline__ void qkt(f32x16& p0, f32x16& p1, const char* K_lds, int r32, int hi, const bf16x8* qr) {
    p0 = f32x16{}; p1 = f32x16{};
    const int base = (int)(uintptr_t)K_lds;
    int ad[4];
#pragma unroll
    for (int dd = 0; dd < 4; ++dd) ad[dd] = base + KSWZ(r32, (dd * 16 + hi * 8) * 2);
    const int d47 = 128 - ((r32 & 8) << 5);
#define KRD(dst, addr, off) asm volatile("ds_read_b128 %0, %1 offset:%2" : "=&v"(dst) : "v"(addr), "i"(off) : "memory")
#define KWAIT(n, x, y) asm volatile("s_waitcnt lgkmcnt(" #n ")" : "+v"(x), "+v"(y) :: "memory")
    bf16x8 fa0, fb0, fa1, fb1;
    KRD(fa0, ad[0], KB * SHM_K); KRD(fb0, ad[0], KB * SHM_K + 32 * 256);
#define QK_STEP(d0, FA, FB, NA, NB) do {                                                                                        \
        if ((d0) < 7) { const int an_ = ad[((d0) + 1) & 3] + ((((d0) + 1) >> 2) ? d47 : 0); KRD(NA, an_, KB * SHM_K); KRD(NB, an_, KB * SHM_K + 32 * 256); KWAIT(2, FA, FB); } \
        else KWAIT(0, FA, FB);                                                                                                  \
        p0 = __builtin_amdgcn_mfma_f32_32x32x16_bf16(FA, qr[d0], p0, 0, 0, 0);                                                 \
        p1 = __builtin_amdgcn_mfma_f32_32x32x16_bf16(FB, qr[d0], p1, 0, 0, 0); } while (0)
    QK_STEP(0, fa0, fb0, fa1, fb1); QK_STEP(1, fa1, fb1, fa0, fb0); QK_STEP(2, fa0, fb0, fa1, fb1); QK_STEP(3, fa1, fb1, fa0, fb0);
    QK_STEP(4, fa0, fb0, fa1, fb1); QK_STEP(5, fa1, fb1, fa0, fb0); QK_STEP(6, fa0, fb0, fa1, fb1); QK_STEP(7, fa1, fb1, fa0, fb0);
#undef QK_STEP
#undef KRD
#undef KWAIT
}
template <int VB>
__device__ __forceinline__ void pv_tile(f32x16* o, int vb0, bf16x8 pa0, bf16x8 pa1, bf16x8 pa2, bf16x8 pa3) {
#define TRRD(dst, off) asm volatile("ds_read_b64_tr_b16 %0, %1 offset:%2" : "=&v"(dst) : "v"(vb0), "i"(off) : "memory")
#define PV_D0(d0) do { s16x4 l0, l1, l2, l3, h0, h1, h2, h3; constexpr int b_ = VB * SHM_V + v_rd_off(d0, 0, 0); \
        TRRD(l0, b_); TRRD(h0, b_ + 2048); TRRD(l1, b_ + 4096); TRRD(h1, b_ + 6144); TRRD(l2, b_ + 8192); TRRD(h2, b_ + 10240); TRRD(l3, b_ + 12288); TRRD(h3, b_ + 14336); \
        asm volatile("s_waitcnt lgkmcnt(0)" ::: "memory"); SBAR();   \
        o[d0] = __builtin_amdgcn_mfma_f32_32x32x16_bf16(pa0, (bf16x8){l0[0], l0[1], l0[2], l0[3], h0[0], h0[1], h0[2], h0[3]}, o[d0], 0, 0, 0);   \
        o[d0] = __builtin_amdgcn_mfma_f32_32x32x16_bf16(pa1, (bf16x8){l1[0], l1[1], l1[2], l1[3], h1[0], h1[1], h1[2], h1[3]}, o[d0], 0, 0, 0);   \
        o[d0] = __builtin_amdgcn_mfma_f32_32x32x16_bf16(pa2, (bf16x8){l2[0], l2[1], l2[2], l2[3], h2[0], h2[1], h2[2], h2[3]}, o[d0], 0, 0, 0);   \
        o[d0] = __builtin_amdgcn_mfma_f32_32x32x16_bf16(pa3, (bf16x8){l3[0], l3[1], l3[2], l3[3], h3[0], h3[1], h3[2], h3[3]}, o[d0], 0, 0, 0); } while (0)
    PV_D0(0); PV_D0(1); PV_D0(2); PV_D0(3);
#undef PV_D0
#undef TRRD
}

struct BlockRef { const bf16* Q; const bf16* K; const bf16* V; bf16* O; int P0; };
struct Seam { bf16x8 qr[8]; };
#define VMW() asm volatile("s_waitcnt vmcnt(0)" ::: "memory")
struct DmaMap { unsigned koff, voff; };
__device__ __forceinline__ DmaMap dma_map(int wid, int lane) {
    DmaMap d;
    { const int row = 4 * wid + (lane >> 4), g = (lane & 15) ^ (row & 15); d.koff = (unsigned)(row * PQ + g * 8); }
    { const int B = 2 * wid + (lane >> 5), kk = (B >> 2) * 8 + ((lane & 31) >> 2), c = (B & 3) * 32 + (lane & 3) * 8;
      const int k = (kk & ~0xC) | ((kk & 4) << 1) | ((kk & 8) >> 1); d.voff = (unsigned)(k * PQ + c); }
    return d;
}
#define DMA16(g_, l_) __builtin_amdgcn_global_load_lds((const unsigned*)(g_), (LAS unsigned*)(l_), 16, 0, 0)
#define DMA_K(bf, k0) do { const bf16* g_ = Kh + (size_t)(k0) * PQ + dm.koff; DMA16(g_, KL + (bf) * SHM_K + wid * 1024); DMA16(g_ + 32 * PQ, KL + (bf) * SHM_K + 8192 + wid * 1024); } while (0)
#define DMA_V(bf, k0) do { const bf16* g_ = Vh + (size_t)(k0) * PQ + dm.voff; DMA16(g_, VL + (bf) * SHM_V + wid * 1024); DMA16(g_ + 32 * PQ, VL + (bf) * SHM_V + 8192 + wid * 1024); } while (0)

__device__ __forceinline__ void moba_prime(const BlockRef& cur, char* lds, Seam& S, bool wait = true) {
    const int tid = fresh_tid(), wid = __builtin_amdgcn_readfirstlane(tid >> 6), lane = tid & 63, r32 = lane & 31, hi = lane >> 5;
    LAS unsigned char* VL = (LAS unsigned char*)(unsigned)(uintptr_t)lds; LAS unsigned char* KL = VL + 2 * SHM_V;
    const bf16* Kh = cur.K; const bf16* Vh = cur.V; const DmaMap dm = dma_map(wid, lane);
    DMA_K(0, 0); DMA_V(0, 0);
    for (int d0 = 0; d0 < 8; ++d0) S.qr[d0] = load8(cur.Q + (size_t)(wid * QBLK + r32) * PQ + d0 * 16 + hi * 8);
    if (wait) { VMW(); __syncthreads(); }
}
__device__ __forceinline__ unsigned moba_select(const bf16x8* qr, const float* KM, int nblk, int hi) {
    float qf[64];
#pragma unroll
    for (int d0 = 0; d0 < 8; ++d0)
#pragma unroll
        for (int e = 0; e < 8; ++e) qf[d0 * 8 + e] = __uint_as_float(((unsigned)(unsigned short)qr[d0][e]) << 16);
    float v0 = -__builtin_inff(), v1 = v0, v2 = v0; int i0 = -1, i1 = -1, i2 = -1;
    for (int j = 0; j < nblk; ++j) {
        const float* km = KM + j * 128 + hi * 8;
        float a0 = 0.f, a1 = 0.f, a2 = 0.f, a3 = 0.f;
#pragma unroll
        for (int d0 = 0; d0 < 8; ++d0) { const f32x4 k0 = *(const f32x4*)(km + d0 * 16), k1 = *(const f32x4*)(km + d0 * 16 + 4);
            a0 = fmaf(qf[d0 * 8 + 0], k0[0], a0); a1 = fmaf(qf[d0 * 8 + 1], k0[1], a1); a2 = fmaf(qf[d0 * 8 + 2], k0[2], a2); a3 = fmaf(qf[d0 * 8 + 3], k0[3], a3);
            a0 = fmaf(qf[d0 * 8 + 4], k1[0], a0); a1 = fmaf(qf[d0 * 8 + 5], k1[1], a1); a2 = fmaf(qf[d0 * 8 + 6], k1[2], a2); a3 = fmaf(qf[d0 * 8 + 7], k1[3], a3); }
        float a = (a0 + a1) + (a2 + a3);
        { auto rr = __builtin_amdgcn_permlane32_swap(__float_as_uint(a), __float_as_uint(a), false, false); a = __uint_as_float(rr[0]) + __uint_as_float(rr[1]); }
        if (a > v0) { v2 = v1; i2 = i1; v1 = v0; i1 = i0; v0 = a; i0 = j; }
        else if (a > v1) { v2 = v1; i2 = i1; v1 = a; i1 = j; }
        else if (a > v2) { v2 = a; i2 = j; }
    }
    unsigned msk = 0u;
    if (i0 >= 0) msk |= 1u << i0; if (i1 >= 0) msk |= 1u << i1; if (i2 >= 0) msk |= 1u << i2;
    return msk;
}
__device__ __forceinline__ void moba_block(const BlockRef& cur, char* lds, Seam& S) {
    const int tid = fresh_tid(), wid = __builtin_amdgcn_readfirstlane(tid >> 6), lane = tid & 63, r32 = lane & 31, hi = lane >> 5;
    const int NT = (cur.P0 + QB) / KVBLK;
    const int ib = cur.P0 >> 8;
    const int qlo = cur.P0 + wid * QBLK, qm = qlo + r32 - 4 * hi;
    char* V_lds = lds; char* K_lds = lds + 2 * SHM_V;
    LAS unsigned char* VL = (LAS unsigned char*)(unsigned)(uintptr_t)lds; LAS unsigned char* KL = VL + 2 * SHM_V;
    float* ws = (float*)(lds + LDS_WS) + wid * 64; float* li_l = ws, * al_l = ws + 32;
    const float* KM = (const float*)(lds + LDS_KM); const float* LUT = (const float*)(lds + LDS_LUT);
    float m_reg = -1e30f, l_reg = 0; f32x16 o[4] = {};
    const int vb0 = (int)(uintptr_t)V_lds + v_rd_base(lane);
    const bf16* Kh = cur.K; const bf16* Vh = cur.V; const DmaMap dm = dma_map(wid, lane);
#define RESC(a) do { if (__any((a) < 1.f)) { if (hi == 0) al_l[r32] = (a); asm volatile("s_waitcnt lgkmcnt(0)" ::: "memory");              \
                     for (int d_ = 0; d_ < 4; ++d_) for (int r = 0; r < 16; ++r) o[d_][r] *= al_l[crow(r, hi)]; } } while (0)
#define KBASE(t) ((t) * KVBLK)
#define MASKT(P0_, P1_, t) const bool dead_ = moba_mask(P0_, P1_, KBASE(t), ib, qm, selmask, LUT, qlo)
    f32x16 pA0, pA1, pB0, pB1; float mnA, mnB, alA, alB; bf16x8 pa0, pa1, pa2, pa3;
    SBAR(); DMA_K(1, KBASE(1)); SBAR();
    const unsigned selmask = ib <= 3 ? (1u << ib) - 1u : moba_select(S.qr, KM, ib, hi);
    SBAR(); qkt<0>(pA0, pA1, K_lds, r32, hi, S.qr);
    { MASKT(pA0, pA1, 0); partialSM(pA0, pA1, m_reg, mnA, alA, dead_); }
    VMW();
    __syncthreads();
    const int Tw = NT - 4 + (wid >> 1);
#define HALF_STEP(PX0, PX1, mnX, alX, PY0, PY1, alY, t, KB, VB) do {                                                          \
        SBAR(); DMA_K(VB, KBASE((t) + 1)); DMA_V(KB, KBASE(t)); SBAR();                                                       \
        if ((t) <= Tw) qkt<KB>(PX0, PX1, K_lds, r32, hi, S.qr);                                                               \
        if ((t) - 1 <= Tw) { finishSM(PY0, PY1, alY, l_reg, pa0, pa1, pa2, pa3); SBAR();                                      \
            pv_tile<VB>(o, vb0, pa0, pa1, pa2, pa3); }                                                                        \
        if ((t) <= Tw) { MASKT(PX0, PX1, (t)); partialSM(PX0, PX1, m_reg, mnX, alX, dead_); RESC(alX); }                      \
        VMW();                                                                                                                \
        __syncthreads(); } while (0)
    for (int t = 1; t + 1 < NT; t += 2) {
        HALF_STEP(pB0, pB1, mnB, alB, pA0, pA1, alA, t, 1, 0);
        HALF_STEP(pA0, pA1, mnA, alA, pB0, pB1, alB, t + 1, 0, 1);
    }
    SBAR(); DMA_V(1, KBASE(NT - 1)); SBAR();
    if (NT - 1 <= Tw) { qkt<1>(pB0, pB1, K_lds, r32, hi, S.qr); SBAR(); }
    if (NT - 2 <= Tw) { finishSM(pA0, pA1, alA, l_reg, pa0, pa1, pa2, pa3); SBAR();
        pv_tile<0>(o, vb0, pa0, pa1, pa2, pa3); }
    if (NT - 1 <= Tw) { MASKT(pB0, pB1, NT - 1); partialSM(pB0, pB1, m_reg, mnB, alB, dead_); RESC(alB); }
    VMW(); __syncthreads();
    if (NT - 1 <= Tw) { finishSM(pB0, pB1, alB, l_reg, pa0, pa1, pa2, pa3); SBAR(); pv_tile<1>(o, vb0, pa0, pa1, pa2, pa3); }
    SBAR();
    if (hi == 0) li_l[r32] = l_reg; asm volatile("s_waitcnt lgkmcnt(0)" ::: "memory");
    float rli[16];
#pragma unroll
    for (int r = 0; r < 16; ++r) rli[r] = __builtin_amdgcn_rcpf(li_l[crow(r, hi)]);
    bf16* Ow = cur.O + (size_t)(wid * QBLK) * PO;
#pragma unroll
    for (int r = 0; r < 16; ++r) { const int orow = crow(r, hi);
#pragma unroll
        for (int d0 = 0; d0 < 4; ++d0) { const float v = o[d0][r] * rli[r];
            const float vn = __shfl_xor(v, 1);
            if ((r32 & 1) == 0) *(unsigned*)(Ow + (size_t)orow * PO + d0 * 32 + r32) = cvtpk(v, vn); } }
    __syncthreads();
#undef RESC
#undef KBASE
#undef MASKT
#undef HALF_STEP
}
#undef VMW
#undef DMA16
#undef DMA_K
#undef DMA_V
#undef SBAR
#undef KSWZ
}

constexpr size_t MiB = 1u << 20;
constexpr size_t WS_CTL = 0, CTL_ZERO_BYTES = 64 * 1024;
constexpr size_t WO_IN = 0;
constexpr size_t WO_CA = 40 * MiB;
constexpr size_t WO_MIX = 48 * MiB;
constexpr size_t WO_GU = 56 * MiB;
constexpr size_t WO_DN = 100 * MiB;
constexpr size_t WSET_BYTES = 122 * MiB;
constexpr size_t WS_W0 = 2 * MiB, WS_W1 = 702 * MiB;
constexpr size_t WS_KPART = 124 * MiB;
constexpr size_t WS_SS = 126 * MiB;
constexpr size_t WS_XB2 = 128 * MiB;
constexpr size_t WS_XB = 254 * MiB;
constexpr size_t WS_PROJ = 318 * MiB;
constexpr size_t WS_GU = WS_PROJ;
constexpr size_t WS_UA = 638 * MiB;
constexpr size_t WS_MG = 830 * MiB;
constexpr size_t WS_END = 894 * MiB;
static_assert(WS_W1 + WSET_BYTES <= WS_MG, "weight set 1");
constexpr int CW_BAR = 4096;

constexpr int RING_OFF = 0, RING_BYTES = 131072;
constexpr int LDSCTL_OFF = RING_BYTES, MISC_OFF = LDSCTL_OFF + 320;
constexpr int LDS_BYTES = LDS_TOTAL;
static_assert(att::LDS_BYTES <= RING_BYTES && MISC_OFF + 128 <= LDS_RB_OFF, "LDS map");

#define XB_TMO      128
#define XB_XCNT(j)  (256  + 64 * (j))
#define XB_XSUB(j)  (1280 + 64 * (j))
#define XB_XGEN(j)  (2304 + 64 * (j))
#define XB_TOP      3328
#define XB_TOPGEN   3392
#define XCD_BAR_WORDS 3456
#define XB_SPIN_CAP (1u << 18)

__device__ __forceinline__ unsigned xb_ld(unsigned* p)              { return __hip_atomic_load(p, __ATOMIC_RELAXED, __HIP_MEMORY_SCOPE_AGENT); }
__device__ __forceinline__ unsigned xb_add(unsigned* p, unsigned v) { return __hip_atomic_fetch_add(p, v, __ATOMIC_RELAXED, __HIP_MEMORY_SCOPE_AGENT); }
__device__ __forceinline__ unsigned xb_xcc_id() { return (unsigned)__builtin_amdgcn_s_getreg((3 << 11) | 20) & 0xFu; }
#define XB_SPIN(cond, bar) do { unsigned _sp = 0; while (cond) { __builtin_amdgcn_s_sleep(1); \
    if ((++_sp & 255u) == 0u) { if (xb_ld(&(bar)[XB_TMO])) break; if (_sp > XB_SPIN_CAP) { atomicAdd(&(bar)[XB_TMO], 1u); break; } } } } while (0)

struct XcdBarrier { unsigned* bar; unsigned x; volatile LAS unsigned* st; };

__device__ __forceinline__ XcdBarrier xcd_barrier_post(unsigned* bar, volatile LAS unsigned* st) {
    XcdBarrier b; b.bar = bar; b.x = xb_xcc_id(); b.st = st;
    if (threadIdx.x == 0) (void)xb_add(&bar[XB_XCNT(b.x)], 1u);
    return b;
}
__device__ __forceinline__ void xcd_barrier_complete(unsigned* bar, unsigned x, unsigned& nloc, unsigned& nx) {
    const unsigned G = gridDim.x * gridDim.y * gridDim.z;
    unsigned sum, cnt, mine, sp = 0u;
    for (;;) {
        sum = 0u; cnt = 0u; mine = 0u;
#pragma unroll
        for (unsigned j = 0; j < 16; ++j) { const unsigned c = xb_ld(&bar[XB_XCNT(j)]); sum += c; cnt += (c > 0u) ? 1u : 0u; mine = (j == x) ? c : mine; }
        if (sum == G) break;
        __builtin_amdgcn_s_sleep(1);
        if ((++sp & 255u) == 0u) { if (xb_ld(&bar[XB_TMO])) break; if (sp > XB_SPIN_CAP) { atomicAdd(&bar[XB_TMO], 1u); break; } }
    }
    nloc = mine > 0u ? mine : 1u; nx = cnt > 0u ? cnt : 1u;
}
__device__ __forceinline__ void xcd_barrier(const XcdBarrier& b) {
    asm volatile("s_waitcnt vmcnt(0)" ::: "memory");
    __syncthreads();
    if (threadIdx.x == 0) {
        unsigned* bar = b.bar;
        __builtin_amdgcn_s_waitcnt(0);
        unsigned nloc = b.st[0], nx = b.st[1];
        if (nloc == 0u) { xcd_barrier_complete(bar, b.x, nloc, nx); b.st[0] = nloc; b.st[1] = nx; }
        const unsigned old = xb_add(&bar[XB_XSUB(b.x)], 1u);
        const unsigned gen = old / nloc;
        if (old + 1u == (gen + 1u) * nloc) {
            __builtin_amdgcn_fence(__ATOMIC_RELEASE, "agent");
            asm volatile("s_waitcnt vmcnt(0)" ::: "memory");
            const unsigned og = xb_add(&bar[XB_TOP], 1u);
            const unsigned tg = og / nx;
            if (og + 1u == (tg + 1u) * nx) xb_add(&bar[XB_TOPGEN], 1u);
            else XB_SPIN(xb_ld(&bar[XB_TOPGEN]) == tg, bar);
            __builtin_amdgcn_fence(__ATOMIC_ACQUIRE, "agent");
            asm volatile("s_waitcnt vmcnt(0)" ::: "memory");
            xb_add(&bar[XB_XGEN(b.x)], 1u);
            asm volatile("s_waitcnt vmcnt(0)" ::: "memory");
        } else {
            XB_SPIN(xb_ld(&bar[XB_XGEN(b.x)]) == gen, bar);
            asm volatile("buffer_inv sc0\n\ts_waitcnt vmcnt(0)" ::: "memory");
        }
    }
    __syncthreads();
}

__device__ __forceinline__ void panel_barrier(unsigned* cnt, unsigned target, unsigned* tmo, bool local) {
    asm volatile("s_waitcnt vmcnt(0)" ::: "memory");
    __syncthreads();
    if (threadIdx.x == 0) {
        if (!local) { __builtin_amdgcn_fence(__ATOMIC_RELEASE, "agent"); asm volatile("s_waitcnt vmcnt(0)" ::: "memory"); }
        (void)xb_add(cnt, 1u);
        unsigned sp = 0u;
        while (xb_ld(cnt) < target) { __builtin_amdgcn_s_sleep(1); if ((++sp & 255u) == 0u) { if (xb_ld(tmo)) break; if (sp > XB_SPIN_CAP) { atomicAdd(tmo, 1u); break; } } }
        if (!local) { __builtin_amdgcn_fence(__ATOMIC_ACQUIRE, "agent"); asm volatile("s_waitcnt vmcnt(0)" ::: "memory"); }
    }
    __syncthreads();
    if (local) asm volatile("buffer_inv sc0\n\ts_waitcnt vmcnt(0)" ::: "memory");
}
struct Args { const float* in[13]; float* out; unsigned char* ws; int ph_lo, ph_hi; };
struct Frame {
    LAS unsigned char* lds;
    int vcu, G;
    unsigned char* ws;
};

__device__ __forceinline__ float wave_sum(float v) {
#pragma unroll
    for (int o = 1; o < 64; o <<= 1) v += __shfl_xor(v, o);
    return v;
}
struct CvtItem { const float* src; size_t rs2; bf16* dst; int ldw; const float* gain; int has_gain; };
constexpr int CVT_I_IN = (DM / 64) * (INC / 32), CVT_NITEMS = CVT_I_IN + 2 * (CCH / 64) * (DM / 32) + (DM / 64) * (DM / 32) + 2 * (DM / 64) * (FF / 32) + (FF / 64) * (DM / 32);
__device__ __forceinline__ CvtItem cvt_decode(const Args& a, unsigned char* wset, int l, int r) {
    constexpr int I_IN = (DM / 64) * (INC / 32), I_CO = (CCH / 64) * (DM / 32), I_AO = (AW / 64) * (DM / 32), I_MIX = (DM / 64) * (DM / 32),
                  I_G = (DM / 64) * (FF / 32), I_U = I_G, I_DN = (FF / 64) * (DM / 32);
    static_assert(I_IN == CVT_I_IN && I_IN + I_CO + I_AO + I_MIX + I_G + I_U + I_DN == CVT_NITEMS, "item counts");
    const float* W; int N, ldw, k0, n0; bf16* WT; const float* gain = nullptr; int dcol = 0, rowmode = 0;
#define CVT_KN(NB) do { k0 = 64 * (r / (NB)); n0 = 32 * (r % (NB)); } while (0)
    if (r < I_IN) { W = a.in[1] + (size_t)l * DM * INC; N = INC; WT = (bf16*)(wset + WO_IN); ldw = DM; gain = a.in[7] + (size_t)l * DM; rowmode = 3; CVT_KN(INC / 32); }
    else if ((r -= I_IN) < I_CO) { W = a.in[3] + (size_t)l * CCH * DM; N = DM; WT = (bf16*)(wset + WO_CA); ldw = 2048; CVT_KN(DM / 32); }
    else if ((r -= I_CO) < I_AO) { W = a.in[4] + (size_t)l * AW * DM; N = DM; WT = (bf16*)(wset + WO_CA); ldw = 2048; dcol = 1024; CVT_KN(DM / 32); }
    else if ((r -= I_AO) < I_MIX) { W = a.in[5] + (size_t)l * DM * DM; N = DM; WT = (bf16*)(wset + WO_MIX); ldw = DM; CVT_KN(DM / 32); }
    else if ((r -= I_MIX) < I_G) { W = a.in[9] + (size_t)l * DM * FF; N = FF; WT = (bf16*)(wset + WO_GU); ldw = DM; gain = a.in[8] + (size_t)l * DM; rowmode = 1; CVT_KN(FF / 32); }
    else if ((r -= I_G) < I_U) { W = a.in[10] + (size_t)l * DM * FF; N = FF; WT = (bf16*)(wset + WO_GU); ldw = DM; gain = a.in[8] + (size_t)l * DM; rowmode = 2; CVT_KN(FF / 32); }
    else { r -= I_U; W = a.in[11] + (size_t)l * FF * DM; N = DM; WT = (bf16*)(wset + WO_DN); ldw = FF; CVT_KN(DM / 32); }
#undef CVT_KN
    int drow = rowmode == 0 ? n0 : 256 * (n0 / 128) + (n0 % 128) + (rowmode == 2 ? 128 : 0);
    if (rowmode == 3) { const int isatt = n0 >= C_GA, gcol = n0 - (isatt ? C_GA : C_GC);
        drow = n0 < C_GC ? n0 : C_GC + 256 * (gcol / 128) + (gcol % 128) + (isatt ? 128 : 0);
        if (n0 < C_B || (n0 >= C_C && n0 < C_Q)) { const int isc = n0 >= C_C, ch = n0 - (isc ? C_C : 0), k = ch / 128, pk = k < 4 ? k : 4 + k;
            drow = 256 * pk + (ch % 128) + (isc ? 128 : 0); } }
    CvtItem c; c.src = W + (size_t)k0 * N + n0; c.rs2 = (size_t)2 * N; c.dst = WT + (size_t)drow * ldw + dcol + k0; c.ldw = ldw; c.gain = (gain ? gain : a.in[7]) + k0; c.has_gain = gain != nullptr;
    return c;
}
__device__ __forceinline__ void cvt_load(const CvtItem& c, int lane, f32x4 (&wv)[8], f32x4 (&gv)[2]) {
    const float* wp = c.src + (size_t)(lane >> 3) * (c.rs2 >> 1) + 4 * (lane & 7);
#pragma unroll
    for (int i = 0; i < 8; ++i) wv[i] = *(const GAS f32x4*)(wp + (size_t)i * 4 * c.rs2);
    gv[0] = *(const f32x4*)(c.gain + 8 * (lane & 7)); gv[1] = *(const f32x4*)(c.gain + 8 * (lane & 7) + 4);
}
__device__ __forceinline__ void cvt_store(const CvtItem& c, int lane, const f32x4 (&wv)[8], const f32x4 (&gv)[2], LAS float* scr) {
    const int ch = lane & 7;
    LAS float* wp = scr + (lane >> 3) * 33 + 4 * (lane & 7);
#pragma unroll
    for (int i = 0; i < 8; ++i)
#pragma unroll
        for (int q = 0; q < 4; ++q) wp[i * 8 * 33 + q] = wv[i][q];
    f32x4 g0 = gv[0], g1 = gv[1];
    if (!c.has_gain) { g0 = (f32x4){1.f, 1.f, 1.f, 1.f}; g1 = g0; }
    LDS_WAIT(); asm volatile("" ::: "memory");
    float t[4][8];
#pragma unroll
    for (int j = 0; j < 4; ++j) { const LAS float* sp = scr + (8 * ch) * 33 + (lane >> 3) + 8 * j;
#pragma unroll
        for (int e = 0; e < 8; ++e) t[j][e] = sp[e * 33]; }
    __builtin_amdgcn_sched_barrier(0);
    LDS_WAIT();
#pragma unroll
    for (int j = 0; j < 4; ++j) { const int n = (lane >> 3) + 8 * j;
        v4u o; o.x = cvt_pk_bf16(t[j][0] * g0[0], t[j][1] * g0[1]); o.y = cvt_pk_bf16(t[j][2] * g0[2], t[j][3] * g0[3]); o.z = cvt_pk_bf16(t[j][4] * g1[0], t[j][5] * g1[1]); o.w = cvt_pk_bf16(t[j][6] * g1[2], t[j][7] * g1[3]);
        __builtin_nontemporal_store(o, (GAS v4u*)(c.dst + (size_t)n * c.ldw + 8 * ch)); }
    asm volatile("" ::: "memory");
}
__device__ __forceinline__ void phase_convert_weights(Frame& F, const Args& a, int l, int it_lo, int it_hi) {
    const int tid = fresh_tid(), lane = tid & 63, wave = __builtin_amdgcn_readfirstlane(tid >> 6);
    LAS float* scr = (LAS float*)(F.lds + RING_OFF + wave * 8448);
    const int gw = F.vcu * NWAVES + wave, NGW = F.G * NWAVES;
    unsigned char* wset = F.ws + ((l & 1) ? WS_W1 : WS_W0);
    const int first = it_lo + gw;
    if (first >= it_hi) return;
    const int n = (it_hi - first + NGW - 1) / NGW;
#define CVT_ITEM(j) cvt_decode(a, wset, l, first + ((j) < n ? (j) : n - 1) * NGW)
    f32x4 wA[8], wB[8], wC[8], wD[8], gA[2], gB[2], gC[2], gD[2];
    CvtItem cA = CVT_ITEM(0), cB = CVT_ITEM(1), cC = CVT_ITEM(2), cD = cA;
    cvt_load(cA, lane, wA, gA); cvt_load(cB, lane, wB, gB); cvt_load(cC, lane, wC, gC);
    for (int j = 0;; j += 4) {
        cD = CVT_ITEM(j + 3); cvt_load(cD, lane, wD, gD); __builtin_amdgcn_sched_barrier(0); cvt_store(cA, lane, wA, gA, scr); if (j + 1 >= n) break;
        cA = CVT_ITEM(j + 4); cvt_load(cA, lane, wA, gA); __builtin_amdgcn_sched_barrier(0); cvt_store(cB, lane, wB, gB, scr); if (j + 2 >= n) break;
        cB = CVT_ITEM(j + 5); cvt_load(cB, lane, wB, gB); __builtin_amdgcn_sched_barrier(0); cvt_store(cC, lane, wC, gC, scr); if (j + 3 >= n) break;
        cC = CVT_ITEM(j + 6); cvt_load(cC, lane, wC, gC); __builtin_amdgcn_sched_barrier(0); cvt_store(cD, lane, wD, gD, scr); if (j + 4 >= n) break;
    }
#undef CVT_ITEM
}
__device__ __forceinline__ void phase_x_to_bf16(Frame& F, const float* x) {
    const int tid = fresh_tid(), lane = tid & 63, wave = __builtin_amdgcn_readfirstlane(tid >> 6);
    const int gw = F.vcu * NWAVES + wave, NGW = F.G * NWAVES;
    bf16* XB = (bf16*)(F.ws + WS_XB); float* SS = (float*)(F.ws + WS_SS);
    for (int m = gw; m < M; m += 2 * NGW) {
        const GAS f32x4* xr0 = (const GAS f32x4*)(x + (size_t)m * DM) + lane; const bool two = m + NGW < M; const GAS f32x4* xr1 = (const GAS f32x4*)(x + (size_t)(two ? m + NGW : m) * DM) + lane;
        f32x4 v0[8], v1[8];
#pragma unroll
        for (int j = 0; j < 8; ++j) v0[j] = __builtin_nontemporal_load(xr0 + 64 * j);
#pragma unroll
        for (int j = 0; j < 8; ++j) v1[j] = __builtin_nontemporal_load(xr1 + 64 * j);
        __builtin_amdgcn_sched_barrier(0);
#pragma unroll
        for (int h = 0; h < 2; ++h) { if (h && !two) break; const int mm = m + h * NGW; float s = 0.f;
            GAS u32x2* o8 = (GAS u32x2*)(XB + (size_t)mm * DM) + lane;
#pragma unroll
            for (int j = 0; j < 8; ++j) { const f32x4 v = h ? v1[j] : v0[j]; s += (v.x * v.x + v.y * v.y) + (v.z * v.z + v.w * v.w);
                u32x2 w; w.x = cvt_pk_bf16(v.x, v.y); w.y = cvt_pk_bf16(v.z, v.w); o8[64 * j] = w; }
            s = wave_sum(s);
            if (lane < 8) SS[(size_t)mm * 8 + lane] = lane == 0 ? s : 0.f; }
    }
}
__device__ __forceinline__ void phase_final_norm(Frame& F, const float* gain, float* out, int pm, int mi) {
    const int tid = fresh_tid(), lane = tid & 63, wave = __builtin_amdgcn_readfirstlane(tid >> 6);
    const int gw = pm >= 0 ? wave : F.vcu * NWAVES + wave, NGW = pm >= 0 ? NWAVES : F.G * NWAVES;
    const int mlo = pm >= 0 ? pm * 256 + mi * 64 : 0, mhi = pm >= 0 ? mlo + 64 : M;
    const bf16* XB = (const bf16*)(F.ws + WS_XB); const float* SS = (const float*)(F.ws + WS_SS);
    for (int m = mlo + gw; m < mhi; m += NGW) {
        float s = lane < 8 ? SS[(size_t)m * 8 + lane] : 0.f; s = wave_sum(s);
        const float r = __builtin_amdgcn_rsqf(s * (1.0f / DM) + RMS_EPS);
#pragma unroll
        for (int j = 0; j < 4; ++j) { const int c = 8 * (lane + 64 * j); const u32x4 w = __builtin_nontemporal_load((const GAS u32x4*)(XB + (size_t)m * DM + c));
            const f32x4 g0 = *(const f32x4*)(gain + c), g1 = *(const f32x4*)(gain + c + 4);
            f32x4 o0, o1; o0[0] = bf_lo(w.x) * r * g0[0]; o0[1] = bf_hi(w.x) * r * g0[1]; o0[2] = bf_lo(w.y) * r * g0[2]; o0[3] = bf_hi(w.y) * r * g0[3];
            o1[0] = bf_lo(w.z) * r * g1[0]; o1[1] = bf_hi(w.z) * r * g1[1]; o1[2] = bf_lo(w.w) * r * g1[2]; o1[3] = bf_hi(w.w) * r * g1[3];
            __builtin_nontemporal_store(o0, (GAS f32x4*)(out + (size_t)m * DM + c)); __builtin_nontemporal_store(o1, (GAS f32x4*)(out + (size_t)m * DM + c + 4)); }
    }
}
__device__ __forceinline__ void unpack8(const u32x4 w, float (&f)[8]) {
    f[0] = bf_lo(w.x); f[1] = bf_hi(w.x); f[2] = bf_lo(w.y); f[3] = bf_hi(w.y); f[4] = bf_lo(w.z); f[5] = bf_hi(w.z); f[6] = bf_lo(w.w); f[7] = bf_hi(w.w);
}
__device__ __forceinline__ void phase_conv(Frame& F, const float* conv_w  ) {
    const bf16* PROJ = (const bf16*)(F.ws + WS_PROJ); bf16* UA = (bf16*)(F.ws + WS_UA);
    const int tid = fresh_tid(), lane = tid & 63, wave = __builtin_amdgcn_readfirstlane(tid >> 6);
    const int gw = F.vcu * NWAVES + wave, NGW = F.G * NWAVES;
    for (int it = gw; it < (M / 16) * 2; it += NGW) {
        const int half = it & 1, rr = it >> 1, m0 = rr * 16, t0 = m0 % SEQ, c0 = half * 512 + lane * 8;
        float w0[8], w1[8], w2[8];
        { const f32x4 a0 = *(const f32x4*)(conv_w + c0), a1 = *(const f32x4*)(conv_w + c0 + 4), b0 = *(const f32x4*)(conv_w + CCH + c0), b1 = *(const f32x4*)(conv_w + CCH + c0 + 4),
                      d0 = *(const f32x4*)(conv_w + 2 * CCH + c0), d1 = *(const f32x4*)(conv_w + 2 * CCH + c0 + 4);
#pragma unroll
          for (int e = 0; e < 4; ++e) { w0[e] = a0[e]; w0[4 + e] = a1[e]; w1[e] = b0[e]; w1[4 + e] = b1[e]; w2[e] = d0[e]; w2[4 + e] = d1[e]; } }
        float p2[8], p1[8];
#pragma unroll
        for (int e = 0; e < 8; ++e) { p2[e] = 0.f; p1[e] = 0.f; }
        if (t0 != 0) {
            unpack8(*(const u32x4*)(PROJ + (size_t)(m0 - 2) * INC + C_H + c0), p2);
            unpack8(*(const u32x4*)(PROJ + (size_t)(m0 - 1) * INC + C_H + c0), p1);
        }
#pragma unroll 8
        for (int r = 0; r < 16; ++r) {
            const size_t m = (size_t)(m0 + r);
            float ch[8], b[8], y[8];
            unpack8(__builtin_nontemporal_load((const GAS u32x4*)(PROJ + m * INC + C_H + c0)), ch); unpack8(__builtin_nontemporal_load((const GAS u32x4*)(PROJ + m * INC + C_B + c0)), b);
#pragma unroll
            for (int e = 0; e < 8; ++e) { const float cu = ch[e]; float acc = w0[e] * p2[e]; acc = acc + w1[e] * p1[e]; acc = acc + w2[e] * cu; y[e] = b[e] * acc; p2[e] = p1[e]; p1[e] = cu; }
            u32x4 w; w.x = cvt_pk_bf16(y[0], y[1]); w.y = cvt_pk_bf16(y[2], y[3]); w.z = cvt_pk_bf16(y[4], y[5]); w.w = cvt_pk_bf16(y[6], y[7]);
            __builtin_nontemporal_store(w, (GAS u32x4*)(UA + m * 2048 + c0));
        }
    }
}
__device__ __forceinline__ int t5_bucket(int n) {
    if (n < 16) return n;
    int b = 16;
    b += (n >= 19); b += (n >= 21); b += (n >= 24); b += (n >= 27); b += (n >= 31); b += (n >= 35); b += (n >= 40); b += (n >= 46);
    b += (n >= 52); b += (n >= 59); b += (n >= 67); b += (n >= 77); b += (n >= 87); b += (n >= 99); b += (n >= 113);
    return b;
}
__device__ __forceinline__ void mixer_stream_work(Frame& F, const Args& a, int l) {
    for (int rep = 0; rep < REP_MISC; ++rep) {
        phase_conv(F, a.in[2] + (size_t)l * 3 * CCH);
        if (l == 0) phase_convert_weights(F, a, 0, CVT_I_IN, CVT_NITEMS);
        if (l + 1 < DEPTH) phase_convert_weights(F, a, l + 1, 0, CVT_NITEMS);
    }
}
__device__ __forceinline__ void phase_attention(Frame& F, char* lds, const float* rel_bias, const Args& a, int l) {
    const bf16* PROJ = (const bf16*)(F.ws + WS_PROJ); bf16* UA = (bf16*)(F.ws + WS_UA); const float* KPART = (const float*)(F.ws + WS_KPART);
    float* KM = (float*)(lds + att::LDS_KM); float* LUT = (float*)(lds + att::LDS_LUT);
    bool streamed = false;
    for (int L = F.vcu; L < BATCH * NH * 8; L += F.G) {
        const int tid = fresh_tid();
        const int bh = L >> 3, x = L & 7, b = bh / NH, h = bh % NH;
        const int qbA = (bh & 1) ? 15 - x : x, qbB = 15 - qbA;
        att::BlockRef bA, bB;
        { const size_t row0 = (size_t)b * SEQ + (size_t)qbA * 256; bA.Q = PROJ + row0 * INC + C_Q + h * HD; bA.O = UA + row0 * 2048 + 1024 + h * HD; bA.P0 = qbA * 256; }
        { const size_t row0 = (size_t)b * SEQ + (size_t)qbB * 256; bB.Q = PROJ + row0 * INC + C_Q + h * HD; bB.O = UA + row0 * 2048 + 1024 + h * HD; bB.P0 = qbB * 256; }
        bA.K = bB.K = PROJ + (size_t)b * SEQ * INC + C_K + h * HD; bA.V = bB.V = PROJ + (size_t)b * SEQ * INC + C_V + h * HD;
        att::Seam S;
        att::moba_prime(bA, lds, S, false);
        for (int idx = tid; idx < 16 * 128; idx += NWAVES * 64) { const int j = idx >> 7, d = idx & 127; float s = 0.f;
            s = KPART[(size_t)((b * 16 + j) * 2 + 0) * 1024 + h * 128 + d] + KPART[(size_t)((b * 16 + j) * 2 + 1) * 1024 + h * 128 + d];
            KM[idx] = s * (1.0f / 256.0f); }
        if (tid < 128) LUT[tid] = (rel_bias[t5_bucket(tid) * NH + h] - rel_bias[31 * NH + h]) * (1.0f / att::SCALE);
        asm volatile("s_waitcnt vmcnt(0)" ::: "memory"); __syncthreads();
        for (int rep = 0; rep < REP_ATT; ++rep) {
        if (rep > 0) att::moba_prime(bA, lds, S);
        att::moba_block(bA, lds, S);
        __syncthreads();
        if (!streamed) { mixer_stream_work(F, a, l); streamed = true; __syncthreads(); }
        att::moba_prime(bB, lds, S);
        att::moba_block(bB, lds, S);
        __syncthreads();
        }
    }
    if (!streamed) mixer_stream_work(F, a, l);
}
constexpr int PH_PER_LAYER = 6, N_PHASES = DEPTH * PH_PER_LAYER + 2;

__global__ void __launch_bounds__(NWAVES * 64, 2) trunk_fwd(Args args) {
    extern __shared__ __attribute__((aligned(16))) unsigned char lds[];
    Frame F;
    F.lds = (LAS unsigned char*)lds;
    volatile LAS unsigned* MISC = (volatile LAS unsigned*)(F.lds + MISC_OFF);
    F.G = gridDim.x; { const int bx = blockIdx.x; F.vcu = (F.G % 8 == 0) ? (bx % 8) * (F.G / 8) + bx / 8 : bx; }
    F.ws = args.ws;
    unsigned* ctl = (unsigned*)(F.ws + WS_CTL);
    for (int u = threadIdx.x; u < (LDS_BYTES - LDSCTL_OFF) / 4; u += NWAVES * 64) ((LAS unsigned*)(F.lds + LDSCTL_OFF))[u] = 0u;
    __syncthreads();
    const int lo = args.ph_lo, hi = args.ph_hi;
    const bool use_bar = (hi - lo) > 1;
    XcdBarrier bar; bar.bar = ctl + CW_BAR; bar.x = 0; bar.st = MISC + 8;
    if (use_bar) bar = xcd_barrier_post(ctl + CW_BAR, MISC + 8);
#define IN(k) (lo <= (k) && (k) < hi)
#define SEAM(k) do { if ((k) + 1 < hi) xcd_barrier(bar); } while (0)
    const bool paneled = (F.G == 256) && use_bar;
    const int my_pm = 8 * ((int)blockIdx.x % 8) + ((int)blockIdx.x / 8) % 8, my_mi = (int)blockIdx.x / 64;
    unsigned pb_epoch = 0u; bool pb_local = false;
    if (paneled && threadIdx.x == 0) __hip_atomic_store(ctl + 12288 + blockIdx.x, 0x100u | xb_xcc_id(), __ATOMIC_RELAXED, __HIP_MEMORY_SCOPE_AGENT);
#define SEAMG(k) do { if ((k) + 1 < hi) { if (paneled) { pb_epoch += 4u; panel_barrier(ctl + 8192 + 64 * my_pm, pb_epoch, ctl + CW_BAR + XB_TMO, pb_local); } else xcd_barrier(bar); } } while (0)

    bf16* XB = (bf16*)(F.ws + WS_XB); bf16* XB2 = (bf16*)(F.ws + WS_XB2); float* SS = (float*)(F.ws + WS_SS); bf16* PROJ = (bf16*)(F.ws + WS_PROJ); bf16* GU = (bf16*)(F.ws + WS_GU);
    bf16* UA = (bf16*)(F.ws + WS_UA); bf16* MG = (bf16*)(F.ws + WS_MG); float* KP = (float*)(F.ws + WS_KPART);

    if (IN(0)) { phase_convert_weights(F, args, 0, 0, CVT_I_IN); phase_x_to_bf16(F, args.in[0]); SEAM(0); }
    if (paneled && lo == 0) {
        const unsigned b0 = (unsigned)blockIdx.x % 64u;
        const unsigned i0 = xb_ld(ctl + 12288 + b0), i1 = xb_ld(ctl + 12288 + b0 + 64), i2 = xb_ld(ctl + 12288 + b0 + 128), i3 = xb_ld(ctl + 12288 + b0 + 192);
        pb_local = (i0 & 0x100u) && i0 == i1 && i0 == i2 && i0 == i3;
    }
    for (int l = 0; l < DEPTH; ++l) {
        const int pb = 1 + l * PH_PER_LAYER;
        unsigned char* wset = F.ws + ((l & 1) ? WS_W1 : WS_W0);
        bf16* WIN = (bf16*)(wset + WO_IN); bf16* WCA = (bf16*)(wset + WO_CA); bf16* WMIX = (bf16*)(wset + WO_MIX); bf16* WGU = (bf16*)(wset + WO_GU); bf16* WDN = (bf16*)(wset + WO_DN);
        if (IN(pb + 0)) {
            pg8::Gemm g{XB, WIN, M, INC, DM, DM, DM}; pg8::WrapOrder S; S.init(M, INC * REP_IN, F.G, fresh_bid()); S.wrapN = INC / 256;
            pg8::EpiProj E{PROJ, INC, C_GC, SS, KP};
#if SPLIT_IN
            for (int hf = 0; hf < 2; ++hf) { S.i0 = hf * 5; S.i1 = hf * 5 + 5; pg8::gemm_phase<pg8::EpiProj, pg8::WrapOrder, true>(F.lds + RING_OFF, g, S, E); if (hf == 0) xcd_barrier(bar); }
#else
            pg8::gemm_phase<pg8::EpiProj, pg8::WrapOrder, true>(F.lds + RING_OFF, g, S, E);
#endif
            SEAM(pb + 0);
        }
        if (IN(pb + 1)) {
            phase_attention(F, (char*)lds + RING_OFF, args.in[6], args, l);
            SEAM(pb + 1);
        }
        if (IN(pb + 2)) {
            pg8::Gemm g{UA, WCA, M, DM, 2048, 2048, 2048}; pg8::WrapOrder S; S.init(M, DM * REP_EF, F.G, fresh_bid()); S.wrapN = DM / 256;
            pg8::EpiGateBf16 E{MG, DM, PROJ + C_GC, INC}; pg8::MidGateRatio MH{PROJ + C_GC, INC};
            pg8::gemm_phase<pg8::EpiGateBf16, pg8::WrapOrder, true, pg8::MidGateRatio>(F.lds + RING_OFF, g, S, E, MH);
            SEAMG(pb + 2);
        }
        if (IN(pb + 3)) {
            pg8::Gemm g{MG, WMIX, M, DM, DM, DM, DM}; pg8::WrapOrder S; S.init(M, DM * REP_G, F.G, fresh_bid()); S.wrapN = DM / 256;
            pg8::EpiResBf16 E{XB, XB2, DM, SS};
            pg8::gemm_phase<pg8::EpiResBf16, pg8::WrapOrder, true>(F.lds + RING_OFF, g, S, E);
            SEAMG(pb + 3);
        }
        if (IN(pb + 4)) {
            pg8::Gemm g{XB2, WGU, M, 2 * FF, DM, DM, DM}; pg8::WrapOrder S; S.init(M, 2 * FF * REP_GU, F.G, fresh_bid()); S.wrapN = 2 * FF / 256;
            pg8::EpiSwiGLU E{GU, (long)256 * INC, SS};
            pg8::gemm_phase<pg8::EpiSwiGLU, pg8::WrapOrder, true>(F.lds + RING_OFF, g, S, E);
            SEAMG(pb + 4);
        }
        if (IN(pb + 5)) {
            pg8::Gemm g{GU, WDN, M, DM, FF, 64, FF, 256 * 64 * 2, (long)256 * INC * 2, true, true};       pg8::WrapOrder S; S.init(M, DM * REP_J, F.G, fresh_bid()); S.wrapN = DM / 256;
            pg8::EpiResBf16 E{XB2, XB, DM, SS};
            pg8::gemm_phase<pg8::EpiResBf16, pg8::WrapOrder, true>(F.lds + RING_OFF, g, S, E);
            SEAMG(pb + 5);
        }
    }
    if (IN(1 + DEPTH * PH_PER_LAYER)) phase_final_norm(F, args.in[12], args.out, paneled ? my_pm : -1, my_mi);
#undef IN
#undef SEAM
#undef SEAMG
}

#ifndef MK_PER_PHASE
#define MK_PER_PHASE 0
#endif
extern "C" void kernel_launch(void* const* d_in, const int* in_sizes, int n_in, void* d_out, int out_size, void* d_ws, size_t ws_size, hipStream_t stream) {
    static int grid = 0;
    if (grid == 0) {
        if (n_in != 13 || in_sizes[0] != M * DM || out_size != M * DM || ws_size < WS_END) {
            fprintf(stderr, "kernel_launch: unexpected shapes (n_in %d, in0 %d, out %d, ws %zu); nothing launched\n", n_in, n_in > 0 ? in_sizes[0] : -1, out_size, ws_size); grid = -1; return; }
        int dev = 0, cus = 0;
        if (hipGetDevice(&dev) != hipSuccess || hipDeviceGetAttribute(&cus, hipDeviceAttributeMultiprocessorCount, dev) != hipSuccess) { grid = -1; return; }
        if (hipFuncSetAttribute((const void*)trunk_fwd, hipFuncAttributeMaxDynamicSharedMemorySize, LDS_BYTES) != hipSuccess) { fprintf(stderr, "kernel_launch: hipFuncSetAttribute failed\n"); grid = -1; return; }
        int per_cu = 0;
        if (hipOccupancyMaxActiveBlocksPerMultiprocessor(&per_cu, (const void*)trunk_fwd, NWAVES * 64, LDS_BYTES) != hipSuccess || per_cu < 1)
            fprintf(stderr, "kernel_launch: note: occupancy query reports %d workgroups per CU\n", per_cu);
        (void)hipGetLastError();
        grid = cus;
    }
    if (grid < 0) return;
    if (hipMemsetAsync((char*)d_ws + WS_CTL, 0, CTL_ZERO_BYTES, stream) != hipSuccess) { fprintf(stderr, "kernel_launch: hipMemsetAsync failed\n"); return; }
    Args a{};
    for (int i = 0; i < 13; ++i) a.in[i] = (const float*)d_in[i];
    a.out = (float*)d_out; a.ws = (unsigned char*)d_ws;
#if MK_PER_PHASE
    for (int p = 0; p < N_PHASES; ++p) { a.ph_lo = p; a.ph_hi = p + 1; hipLaunchKernelGGL(trunk_fwd, dim3(grid), dim3(NWAVES * 64), LDS_BYTES, stream, a); }
#else
    a.ph_lo = 0; a.ph_hi = N_PHASES;
    hipLaunchKernelGGL(trunk_fwd, dim3(grid), dim3(NWAVES * 64), LDS_BYTES, stream, a);
#endif
    const hipError_t le = hipPeekAtLastError();
    if (le != hipSuccess) fprintf(stderr, "kernel_launch: launch failed: %s\n", hipGetErrorName(le));
}
```

```cpp
#include <hip/hip_runtime.h>
#include <cstdio>
#include <cstdint>

#ifndef REP_ATT
#define REP_ATT 1
#endif
#ifndef REP_BIG
#define REP_BIG 1
#endif
#ifndef REP_IN
#define REP_IN 1
#endif
#ifndef REP_GU
#define REP_GU 1
#endif
#ifndef REP_EF
#define REP_EF 1
#endif
#ifndef REP_G
#define REP_G 1
#endif
#ifndef REP_J
#define REP_J 1
#endif
#ifndef SPLIT_IN
#define SPLIT_IN 0
#endif
#ifndef REP_MISC
#define REP_MISC 1
#endif
constexpr int BATCH = 4, SEQ = 4096, DM = 2048, DEPTH = 4, CCH = 1024, AW = 1024, NH = 8, HD = 128, FF = 5632, INC = 10240;
constexpr int M = BATCH * SEQ;
constexpr int C_H = 0, C_B = 1024, C_C = 2048, C_Q = 3072, C_K = 4096, C_V = 5120, C_GC = 6144, C_GA = 8192;
constexpr float RMS_EPS = 1e-6f;
constexpr int NWAVES = 8;

#define GAS __attribute__((address_space(1)))
#define LAS __attribute__((address_space(3)))
typedef unsigned short bf16;
typedef unsigned v4u __attribute__((ext_vector_type(4)));
typedef float f32x4 __attribute__((ext_vector_type(4)));
typedef float f32x2 __attribute__((ext_vector_type(2)));
typedef float f32x16 __attribute__((ext_vector_type(16)));
typedef short bf16x8 __attribute__((ext_vector_type(8)));
typedef short s16x4 __attribute__((ext_vector_type(4)));
typedef unsigned u32x4 __attribute__((ext_vector_type(4)));
typedef unsigned u32x2 __attribute__((ext_vector_type(2)));
typedef GAS unsigned gu32;
#define RLX_AGENT __ATOMIC_RELAXED, __HIP_MEMORY_SCOPE_AGENT
#define LDS_WAIT() asm volatile("s_waitcnt lgkmcnt(0)" ::: "memory")
#define VM_WAIT() asm volatile("s_waitcnt vmcnt(0)" ::: "memory")

__device__ __forceinline__ int fresh_tid() { int t = threadIdx.x; asm volatile("" : "+v"(t)); return t; }
__device__ __forceinline__ int fresh_bid() { int b = blockIdx.x; asm volatile("" : "+s"(b)); return b; }
__device__ __forceinline__ unsigned cvt_pk_bf16(float lo, float hi) { unsigned r; asm volatile("v_cvt_pk_bf16_f32 %0, %1, %2" : "=v"(r) : "v"(lo), "v"(hi)); return r; }
__device__ __forceinline__ float bf_lo(unsigned w) { return __uint_as_float(w << 16); }
__device__ __forceinline__ float bf_hi(unsigned w) { return __uint_as_float(w & 0xffff0000u); }
__device__ __forceinline__ unsigned q8(float s) { return (unsigned)(s * 255.0f + 0.5f); }
__device__ __forceinline__ unsigned pack4(unsigned a, unsigned b, unsigned c, unsigned d) { return a | (b << 8) | (c << 16) | (d << 24); }
__device__ __forceinline__ float ub0(unsigned w) { return (float)(w & 0xffu); }
__device__ __forceinline__ float ub1(unsigned w) { return (float)((w >> 8) & 0xffu); }
__device__ __forceinline__ float ub2(unsigned w) { return (float)((w >> 16) & 0xffu); }
__device__ __forceinline__ float ub3(unsigned w) { return (float)(w >> 24); }
__device__ __forceinline__ float fast_sigmoid(float x) { return __builtin_amdgcn_rcpf(1.0f + __builtin_amdgcn_exp2f(-1.4426950408889634f * x)); }

constexpr int LDS_RB_OFF = 132096, LDS_RB_BYTES = 8192;
constexpr int LDS_XT_OFF = LDS_RB_OFF + 2 * LDS_RB_BYTES;
constexpr int LDS_TOTAL = 163840;
static_assert(LDS_XT_OFF + 4096 <= LDS_TOTAL, "LDS map");
namespace pg8 {
constexpr int BM = 256, BK = 64, HALF = 128, HTB = HALF * BK * 2  , STAGE_BYTES = 8 * HTB, NXCD = 8, WGM = 8;

__host__ __device__ __forceinline__ int lds_byte(int r, int c) { const int st = (r >> 4) * 2 + (c >> 5), rr = r & 15, cc = c & 31, ob = rr * 64 + cc * 2; return st * 1024 + (ob ^ (((ob >> 9) & 1) << 5)); }
__host__ __device__ __forceinline__ void stage_rc(int b, int& R, int& C) { const int st = b / 1024, sb = b % 1024, swz = sb ^ (((sb >> 9) & 1) << 5); R = (st >> 1) * 16 + swz / 64; C = (st & 1) * 32 + (swz % 64) / 2; }
__host__ __device__ __forceinline__ int perm32(int rho) { const int n = rho >> 4, i = rho & 15; return 8 * (i >> 2) + 4 * n + (i & 3); }

struct Unit { int pm, pn; };
struct Gemm { const bf16* A; const bf16* Bt; int M, N, K, lda, ldb; int kstepA = 0; long tstepA = 0; bool snake = false; bool splitA = false; };

struct StaticOrder {
    int nM, nN, nwg, G, c;
    __host__ __device__ void init(int M_, int N_, int G_, int c_) { nM = M_ / BM; nN = N_ / BM; nwg = nM * nN; G = G_; c = c_; }
    __host__ __device__ bool next(int i, Unit& u) const {
        const long L = (long)i * G + c; if (L >= nwg) return false;
        int wgid = (int)L; { const int q = nwg / NXCD, r = nwg % NXCD, xcd = wgid % NXCD, off = wgid / NXCD; wgid = (xcd < r ? xcd * (q + 1) : r * (q + 1) + (xcd - r) * q) + off; }
        const int nig = WGM * nN, gid = wgid / nig, fm = gid * WGM, gsz = (nM - fm) < WGM ? (nM - fm) : WGM;
        u.pm = fm + ((wgid % nig) % gsz); u.pn = (wgid % nig) / gsz; return true;
    }
};

struct WrapOrder : StaticOrder { int wrapN; int i0 = 0, i1 = 1 << 30;
    __host__ __device__ bool next(int i, Unit& u) const { if (i + i0 >= i1) return false; if (!StaticOrder::next(i + i0, u)) return false; u.pn %= wrapN; return true; } };

__device__ __forceinline__ void rs_prefetch(LAS unsigned char* lds, const float* SS8, const Unit& u, int ui, int wid, int lane) {
    const float* src = SS8 + ((size_t)u.pm * BM + 32 * wid) * 8 + lane * 4;
    __builtin_amdgcn_global_load_lds((const unsigned*)src, (LAS unsigned*)(lds + LDS_RB_OFF + (ui & 1) * LDS_RB_BYTES + wid * 1024), 16, 0, 0);
}
__device__ __forceinline__ void row_scales(LAS unsigned char* lds, int ui, int wr, int fr, float (&rs)[2][4]) {
    const LAS f32x4* rb = (const LAS f32x4*)(lds + LDS_RB_OFF + (ui & 1) * LDS_RB_BYTES);
#pragma unroll
    for (int ai = 0; ai < 2; ++ai)
#pragma unroll
        for (int m = 0; m < 4; ++m) { const int r = ai * HALF + wr * 64 + m * 16 + fr; const f32x4 x = rb[2 * r], y = rb[2 * r + 1];
            const float s = ((x[0] + x[1]) + (x[2] + x[3])) + ((y[0] + y[1]) + (y[2] + y[3]));
            rs[ai][m] = __builtin_amdgcn_rsqf(s * (1.0f / DM) + RMS_EPS); }
}
__device__ __forceinline__ float row_scale1(LAS unsigned char* lds, int ui, int r) {
    const LAS f32x4* rb = (const LAS f32x4*)(lds + LDS_RB_OFF + (ui & 1) * LDS_RB_BYTES);
    const f32x4 x = rb[2 * r], y = rb[2 * r + 1];
    return __builtin_amdgcn_rsqf((((x[0] + x[1]) + (x[2] + x[3])) + ((y[0] + y[1]) + (y[2] + y[3]))) * (1.0f / DM) + RMS_EPS);
}
struct RsPipe { f32x4 x, y;
    __device__ __forceinline__ void load(LAS unsigned char* lds, int ui, int r) { const LAS f32x4* rb = (const LAS f32x4*)(lds + LDS_RB_OFF + (ui & 1) * LDS_RB_BYTES); x = rb[2 * r]; y = rb[2 * r + 1]; }
    __device__ __forceinline__ float msq() const { return (((x[0] + x[1]) + (x[2] + x[3])) + ((y[0] + y[1]) + (y[2] + y[3]))) * (1.0f / DM) + RMS_EPS; }
};
#define RS_PIPE_BEGIN() RsPipe rs_nxt; rs_nxt.load(lds, ui, rl0)
#define RS_PIPE_STEP(cur_) const RsPipe cur_ = rs_nxt; { const int gn_ = ai * 4 + m + 1; if (gn_ < 8) rs_nxt.load(lds, ui, rl0 + (gn_ >> 2) * HALF + (gn_ & 3) * 16); } __builtin_amdgcn_sched_barrier(0)
struct EpiProj {
    static constexpr bool PERM = true, PREFETCH = true;
    bf16* O; int ldc; int sig_from; const float* SS; float* KP;
    __device__ __forceinline__ void prefetch(LAS unsigned char* lds, const Unit& u, int ui, int wid, int lane) const { rs_prefetch(lds, SS, u, ui, wid, lane); }
    __device__ __forceinline__ void operator()(const f32x4 (&acc)[2][2][4][2], const Unit& u, int wr, int wc, int fr, int fq, LAS unsigned char* lds, int ui) const {
        int row0 = u.pm * BM + wr * 64 + fr; const int colt = u.pn * BM;
        const bool sig = colt >= sig_from; const bool isk = colt >= C_K && colt < C_V; const bool isch = colt < C_B || (colt >= C_C && colt < C_Q);
        int col0 = colt + wc * 32 + 8 * fq;
        asm volatile("" : "+v"(row0), "+v"(col0));
        const int rl0 = wr * 64 + fr;
        RS_PIPE_BEGIN();
        if (sig) {
            const int gc0 = ((colt - sig_from) >> 1) + wc * 32 + 8 * fq;
#pragma unroll
            for (int ai = 0; ai < 2; ++ai)
#pragma unroll
                for (int m = 0; m < 4; ++m) { RS_PIPE_STEP(rsc); bf16* rowp = O + (size_t)(row0 + ai * HALF + m * 16) * ldc + gc0; const float k1 = -1.4426950408889634f * __builtin_amdgcn_rsqf(rsc.msq());
                    unsigned qc[8], qa[8];
#define SG8(A_) ((unsigned)(__builtin_amdgcn_rcpf(__builtin_fmaf(__builtin_amdgcn_exp2f((A_) * k1), 1.0f / 255.0f, 1.0f / 255.0f)) + 0.5f))
#pragma unroll
                    for (int e = 0; e < 4; ++e) { qc[e] = SG8(acc[ai][0][m][0][e]); qc[4 + e] = SG8(acc[ai][0][m][1][e]);
                        const unsigned a0 = SG8(acc[ai][1][m][0][e]), a1 = SG8(acc[ai][1][m][1][e]);
                        qa[e] = a0 < 1u ? 1u : a0; qa[4 + e] = a1 < 1u ? 1u : a1; }
                    u32x4 w; w.x = pack4(qc[0], qc[1], qc[2], qc[3]); w.y = pack4(qc[4], qc[5], qc[6], qc[7]); w.z = pack4(qa[0], qa[1], qa[2], qa[3]); w.w = pack4(qa[4], qa[5], qa[6], qa[7]);
                    *(u32x4*)(rowp + C_GC) = w; }
#undef SG8
            return;
        }
        if (isch) {
            const int pk = u.pn < 4 ? u.pn : u.pn - 4, cc0 = 128 * pk + wc * 32 + 8 * fq;
#pragma unroll
            for (int ai = 0; ai < 2; ++ai)
#pragma unroll
                for (int m = 0; m < 4; ++m) { RS_PIPE_STEP(rsc); const float r2 = __builtin_amdgcn_rcpf(rsc.msq());
                    const f32x4 p0 = acc[ai][0][m][0] * acc[ai][1][m][0] * r2, p1 = acc[ai][0][m][1] * acc[ai][1][m][1] * r2;
                    u32x4 w; w.x = cvt_pk_bf16(p0[0], p0[1]); w.y = cvt_pk_bf16(p0[2], p0[3]); w.z = cvt_pk_bf16(p1[0], p1[1]); w.w = cvt_pk_bf16(p1[2], p1[3]);
                    *(u32x4*)(O + (size_t)(row0 + ai * HALF + m * 16) * ldc + C_H + cc0) = w; }
            return;
        }
#pragma unroll
        for (int ai = 0; ai < 2; ++ai)
#pragma unroll
            for (int m = 0; m < 4; ++m) { RS_PIPE_STEP(rsc); bf16* rowp = O + (size_t)(row0 + ai * HALF + m * 16) * ldc + col0; const float rsv = __builtin_amdgcn_rsqf(rsc.msq());
#pragma unroll
                for (int bj = 0; bj < 2; ++bj) { f32x4 v0 = acc[ai][bj][m][0] * rsv, v1 = acc[ai][bj][m][1] * rsv;
                    u32x4 w; w.x = cvt_pk_bf16(v0[0], v0[1]); w.y = cvt_pk_bf16(v0[2], v0[3]); w.z = cvt_pk_bf16(v1[0], v1[1]); w.w = cvt_pk_bf16(v1[2], v1[3]);
                    *(u32x4*)(rowp + bj * HALF) = w; }
                __builtin_amdgcn_sched_barrier(0); }
        if (isk) {
            f32x4 cs[2][2];
#pragma unroll
            for (int bj = 0; bj < 2; ++bj)
#pragma unroll
                for (int n = 0; n < 2; ++n) { f32x4 t = (f32x4){0.f, 0.f, 0.f, 0.f};
#pragma unroll
                    for (int ai = 0; ai < 2; ++ai)
#pragma unroll
                        for (int m = 0; m < 4; ++m) t += acc[ai][bj][m][n] * row_scale1(lds, ui, rl0 + ai * HALF + m * 16);
                    cs[bj][n] = t; }
#pragma unroll
            for (int bj = 0; bj < 2; ++bj)
#pragma unroll
                for (int n = 0; n < 2; ++n)
#pragma unroll
                    for (int e = 0; e < 4; ++e) { float x = cs[bj][n][e]; x += __shfl_xor(x, 1); x += __shfl_xor(x, 2); x += __shfl_xor(x, 4); x += __shfl_xor(x, 8); cs[bj][n][e] = x; }
            if (fr == 0) { float* kp = KP + (size_t)(u.pm * 2 + wr) * 1024 + (colt - C_K) + wc * 32 + 8 * fq;
#pragma unroll
                for (int bj = 0; bj < 2; ++bj) { *(f32x4*)(kp + bj * HALF) = cs[bj][0]; *(f32x4*)(kp + bj * HALF + 4) = cs[bj][1]; } }
        }
    }
};
struct MidGateRatio {
    static constexpr bool ENABLED = true;
    const bf16* R; int ldg;
    __device__ __forceinline__ void operator()(f32x4 (&acc)[2][2][4][2], const Unit& u, int wr, int wc, int fr, int fq) const {
        int row0 = u.pm * BM + wr * 64 + fr; int col0 = u.pn * BM + wc * 32 + 8 * fq;
        asm volatile("" : "+v"(row0), "+v"(col0));
        const char* base = (const char*)R + ((size_t)row0 * ldg + col0) * 2;
        const size_t rstep = (size_t)ldg * 32;
        u32x4 rr[2][4][2];
#pragma unroll
        for (int ai = 0; ai < 2; ++ai)
#pragma unroll
            for (int m = 0; m < 4; ++m) { const char* p = base + (size_t)(ai * 8 + m) * rstep;
#pragma unroll
                for (int bj = 0; bj < 2; ++bj) rr[ai][m][bj] = *(const u32x4*)(p + bj * 256); }
        __builtin_amdgcn_sched_barrier(0);
#pragma unroll
        for (int ai = 0; ai < 2; ++ai)
#pragma unroll
            for (int m = 0; m < 4; ++m)
#pragma unroll
                for (int bj = 0; bj < 2; ++bj) { const u32x4 c = rr[ai][m][bj];
                    acc[ai][bj][m][0] *= (f32x4){ub0(c.x) * __builtin_amdgcn_rcpf(ub0(c.z)), ub1(c.x) * __builtin_amdgcn_rcpf(ub1(c.z)), ub2(c.x) * __builtin_amdgcn_rcpf(ub2(c.z)), ub3(c.x) * __builtin_amdgcn_rcpf(ub3(c.z))};
                    acc[ai][bj][m][1] *= (f32x4){ub0(c.y) * __builtin_amdgcn_rcpf(ub0(c.w)), ub1(c.y) * __builtin_amdgcn_rcpf(ub1(c.w)), ub2(c.y) * __builtin_amdgcn_rcpf(ub2(c.w)), ub3(c.y) * __builtin_amdgcn_rcpf(ub3(c.w))}; }
        __builtin_amdgcn_sched_barrier(0);
    }
};
struct EpiGateBf16 {
    static constexpr bool PERM = true, PREFETCH = false;
    bf16* O; int ldc; const bf16* G; int ldg;
    __device__ __forceinline__ void operator()(const f32x4 (&acc)[2][2][4][2], const Unit& u, int wr, int wc, int fr, int fq, LAS unsigned char* lds, int ui) const {
        const int row0 = u.pm * BM + wr * 64 + fr; const int col0 = u.pn * BM + wc * 32 + 8 * fq;
        u32x2 gg[2][4][2];
#pragma unroll
        for (int ai = 0; ai < 2; ++ai)
#pragma unroll
            for (int m = 0; m < 4; ++m)
#pragma unroll
                for (int bj = 0; bj < 2; ++bj) gg[ai][m][bj] = *(const u32x2*)((const char*)(G + (size_t)(row0 + ai * HALF + m * 16) * ldg + col0 + bj * HALF) + 8);
        __builtin_amdgcn_sched_barrier(0);
        const float k = 1.0f / 255.0f;
#pragma unroll
        for (int ai = 0; ai < 2; ++ai)
#pragma unroll
            for (int m = 0; m < 4; ++m) { const size_t r = (size_t)(row0 + ai * HALF + m * 16);
#pragma unroll
                for (int bj = 0; bj < 2; ++bj) { const u32x2 g = gg[ai][m][bj];
                    f32x4 v0 = acc[ai][bj][m][0] * k, v1 = acc[ai][bj][m][1] * k;
                    v0[0] *= ub0(g.x); v0[1] *= ub1(g.x); v0[2] *= ub2(g.x); v0[3] *= ub3(g.x);
                    v1[0] *= ub0(g.y); v1[1] *= ub1(g.y); v1[2] *= ub2(g.y); v1[3] *= ub3(g.y);
                    u32x4 w; w.x = cvt_pk_bf16(v0[0], v0[1]); w.y = cvt_pk_bf16(v0[2], v0[3]); w.z = cvt_pk_bf16(v1[0], v1[1]); w.w = cvt_pk_bf16(v1[2], v1[3]);
                    *(u32x4*)(O + r * ldc + col0 + bj * HALF) = w; } }
    }
};
struct EpiResBf16 {
    static constexpr bool PERM = true, PREFETCH = false;
    const bf16* X; bf16* XO; int ldc; float* SS;
    __device__ __forceinline__ void operator()(const f32x4 (&acc)[2][2][4][2], const Unit& u, int wr, int wc, int fr, int fq, LAS unsigned char* lds, int ui) const {
        const int row0 = u.pm * BM + wr * 64 + fr; const int col0 = u.pn * BM + wc * 32 + 8 * fq;
        LAS float* XT = (LAS float*)(lds + LDS_XT_OFF);
        u32x4 xx[2][4][2];
#pragma unroll
        for (int ai = 0; ai < 2; ++ai)
#pragma unroll
            for (int m = 0; m < 4; ++m)
#pragma unroll
                for (int bj = 0; bj < 2; ++bj) xx[ai][m][bj] = *(const u32x4*)(X + (size_t)(row0 + ai * HALF + m * 16) * ldc + col0 + bj * HALF);
        __builtin_amdgcn_sched_barrier(0);
#pragma unroll
        for (int ai = 0; ai < 2; ++ai)
#pragma unroll
            for (int m = 0; m < 4; ++m) { const size_t r = (size_t)(row0 + ai * HALF + m * 16); float ss = 0.f;
#pragma unroll
                for (int bj = 0; bj < 2; ++bj) { bf16* xp = XO + r * ldc + col0 + bj * HALF; const u32x4 xo = xx[ai][m][bj];
                    f32x4 v0 = acc[ai][bj][m][0], v1 = acc[ai][bj][m][1];
                    v0[0] += bf_lo(xo.x); v0[1] += bf_hi(xo.x); v0[2] += bf_lo(xo.y); v0[3] += bf_hi(xo.y);
                    v1[0] += bf_lo(xo.z); v1[1] += bf_hi(xo.z); v1[2] += bf_lo(xo.w); v1[3] += bf_hi(xo.w);
                    ss += ((v0[0] * v0[0] + v0[1] * v0[1]) + (v0[2] * v0[2] + v0[3] * v0[3])) + ((v1[0] * v1[0] + v1[1] * v1[1]) + (v1[2] * v1[2] + v1[3] * v1[3]));
                    u32x4 w; w.x = cvt_pk_bf16(v0[0], v0[1]); w.y = cvt_pk_bf16(v0[2], v0[3]); w.z = cvt_pk_bf16(v1[0], v1[1]); w.w = cvt_pk_bf16(v1[2], v1[3]);
                    *(u32x4*)xp = w; }
                ss += __shfl_xor(ss, 16); ss += __shfl_xor(ss, 32);
                if (fq == 0) XT[(ai * HALF + wr * 64 + m * 16 + fr) * 4 + wc] = ss; }
        asm volatile("s_waitcnt lgkmcnt(0)" ::: "memory"); __builtin_amdgcn_s_barrier(); asm volatile("" ::: "memory");
        const int t = fresh_tid();
        if (t < 256) { const f32x4 p = *(const LAS f32x4*)(XT + t * 4); SS[((size_t)u.pm * BM + t) * 8 + u.pn] = (p[0] + p[1]) + (p[2] + p[3]); }
        asm volatile("s_waitcnt lgkmcnt(0)" ::: "memory");
    }
};
struct EpiSwiGLU {
    static constexpr bool PERM = true, PREFETCH = true;
    bf16* O; long pstep; const float* SS;
    __device__ __forceinline__ void prefetch(LAS unsigned char* lds, const Unit& u, int ui, int wid, int lane) const { rs_prefetch(lds, SS, u, ui, wid, lane); }
    __device__ __forceinline__ void operator()(const f32x4 (&acc)[2][2][4][2], const Unit& u, int wr, int wc, int fr, int fq, LAS unsigned char* lds, int ui) const {
        bf16* tbase = O + (size_t)u.pm * pstep + ((size_t)(u.pn * 4 + wc) * BM + wr * 64 + fr) * 32 + 8 * fq;
        const int rl0 = wr * 64 + fr;
        RS_PIPE_BEGIN();
#pragma unroll
        for (int ai = 0; ai < 2; ++ai)
#pragma unroll
            for (int m = 0; m < 4; ++m) { RS_PIPE_STEP(rsc); bf16* rowp = tbase + (ai * HALF + m * 16) * 32;
                const float irs2 = rsc.msq();
                const float k1 = -1.4426950408889634f * __builtin_amdgcn_rsqf(irs2);
                f32x4 v0, v1;
#pragma unroll
                for (int e = 0; e < 4; ++e) { const float a0 = acc[ai][0][m][0][e], a1 = acc[ai][0][m][1][e];
                    const float d0 = __builtin_fmaf(__builtin_amdgcn_exp2f(a0 * k1), irs2, irs2), d1 = __builtin_fmaf(__builtin_amdgcn_exp2f(a1 * k1), irs2, irs2);
                    v0[e] = (a0 * acc[ai][1][m][0][e]) * __builtin_amdgcn_rcpf(d0); v1[e] = (a1 * acc[ai][1][m][1][e]) * __builtin_amdgcn_rcpf(d1); }
                u32x4 w; w.x = cvt_pk_bf16(v0[0], v0[1]); w.y = cvt_pk_bf16(v0[2], v0[3]); w.z = cvt_pk_bf16(v1[0], v1[1]); w.w = cvt_pk_bf16(v1[2], v1[3]);
                *(u32x4*)rowp = w; }
    }
};

struct NoMid { static constexpr bool ENABLED = false; __device__ __forceinline__ void operator()(f32x4 (&)[2][2][4][2], const Unit&, int, int, int, int) const {} };
template <class Epi, class Sched, bool ALIGN_EPI, class Mid = NoMid>
__device__ __forceinline__ void gemm_phase(LAS unsigned char* lds, const Gemm g, const Sched& S, const Epi& E, const Mid& MH = Mid()) {
    int tid = fresh_tid(); const int wid = __builtin_amdgcn_readfirstlane(tid >> 6); int lane = tid & 63; const int wr = wid >> 2, wc = wid & 3; int fr = lane & 15, fq = lane >> 4;
    const int K = g.K, nt = K / BK;
    unsigned voffA[2], voffB[2]; int aoff, boff;
#define PG8_LANE_CONSTS() do { _Pragma("unroll") for (int i_ = 0; i_ < 2; ++i_) { int R_, C_; stage_rc(tid * 16 + i_ * 8192, R_, C_); const int Rb_ = Epi::PERM ? ((R_ & ~31) + perm32(R_ & 31)) : R_; \
        voffA[i_] = g.splitA ? (unsigned)((C_ >> 5) * 256 * 32 + R_ * 32 + (C_ & 31)) * 2u : (unsigned)(R_ * g.lda + C_) * 2u; voffB[i_] = (unsigned)(Rb_ * g.ldb + C_) * 2u; } \
        aoff = lds_byte(wr * 64 + fr, fq * 8); boff = lds_byte(wc * 32 + fr, fq * 8); } while (0)
    PG8_LANE_CONSTS();
    const size_t kstep = (size_t)(BK * 2);
    const size_t kstepA = g.kstepA ? (size_t)g.kstepA : kstep;
    const size_t hstepA = g.splitA ? (size_t)HALF * 32 * 2 : (size_t)HALF * g.lda * 2, hstepB = (size_t)HALF * g.ldb * 2;
    const size_t tstepA = g.tstepA ? (size_t)g.tstepA : 2 * hstepA, tstepB = 2 * hstepB;
    const unsigned ldsw = (unsigned)wid * 1024u;
#define PG8_SA(b, h) (((b) * 2 + (h)) * HTB)
#define PG8_SB(b, h) ((4 + (b) * 2 + (h)) * HTB)
#define PG8_STAGE(bufoff, gbase, voff) do { _Pragma("unroll") for (int _i = 0; _i < 2; ++_i) \
        __builtin_amdgcn_global_load_lds((const unsigned*)((const char*)(gbase) + (voff)[_i]), (LAS unsigned*)(lds + (bufoff) + ldsw + _i * 8192), 16, 0, 0); } while (0)
#define PG8_LDA(dst, b, h) do { _Pragma("unroll") for (int m = 0; m < 4; ++m) _Pragma("unroll") for (int k = 0; k < 2; ++k) dst[m][k] = *(const LAS bf16x8*)(lds + PG8_SA(b, h) + aoff + m * 2048 + k * 1024); } while (0)
#define PG8_LDB(dst, b, h) do { _Pragma("unroll") for (int n = 0; n < 2; ++n) _Pragma("unroll") for (int k = 0; k < 2; ++k) dst[n][k] = *(const LAS bf16x8*)(lds + PG8_SB(b, h) + boff + n * 2048 + k * 1024); } while (0)
#define PG8_MMA(ai, bj, At, Bt) do { __builtin_amdgcn_s_setprio(1); _Pragma("unroll") for (int m = 0; m < 4; ++m) _Pragma("unroll") for (int n = 0; n < 2; ++n) _Pragma("unroll") for (int k = 0; k < 2; ++k) \
        acc[ai][bj][m][n] = __builtin_amdgcn_mfma_f32_16x16x32_bf16(Bt[n][k], At[m][k], acc[ai][bj][m][n], 0, 0, 0); __builtin_amdgcn_s_setprio(0); } while (0)
#define PG8_WAIT_V(n) asm volatile("s_waitcnt vmcnt(" #n ")" ::: "memory")
#define PG8_WAIT_L(n) asm volatile("s_waitcnt lgkmcnt(" #n ")" ::: "memory")
#define PG8_BAR __builtin_amdgcn_s_barrier()
#define PG8_SCHED __builtin_amdgcn_sched_barrier(0)
    Unit cur, nxt; int ui = 0;
    if (!S.next(0, cur)) return;
    const bool snake = g.snake;
    const size_t spanA = (size_t)(nt - 1) * kstepA, spanB = (size_t)(nt - 1) * kstep;
    long sA = snake ? -(long)kstepA : (long)kstepA, sB = snake ? -(long)kstep : (long)kstep;
    f32x4 acc[2][2][4][2];
#pragma unroll
    for (int a = 0; a < 2; ++a)
#pragma unroll
        for (int b = 0; b < 2; ++b)
#pragma unroll
            for (int m = 0; m < 4; ++m)
#pragma unroll
                for (int n = 0; n < 2; ++n) acc[a][b][m][n] = (f32x4){0.f, 0.f, 0.f, 0.f};
    bf16x8 At[4][2], B0[2][2], B1[2][2];
    const char* cA = (const char*)g.A + (size_t)cur.pm * tstepA + (snake ? spanA : 0); const char* cB = (const char*)g.Bt + (size_t)cur.pn * tstepB + (snake ? spanB : 0);
    if constexpr (Epi::PREFETCH) E.prefetch(lds, cur, 0, wid, lane);
    PG8_STAGE(PG8_SB(0, 0), cB, voffB); PG8_STAGE(PG8_SB(0, 1), cB + hstepB, voffB); PG8_STAGE(PG8_SA(0, 0), cA, voffA); PG8_STAGE(PG8_SA(0, 1), cA + hstepA, voffA);
    if (wr == 1) PG8_BAR;
    PG8_WAIT_V(2); PG8_BAR;
    PG8_STAGE(PG8_SB(1, 0), cB + sB, voffB); PG8_STAGE(PG8_SA(1, 0), cA + sA, voffA); PG8_STAGE(PG8_SB(1, 1), cB + hstepB + sB, voffB);
    PG8_WAIT_V(6); PG8_BAR;
    for (;;) {
        if (ui > 0) { tid = fresh_tid(); lane = tid & 63; fr = lane & 15; fq = lane >> 4; PG8_LANE_CONSTS(); }
        const bool has_next = S.next(ui + 1, nxt);
        const long nsA = has_next ? (snake ? -sA : sA) : 0, nsB = has_next ? (snake ? -sB : sB) : 0;
        const char* nA = has_next ? (const char*)g.A + (size_t)nxt.pm * tstepA + (nsA < 0 ? spanA : 0) : cA; const char* nB = has_next ? (const char*)g.Bt + (size_t)nxt.pn * tstepB + (nsB < 0 ? spanB : 0) : cB;
        for (int t = 0; t < nt; t += 2) {
            if constexpr (Mid::ENABLED) { if (t == (nt >> 1)) MH(acc, cur, wr, wc, fr, fq); }
            const bool last = (t == nt - 2);
            const char* a1 = cA + (long)(t + 1) * sA;
            const char* a2 = last ? nA : cA + (long)(t + 2) * sA; const char* b2 = last ? nB : cB + (long)(t + 2) * sB;
            const char* a3 = a2 + (last ? nsA : sA); const char* b3 = b2 + (last ? nsB : sB);
            PG8_LDB(B0, 0, 0); PG8_LDB(B1, 0, 1); PG8_SCHED; PG8_LDA(At, 0, 0); PG8_STAGE(PG8_SA(1, 1), a1 + hstepA, voffA);
            PG8_WAIT_V(8); PG8_WAIT_L(0); PG8_BAR; PG8_MMA(0, 0, At, B0); PG8_MMA(0, 1, At, B1); PG8_BAR; PG8_SCHED;
            PG8_LDA(At, 0, 1); PG8_STAGE(PG8_SB(0, 0), b2, voffB); PG8_STAGE(PG8_SB(0, 1), b2 + hstepB, voffB); PG8_STAGE(PG8_SA(0, 0), a2, voffA);
            PG8_WAIT_V(8); PG8_WAIT_L(0); PG8_BAR; PG8_MMA(1, 0, At, B0); PG8_MMA(1, 1, At, B1); PG8_BAR; PG8_SCHED;
            PG8_LDB(B0, 1, 0); PG8_LDB(B1, 1, 1); PG8_SCHED; PG8_LDA(At, 1, 0); PG8_STAGE(PG8_SA(0, 1), a2 + hstepA, voffA);
            PG8_WAIT_V(8); PG8_WAIT_L(0); PG8_BAR; PG8_MMA(0, 0, At, B0); PG8_MMA(0, 1, At, B1); PG8_BAR; PG8_SCHED;
            PG8_LDA(At, 1, 1); PG8_STAGE(PG8_SB(1, 0), b3, voffB); PG8_STAGE(PG8_SB(1, 1), b3 + hstepB, voffB); PG8_STAGE(PG8_SA(1, 0), a3, voffA);
            PG8_WAIT_V(8); PG8_WAIT_L(0); PG8_BAR; PG8_MMA(1, 0, At, B0); PG8_MMA(1, 1, At, B1); PG8_BAR; PG8_SCHED;
        }
        if constexpr (ALIGN_EPI) { if (wr == 0) PG8_BAR; }
        E(acc, cur, wr, wc, fr, fq, lds, ui);
        if (!has_next) break;
#pragma unroll
        for (int a = 0; a < 2; ++a)
#pragma unroll
            for (int b = 0; b < 2; ++b)
#pragma unroll
                for (int m = 0; m < 4; ++m)
#pragma unroll
                    for (int n = 0; n < 2; ++n) acc[a][b][m][n] = (f32x4){0.f, 0.f, 0.f, 0.f};
        cur = nxt; cA = nA; cB = nB; sA = nsA; sB = nsB; ++ui;
        if constexpr (Epi::PREFETCH) E.prefetch(lds, cur, ui, wid, lane);
        if constexpr (ALIGN_EPI) { if (wr == 1) PG8_BAR; }
    }
    PG8_WAIT_V(0);
    if constexpr (!ALIGN_EPI) { if (wr == 0) PG8_BAR; }
    PG8_BAR;
#undef PG8_LANE_CONSTS
#undef PG8_SA
#undef PG8_SB
#undef PG8_STAGE
#undef PG8_LDA
#undef PG8_LDB
#undef PG8_MMA
#undef PG8_WAIT_V
#undef PG8_WAIT_L
#undef PG8_BAR
#undef PG8_SCHED
}
}

namespace att {
constexpr int D = 128, NW = 8, QBLK = 32, KVBLK = 64, QB = NW * QBLK;
constexpr int PQ = INC;
constexpr int PO = 2048;
constexpr int SHM_V = KVBLK * D * 2, SHM_K = KVBLK * D * 2;
constexpr int LDS_WS = 2 * SHM_V + 2 * SHM_K;
constexpr int LDS_KM = LDS_WS + NW * 64 * 4;
constexpr int LDS_LUT = LDS_KM + 16 * 128 * 4;
constexpr int LDS_BYTES = LDS_LUT + 128 * 4;
constexpr float SCALE = 0.08838834764831845f;
constexpr float THR = 8.f;

#define KSWZ(row, colB) ((row) * 256 + ((colB) ^ (((row) & 15) << 4)))
#define SBAR() __builtin_amdgcn_sched_barrier(0)
__device__ __forceinline__ int v_st(int k, int c) { const int kk = (k & ~0xC) | ((k & 4) << 1) | ((k & 8) >> 1); return ((kk >> 3) * 4 + (c >> 5)) * 512 + ((kk & 7) * 32 + (c & 31)) * 2; }
__device__ __forceinline__ int v_rd_base(int lane) { return ((lane & 3) << 3) | (((lane >> 2) & 3) << 6) | (((lane >> 4) & 1) << 5) | (((lane >> 5) & 1) << 8); }
constexpr int v_rd_off(int d0, int ks, int half) { return d0 * 512 + ks * 4096 + half * 2048; }
__device__ __forceinline__ int crow(int r, int hi) { return (r & 3) + 8 * (r >> 2) + 4 * hi; }
__device__ __forceinline__ unsigned cvtpk(float lo, float hi) { unsigned r; asm volatile("v_cvt_pk_bf16_f32 %0, %1, %2" : "=v"(r) : "v"(lo), "v"(hi)); return r; }
__device__ __forceinline__ bf16x8 load8(const bf16* p) { return *reinterpret_cast<const bf16x8*>(p); }

__device__ __forceinline__ bool moba_mask(f32x16& p0, f32x16& p1, int kb, int ib, int qm, unsigned selmask, const float* LUT, int qlo) {
    const float NEG = -__builtin_inff();
    const int jb = kb >> 8;
    if (kb + 63 + 113 <= qlo) {
        return jb != ib && ((selmask >> jb) & 1u) == 0u;
    } else {
        const bool ok = (jb == ib) || ((selmask >> jb) & 1u);
        const int dq = qm - kb;
#pragma unroll
        for (int g = 0; g < 4; ++g) {
#pragma unroll
            for (int e = 0; e < 4; ++e) { const int r = 4 * g + e;
                const int c = (r & 3) + 8 * (r >> 2);
                const int d0 = dq - c, d1 = d0 - 32;
                const int i0 = d0 < 0 ? 0 : (d0 > 127 ? 127 : d0), i1 = d1 < 0 ? 0 : (d1 > 127 ? 127 : d1);
                const float b0 = LUT[i0], b1 = LUT[i1];
                p0[r] = (ok && d0 >= 0) ? p0[r] + b0 : NEG;
                p1[r] = (ok && d1 >= 0) ? p1[r] + b1 : NEG; }
            SBAR();
        }
    }
    return false;
}
__device__ __forceinline__ void partialSM(f32x16& p0, f32x16& p1, float& m_reg, float& mn, float& alpha, bool dead) {
    float pmax;
    { float ma = p0[0], mb = p1[0];
#pragma unroll
      for (int r = 1; r < 16; ++r) { ma = fmaxf(ma, p0[r]); mb = fmaxf(mb, p1[r]); }
      pmax = fmaxf(ma, mb); }
    { auto rr = __builtin_amdgcn_permlane32_swap(__float_as_uint(pmax), __float_as_uint(pmax), false, false);
      pmax = fmaxf(__uint_as_float(rr[0]), __uint_as_float(rr[1])); }
    constexpr float C2 = 1.4426950408889634f * SCALE;
    if (__builtin_expect(__all((pmax - m_reg) * SCALE <= THR), 1)) { mn = m_reg; alpha = 1.f; }
    else { mn = fmaxf(m_reg, pmax); alpha = __builtin_amdgcn_exp2f((m_reg - mn) * C2); m_reg = mn; }
    const float mnL = dead ? -__builtin_inff() : -mn * C2;
    for (int r = 0; r < 16; ++r) p0[r] = fmaf(p0[r], C2, mnL); for (int r = 0; r < 16; ++r) p1[r] = fmaf(p1[r], C2, mnL);
    for (int r = 0; r < 16; ++r) p0[r] = __builtin_amdgcn_exp2f(p0[r]);
}
__device__ __forceinline__ void finishSM(f32x16& p0, f32x16& p1, float alpha, float& l_reg, bf16x8& pa0, bf16x8& pa1, bf16x8& pa2, bf16x8& pa3) {
    for (int r = 0; r < 16; ++r) p1[r] = __builtin_amdgcn_exp2f(p1[r]);
    float ps;
    { float s0 = p0[0], s1 = p0[1], s2 = p0[2], s3 = p0[3];
#define ADDF(a_, b_) asm("v_add_f32 %0, %0, %1" : "+v"(a_) : "v"(b_))
#pragma unroll
      for (int r = 4; r < 16; r += 4) { ADDF(s0, p0[r]); ADDF(s1, p0[r + 1]); ADDF(s2, p0[r + 2]); ADDF(s3, p0[r + 3]); }
#pragma unroll
      for (int r = 0; r < 16; r += 4) { ADDF(s0, p1[r]); ADDF(s1, p1[r + 1]); ADDF(s2, p1[r + 2]); ADDF(s3, p1[r + 3]); }
      ADDF(s0, s1); ADDF(s2, s3); ADDF(s0, s2); ps = s0; }
#undef ADDF
    { auto rr = __builtin_amdgcn_permlane32_swap(__float_as_uint(ps), __float_as_uint(ps), false, false);
      ps = __uint_as_float(rr[0]) + __uint_as_float(rr[1]); }
    l_reg = l_reg * alpha + ps;
#define PK4(P, B_, OUT) do { unsigned a0 = cvtpk(P[B_+0], P[B_+1]), a1 = cvtpk(P[B_+2], P[B_+3]);                          \
        unsigned b0 = cvtpk(P[B_+4], P[B_+5]), b1 = cvtpk(P[B_+6], P[B_+7]);                                             \
        auto r0 = __builtin_amdgcn_permlane32_swap(a0, b0, false, false); auto r1 = __builtin_amdgcn_permlane32_swap(a1, b1, false, false); \
        u32x4 w = {r0[0], r1[0], r0[1], r1[1]}; OUT = *reinterpret_cast<bf16x8*>(&w); } while (0)
    PK4(p0, 0, pa0); PK4(p0, 8, pa1); PK4(p1, 0, pa2); PK4(p1, 8, pa3);
#undef PK4
}
template <int KB>
__device__ __forceinline__ void qkt(f32x16& p0, f32x16& p1, const char* K_lds, int r32, int hi, const bf16x8* qr) {
    p0 = f32x16{}; p1 = f32x16{};
    const int base = (int)(uintptr_t)K_lds;
    int ad[4];
#pragma unroll
    for (int dd = 0; dd < 4; ++dd) ad[dd] = base + KSWZ(r32, (dd * 16 + hi * 8) * 2);
    const int d47 = 128 - ((r32 & 8) << 5);
#define KRD(dst, addr, off) asm volatile("ds_read_b128 %0, %1 offset:%2" : "=&v"(dst) : "v"(addr), "i"(off) : "memory")
#define KWAIT(n, x, y) asm volatile("s_waitcnt lgkmcnt(" #n ")" : "+v"(x), "+v"(y) :: "memory")
    bf16x8 fa0, fb0, fa1, fb1;
    KRD(fa0, ad[0], KB * SHM_K); KRD(fb0, ad[0], KB * SHM_K + 32 * 256);
#define QK_STEP(d0, FA, FB, NA, NB) do {                                                                                        \
        if ((d0) < 7) { const int an_ = ad[((d0) + 1) & 3] + ((((d0) + 1) >> 2) ? d47 : 0); KRD(NA, an_, KB * SHM_K); KRD(NB, an_, KB * SHM_K + 32 * 256); KWAIT(2, FA, FB); } \
        else KWAIT(0, FA, FB);                                                                                                  \
        p0 = __builtin_amdgcn_mfma_f32_32x32x16_bf16(FA, qr[d0], p0, 0, 0, 0);                                                 \
        p1 = __builtin_amdgcn_mfma_f32_32x32x16_bf16(FB, qr[d0], p1, 0, 0, 0); } while (0)
    QK_STEP(0, fa0, fb0, fa1, fb1); QK_STEP(1, fa1, fb1, fa0, fb0); QK_STEP(2, fa0, fb0, fa1, fb1); QK_STEP(3, fa1, fb1, fa0, fb0);
    QK_STEP(4, fa0, fb0, fa1, fb1); QK_STEP(5, fa1, fb1, fa0, fb0); QK_STEP(6, fa0, fb0, fa1, fb1); QK_STEP(7, fa1, fb1, fa0, fb0);
#undef QK_STEP
#undef KRD
#undef KWAIT
}
template <int VB>
__device__ __forceinline__ void pv_tile(f32x16* o, int vb0, bf16x8 pa0, bf16x8 pa1, bf16x8 pa2, bf16x8 pa3) {
#define TRRD(dst, off) asm volatile("ds_read_b64_tr_b16 %0, %1 offset:%2" : "=&v"(dst) : "v"(vb0), "i"(off) : "memory")
#define PV_D0(d0) do { s16x4 l0, l1, l2, l3, h0, h1, h2, h3; constexpr int b_ = VB * SHM_V + v_rd_off(d0, 0, 0); \
        TRRD(l0, b_); TRRD(h0, b_ + 2048); TRRD(l1, b_ + 4096); TRRD(h1, b_ + 6144); TRRD(l2, b_ + 8192); TRRD(h2, b_ + 10240); TRRD(l3, b_ + 12288); TRRD(h3, b_ + 14336); \
        asm volatile("s_waitcnt lgkmcnt(0)" ::: "memory"); SBAR();   \
        o[d0] = __builtin_amdgcn_mfma_f32_32x32x16_bf16(pa0, (bf16x8){l0[0], l0[1], l0[2], l0[3], h0[0], h0[1], h0[2], h0[3]}, o[d0], 0, 0, 0);   \
        o[d0] = __builtin_amdgcn_mfma_f32_32x32x16_bf16(pa1, (bf16x8){l1[0], l1[1], l1[2], l1[3], h1[0], h1[1], h1[2], h1[3]}, o[d0], 0, 0, 0);   \
        o[d0] = __builtin_amdgcn_mfma_f32_32x32x16_bf16(pa2, (bf16x8){l2[0], l2[1], l2[2], l2[3], h2[0], h2[1], h2[2], h2[3]}, o[d0], 0, 0, 0);   \
        o[d0] = __builtin_amdgcn_mfma_f32_32x32x16_bf16(pa3, (bf16x8){l3[0], l3[1], l3[2], l3[3], h3[0], h3[1], h3[2], h3[3]}, o[d0], 0, 0, 0); } while (0)
    PV_D0(0); PV_D0(1); PV_D0(2); PV_D0(3);
#undef PV_D0
#undef TRRD
}

struct BlockRef { const bf16* Q; const bf16* K; const bf16* V; bf16* O; int P0; };
struct Seam { bf16x8 qr[8]; };
#define VMW() asm volatile("s_waitcnt vmcnt(0)" ::: "memory")
struct DmaMap { unsigned koff, voff; };
__device__ __forceinline__ DmaMap dma_map(int wid, int lane) {
    DmaMap d;
    { const int row = 4 * wid + (lane >> 4), g = (lane & 15) ^ (row & 15); d.koff = (unsigned)(row * PQ + g * 8); }
    { const int B = 2 * wid + (lane >> 5), kk = (B >> 2) * 8 + ((lane & 31) >> 2), c = (B & 3) * 32 + (lane & 3) * 8;
      const int k = (kk & ~0xC) | ((kk & 4) << 1) | ((kk & 8) >> 1); d.voff = (unsigned)(k * PQ + c); }
    return d;
}
#define DMA16(g_, l_) __builtin_amdgcn_global_load_lds((const unsigned*)(g_), (LAS unsigned*)(l_), 16, 0, 0)
#define DMA_K(bf, k0) do { const bf16* g_ = Kh + (size_t)(k0) * PQ + dm.koff; DMA16(g_, KL + (bf) * SHM_K + wid * 1024); DMA16(g_ + 32 * PQ, KL + (bf) * SHM_K + 8192 + wid * 1024); } while (0)
#define DMA_V(bf, k0) do { const bf16* g_ = Vh + (size_t)(k0) * PQ + dm.voff; DMA16(g_, VL + (bf) * SHM_V + wid * 1024); DMA16(g_ + 32 * PQ, VL + (bf) * SHM_V + 8192 + wid * 1024); } while (0)

__device__ __forceinline__ void moba_prime(const BlockRef& cur, char* lds, Seam& S, bool wait = true) {
    const int tid = fresh_tid(), wid = __builtin_amdgcn_readfirstlane(tid >> 6), lane = tid & 63, r32 = lane & 31, hi = lane >> 5;
    LAS unsigned char* VL = (LAS unsigned char*)(unsigned)(uintptr_t)lds; LAS unsigned char* KL = VL + 2 * SHM_V;
    const bf16* Kh = cur.K; const bf16* Vh = cur.V; const DmaMap dm = dma_map(wid, lane);
    DMA_K(0, 0); DMA_V(0, 0);
    for (int d0 = 0; d0 < 8; ++d0) S.qr[d0] = load8(cur.Q + (size_t)(wid * QBLK + r32) * PQ + d0 * 16 + hi * 8);
    if (wait) { VMW(); __syncthreads(); }
}
__device__ __forceinline__ unsigned moba_select(const bf16x8* qr, const float* KM, int nblk, int hi) {
    float qf[64];
#pragma unroll
    for (int d0 = 0; d0 < 8; ++d0)
#pragma unroll
        for (int e = 0; e < 8; ++e) qf[d0 * 8 + e] = __uint_as_float(((unsigned)(unsigned short)qr[d0][e]) << 16);
    float v0 = -__builtin_inff(), v1 = v0, v2 = v0; int i0 = -1, i1 = -1, i2 = -1;
    for (int j = 0; j < nblk; ++j) {
        const float* km = KM + j * 128 + hi * 8;
        float a0 = 0.f, a1 = 0.f, a2 = 0.f, a3 = 0.f;
#pragma unroll
        for (int d0 = 0; d0 < 8; ++d0) { const f32x4 k0 = *(const f32x4*)(km + d0 * 16), k1 = *(const f32x4*)(km + d0 * 16 + 4);
            a0 = fmaf(qf[d0 * 8 + 0], k0[0], a0); a1 = fmaf(qf[d0 * 8 + 1], k0[1], a1); a2 = fmaf(qf[d0 * 8 + 2], k0[2], a2); a3 = fmaf(qf[d0 * 8 + 3], k0[3], a3);
            a0 = fmaf(qf[d0 * 8 + 4], k1[0], a0); a1 = fmaf(qf[d0 * 8 + 5], k1[1], a1); a2 = fmaf(qf[d0 * 8 + 6], k1[2], a2); a3 = fmaf(qf[d0 * 8 + 7], k1[3], a3); }
        float a = (a0 + a1) + (a2 + a3);
        { auto rr = __builtin_amdgcn_permlane32_swap(__float_as_uint(a), __float_as_uint(a), false, false); a = __uint_as_float(rr[0]) + __uint_as_float(rr[1]); }
        if (a > v0) { v2 = v1; i2 = i1; v1 = v0; i1 = i0; v0 = a; i0 = j; }
        else if (a > v1) { v2 = v1; i2 = i1; v1 = a; i1 = j; }
        else if (a > v2) { v2 = a; i2 = j; }
    }
    unsigned msk = 0u;
    if (i0 >= 0) msk |= 1u << i0; if (i1 >= 0) msk |= 1u << i1; if (i2 >= 0) msk |= 1u << i2;
    return msk;
}
__device__ __forceinline__ void moba_block(const BlockRef& cur, char* lds, Seam& S) {
    const int tid = fresh_tid(), wid = __builtin_amdgcn_readfirstlane(tid >> 6), lane = tid & 63, r32 = lane & 31, hi = lane >> 5;
    const int NT = (cur.P0 + QB) / KVBLK;
    const int ib = cur.P0 >> 8;
    const int qlo = cur.P0 + wid * QBLK, qm = qlo + r32 - 4 * hi;
    char* V_lds = lds; char* K_lds = lds + 2 * SHM_V;
    LAS unsigned char* VL = (LAS unsigned char*)(unsigned)(uintptr_t)lds; LAS unsigned char* KL = VL + 2 * SHM_V;
    float* ws = (float*)(lds + LDS_WS) + wid * 64; float* li_l = ws, * al_l = ws + 32;
    const float* KM = (const float*)(lds + LDS_KM); const float* LUT = (const float*)(lds + LDS_LUT);
    float m_reg = -1e30f, l_reg = 0; f32x16 o[4] = {};
    const int vb0 = (int)(uintptr_t)V_lds + v_rd_base(lane);
    const bf16* Kh = cur.K; const bf16* Vh = cur.V; const DmaMap dm = dma_map(wid, lane);
#define RESC(a) do { if (__any((a) < 1.f)) { if (hi == 0) al_l[r32] = (a); asm volatile("s_waitcnt lgkmcnt(0)" ::: "memory");              \
                     for (int d_ = 0; d_ < 4; ++d_) for (int r = 0; r < 16; ++r) o[d_][r] *= al_l[crow(r, hi)]; } } while (0)
#define KBASE(t) ((t) * KVBLK)
#define MASKT(P0_, P1_, t) const bool dead_ = moba_mask(P0_, P1_, KBASE(t), ib, qm, selmask, LUT, qlo)
    f32x16 pA0, pA1, pB0, pB1; float mnA, mnB, alA, alB; bf16x8 pa0, pa1, pa2, pa3;
    SBAR(); DMA_K(1, KBASE(1)); SBAR();
    const unsigned selmask = ib <= 3 ? (1u << ib) - 1u : moba_select(S.qr, KM, ib, hi);
    SBAR(); qkt<0>(pA0, pA1, K_lds, r32, hi, S.qr);
    { MASKT(pA0, pA1, 0); partialSM(pA0, pA1, m_reg, mnA, alA, dead_); }
    VMW();
    __syncthreads();
    const int Tw = NT - 4 + (wid >> 1);
#define HALF_STEP(PX0, PX1, mnX, alX, PY0, PY1, alY, t, KB, VB) do {                                                          \
        SBAR(); DMA_K(VB, KBASE((t) + 1)); DMA_V(KB, KBASE(t)); SBAR();                                                       \
        if ((t) <= Tw) qkt<KB>(PX0, PX1, K_lds, r32, hi, S.qr);                                                               \
        if ((t) - 1 <= Tw) { finishSM(PY0, PY1, alY, l_reg, pa0, pa1, pa2, pa3); SBAR();                                      \
            pv_tile<VB>(o, vb0, pa0, pa1, pa2, pa3); }                                                                        \
        if ((t) <= Tw) { MASKT(PX0, PX1, (t)); partialSM(PX0, PX1, m_reg, mnX, alX, dead_); RESC(alX); }                      \
        VMW();                                                                                                                \
        __syncthreads(); } while (0)
    for (int t = 1; t + 1 < NT; t += 2) {
        HALF_STEP(pB0, pB1, mnB, alB, pA0, pA1, alA, t, 1, 0);
        HALF_STEP(pA0, pA1, mnA, alA, pB0, pB1, alB, t + 1, 0, 1);
    }
    SBAR(); DMA_V(1, KBASE(NT - 1)); SBAR();
    if (NT - 1 <= Tw) { qkt<1>(pB0, pB1, K_lds, r32, hi, S.qr); SBAR(); }
    if (NT - 2 <= Tw) { finishSM(pA0, pA1, alA, l_reg, pa0, pa1, pa2, pa3); SBAR();
        pv_tile<0>(o, vb0, pa0, pa1, pa2, pa3); }
    if (NT - 1 <= Tw) { MASKT(pB0, pB1, NT - 1); partialSM(pB0, pB1, m_reg, mnB, alB, dead_); RESC(alB); }
    VMW(); __syncthreads();
    if (NT - 1 <= Tw) { finishSM(pB0, pB1, alB, l_reg, pa0, pa1, pa2, pa3); SBAR(); pv_tile<1>(o, vb0, pa0, pa1, pa2, pa3); }
    SBAR();
    if (hi == 0) li_l[r32] = l_reg; asm volatile("s_waitcnt lgkmcnt(0)" ::: "memory");
    float rli[16];
#pragma unroll
    for (int r = 0; r < 16; ++r) rli[r] = __builtin_amdgcn_rcpf(li_l[crow(r, hi)]);
    bf16* Ow = cur.O + (size_t)(wid * QBLK) * PO;
#pragma unroll
    for (int r = 0; r < 16; ++r) { const int orow = crow(r, hi);
#pragma unroll
        for (int d0 = 0; d0 < 4; ++d0) { const float v = o[d0][r] * rli[r];
            const float vn = __shfl_xor(v, 1);
            if ((r32 & 1) == 0) *(unsigned*)(Ow + (size_t)orow * PO + d0 * 32 + r32) = cvtpk(v, vn); } }
    __syncthreads();
#undef RESC
#undef KBASE
#undef MASKT
#undef HALF_STEP
}
#undef VMW
#undef DMA16
#undef DMA_K
#undef DMA_V
#undef SBAR
#undef KSWZ
}

constexpr size_t MiB = 1u << 20;
constexpr size_t WS_CTL = 0, CTL_ZERO_BYTES = 64 * 1024;
constexpr size_t WO_IN = 0;
constexpr size_t WO_CA = 40 * MiB;
constexpr size_t WO_MIX = 48 * MiB;
constexpr size_t WO_GU = 56 * MiB;
constexpr size_t WO_DN = 100 * MiB;
constexpr size_t WSET_BYTES = 122 * MiB;
constexpr size_t WS_W0 = 2 * MiB, WS_W1 = 702 * MiB;
constexpr size_t WS_KPART = 124 * MiB;
constexpr size_t WS_SS = 126 * MiB;
constexpr size_t WS_XB2 = 128 * MiB;
constexpr size_t WS_XB = 254 * MiB;
constexpr size_t WS_PROJ = 318 * MiB;
constexpr size_t WS_GU = WS_PROJ;
constexpr size_t WS_UA = 638 * MiB;
constexpr size_t WS_MG = 830 * MiB;
constexpr size_t WS_END = 894 * MiB;
static_assert(WS_W1 + WSET_BYTES <= WS_MG, "weight set 1");
constexpr int CW_BAR = 4096;

constexpr int RING_OFF = 0, RING_BYTES = 131072;
constexpr int LDSCTL_OFF = RING_BYTES, MISC_OFF = LDSCTL_OFF + 320;
constexpr int LDS_BYTES = LDS_TOTAL;
static_assert(att::LDS_BYTES <= RING_BYTES && MISC_OFF + 128 <= LDS_RB_OFF, "LDS map");

#define XB_TMO      128
#define XB_XCNT(j)  (256  + 64 * (j))
#define XB_XSUB(j)  (1280 + 64 * (j))
#define XB_XGEN(j)  (2304 + 64 * (j))
#define XB_TOP      3328
#define XB_TOPGEN   3392
#define XCD_BAR_WORDS 3456
#define XB_SPIN_CAP (1u << 18)

__device__ __forceinline__ unsigned xb_ld(unsigned* p)              { return __hip_atomic_load(p, __ATOMIC_RELAXED, __HIP_MEMORY_SCOPE_AGENT); }
__device__ __forceinline__ unsigned xb_add(unsigned* p, unsigned v) { return __hip_atomic_fetch_add(p, v, __ATOMIC_RELAXED, __HIP_MEMORY_SCOPE_AGENT); }
__device__ __forceinline__ unsigned xb_xcc_id() { return (unsigned)__builtin_amdgcn_s_getreg((3 << 11) | 20) & 0xFu; }
#define XB_SPIN(cond, bar) do { unsigned _sp = 0; while (cond) { __builtin_amdgcn_s_sleep(1); \
    if ((++_sp & 255u) == 0u) { if (xb_ld(&(bar)[XB_TMO])) break; if (_sp > XB_SPIN_CAP) { atomicAdd(&(bar)[XB_TMO], 1u); break; } } } } while (0)

struct XcdBarrier { unsigned* bar; unsigned x; volatile LAS unsigned* st; };

__device__ __forceinline__ XcdBarrier xcd_barrier_post(unsigned* bar, volatile LAS unsigned* st) {
    XcdBarrier b; b.bar = bar; b.x = xb_xcc_id(); b.st = st;
    if (threadIdx.x == 0) (void)xb_add(&bar[XB_XCNT(b.x)], 1u);
    return b;
}
__device__ __forceinline__ void xcd_barrier_complete(unsigned* bar, unsigned x, unsigned& nloc, unsigned& nx) {
    const unsigned G = gridDim.x * gridDim.y * gridDim.z;
    unsigned sum, cnt, mine, sp = 0u;
    for (;;) {
        sum = 0u; cnt = 0u; mine = 0u;
#pragma unroll
        for (unsigned j = 0; j < 16; ++j) { const unsigned c = xb_ld(&bar[XB_XCNT(j)]); sum += c; cnt += (c > 0u) ? 1u : 0u; mine = (j == x) ? c : mine; }
        if (sum == G) break;
        __builtin_amdgcn_s_sleep(1);
        if ((++sp & 255u) == 0u) { if (xb_ld(&bar[XB_TMO])) break; if (sp > XB_SPIN_CAP) { atomicAdd(&bar[XB_TMO], 1u); break; } }
    }
    nloc = mine > 0u ? mine : 1u; nx = cnt > 0u ? cnt : 1u;
}
__device__ __forceinline__ void xcd_barrier(const XcdBarrier& b) {
    asm volatile("s_waitcnt vmcnt(0)" ::: "memory");
    __syncthreads();
    if (threadIdx.x == 0) {
        unsigned* bar = b.bar;
        __builtin_amdgcn_s_waitcnt(0);
        unsigned nloc = b.st[0], nx = b.st[1];
        if (nloc == 0u) { xcd_barrier_complete(bar, b.x, nloc, nx); b.st[0] = nloc; b.st[1] = nx; }
        const unsigned old = xb_add(&bar[XB_XSUB(b.x)], 1u);
        const unsigned gen = old / nloc;
        if (old + 1u == (gen + 1u) * nloc) {
            __builtin_amdgcn_fence(__ATOMIC_RELEASE, "agent");
            asm volatile("s_waitcnt vmcnt(0)" ::: "memory");
            const unsigned og = xb_add(&bar[XB_TOP], 1u);
            const unsigned tg = og / nx;
            if (og + 1u == (tg + 1u) * nx) xb_add(&bar[XB_TOPGEN], 1u);
            else XB_SPIN(xb_ld(&bar[XB_TOPGEN]) == tg, bar);
            __builtin_amdgcn_fence(__ATOMIC_ACQUIRE, "agent");
            asm volatile("s_waitcnt vmcnt(0)" ::: "memory");
            xb_add(&bar[XB_XGEN(b.x)], 1u);
            asm volatile("s_waitcnt vmcnt(0)" ::: "memory");
        } else {
            XB_SPIN(xb_ld(&bar[XB_XGEN(b.x)]) == gen, bar);
            asm volatile("buffer_inv sc0\n\ts_waitcnt vmcnt(0)" ::: "memory");
        }
    }
    __syncthreads();
}

__device__ __forceinline__ void panel_barrier(unsigned* cnt, unsigned target, unsigned* tmo, bool local) {
    asm volatile("s_waitcnt vmcnt(0)" ::: "memory");
    __syncthreads();
    if (threadIdx.x == 0) {
        if (!local) { __builtin_amdgcn_fence(__ATOMIC_RELEASE, "agent"); asm volatile("s_waitcnt vmcnt(0)" ::: "memory"); }
        (void)xb_add(cnt, 1u);
        unsigned sp = 0u;
        while (xb_ld(cnt) < target) { __builtin_amdgcn_s_sleep(1); if ((++sp & 255u) == 0u) { if (xb_ld(tmo)) break; if (sp > XB_SPIN_CAP) { atomicAdd(tmo, 1u); break; } } }
        if (!local) { __builtin_amdgcn_fence(__ATOMIC_ACQUIRE, "agent"); asm volatile("s_waitcnt vmcnt(0)" ::: "memory"); }
    }
    __syncthreads();
    if (local) asm volatile("buffer_inv sc0\n\ts_waitcnt vmcnt(0)" ::: "memory");
}
struct Args { const float* in[13]; float* out; unsigned char* ws; int ph_lo, ph_hi; };
struct Frame {
    LAS unsigned char* lds;
    int vcu, G;
    unsigned char* ws;
};

__device__ __forceinline__ float wave_sum(float v) {
#pragma unroll
    for (int o = 1; o < 64; o <<= 1) v += __shfl_xor(v, o);
    return v;
}
struct CvtItem { const float* src; size_t rs2; bf16* dst; int ldw; const float* gain; int has_gain; };
constexpr int CVT_I_IN = (DM / 64) * (INC / 32), CVT_NITEMS = CVT_I_IN + 2 * (CCH / 64) * (DM / 32) + (DM / 64) * (DM / 32) + 2 * (DM / 64) * (FF / 32) + (FF / 64) * (DM / 32);
__device__ __forceinline__ CvtItem cvt_decode(const Args& a, unsigned char* wset, int l, int r) {
    constexpr int I_IN = (DM / 64) * (INC / 32), I_CO = (CCH / 64) * (DM / 32), I_AO = (AW / 64) * (DM / 32), I_MIX = (DM / 64) * (DM / 32),
                  I_G = (DM / 64) * (FF / 32), I_U = I_G, I_DN = (FF / 64) * (DM / 32);
    static_assert(I_IN == CVT_I_IN && I_IN + I_CO + I_AO + I_MIX + I_G + I_U + I_DN == CVT_NITEMS, "item counts");
    const float* W; int N, ldw, k0, n0; bf16* WT; const float* gain = nullptr; int dcol = 0, rowmode = 0;
#define CVT_KN(NB) do { k0 = 64 * (r / (NB)); n0 = 32 * (r % (NB)); } while (0)
    if (r < I_IN) { W = a.in[1] + (size_t)l * DM * INC; N = INC; WT = (bf16*)(wset + WO_IN); ldw = DM; gain = a.in[7] + (size_t)l * DM; rowmode = 3; CVT_KN(INC / 32); }
    else if ((r -= I_IN) < I_CO) { W = a.in[3] + (size_t)l * CCH * DM; N = DM; WT = (bf16*)(wset + WO_CA); ldw = 2048; CVT_KN(DM / 32); }
    else if ((r -= I_CO) < I_AO) { W = a.in[4] + (size_t)l * AW * DM; N = DM; WT = (bf16*)(wset + WO_CA); ldw = 2048; dcol = 1024; CVT_KN(DM / 32); }
    else if ((r -= I_AO) < I_MIX) { W = a.in[5] + (size_t)l * DM * DM; N = DM; WT = (bf16*)(wset + WO_MIX); ldw = DM; CVT_KN(DM / 32); }
    else if ((r -= I_MIX) < I_G) { W = a.in[9] + (size_t)l * DM * FF; N = FF; WT = (bf16*)(wset + WO_GU); ldw = DM; gain = a.in[8] + (size_t)l * DM; rowmode = 1; CVT_KN(FF / 32); }
    else if ((r -= I_G) < I_U) { W = a.in[10] + (size_t)l * DM * FF; N = FF; WT = (bf16*)(wset + WO_GU); ldw = DM; gain = a.in[8] + (size_t)l * DM; rowmode = 2; CVT_KN(FF / 32); }
    else { r -= I_U; W = a.in[11] + (size_t)l * FF * DM; N = DM; WT = (bf16*)(wset + WO_DN); ldw = FF; CVT_KN(DM / 32); }
#undef CVT_KN
    int drow = rowmode == 0 ? n0 : 256 * (n0 / 128) + (n0 % 128) + (rowmode == 2 ? 128 : 0);
    if (rowmode == 3) { const int isatt = n0 >= C_GA, gcol = n0 - (isatt ? C_GA : C_GC);
        drow = n0 < C_GC ? n0 : C_GC + 256 * (gcol / 128) + (gcol % 128) + (isatt ? 128 : 0);
        if (n0 < C_B || (n0 >= C_C && n0 < C_Q)) { const int isc = n0 >= C_C, ch = n0 - (isc ? C_C : 0), k = ch / 128, pk = k < 4 ? k : 4 + k;
            drow = 256 * pk + (ch % 128) + (isc ? 128 : 0); } }
    CvtItem c; c.src = W + (size_t)k0 * N + n0; c.rs2 = (size_t)2 * N; c.dst = WT + (size_t)drow * ldw + dcol + k0; c.ldw = ldw; c.gain = (gain ? gain : a.in[7]) + k0; c.has_gain = gain != nullptr;
    return c;
}
__device__ __forceinline__ void cvt_load(const CvtItem& c, int lane, f32x4 (&wv)[8], f32x4 (&gv)[2]) {
    const float* wp = c.src + (size_t)(lane >> 3) * (c.rs2 >> 1) + 4 * (lane & 7);
#pragma unroll
    for (int i = 0; i < 8; ++i) wv[i] = *(const GAS f32x4*)(wp + (size_t)i * 4 * c.rs2);
    gv[0] = *(const f32x4*)(c.gain + 8 * (lane & 7)); gv[1] = *(const f32x4*)(c.gain + 8 * (lane & 7) + 4);
}
__device__ __forceinline__ void cvt_store(const CvtItem& c, int lane, const f32x4 (&wv)[8], const f32x4 (&gv)[2], LAS float* scr) {
    const int ch = lane & 7;
    LAS float* wp = scr + (lane >> 3) * 33 + 4 * (lane & 7);
#pragma unroll
    for (int i = 0; i < 8; ++i)
#pragma unroll
        for (int q = 0; q < 4; ++q) wp[i * 8 * 33 + q] = wv[i][q];
    f32x4 g0 = gv[0], g1 = gv[1];
    if (!c.has_gain) { g0 = (f32x4){1.f, 1.f, 1.f, 1.f}; g1 = g0; }
    LDS_WAIT(); asm volatile("" ::: "memory");
    float t[4][8];
#pragma unroll
    for (int j = 0; j < 4; ++j) { const LAS float* sp = scr + (8 * ch) * 33 + (lane >> 3) + 8 * j;
#pragma unroll
        for (int e = 0; e < 8; ++e) t[j][e] = sp[e * 33]; }
    __builtin_amdgcn_sched_barrier(0);
    LDS_WAIT();
#pragma unroll
    for (int j = 0; j < 4; ++j) { const int n = (lane >> 3) + 8 * j;
        v4u o; o.x = cvt_pk_bf16(t[j][0] * g0[0], t[j][1] * g0[1]); o.y = cvt_pk_bf16(t[j][2] * g0[2], t[j][3] * g0[3]); o.z = cvt_pk_bf16(t[j][4] * g1[0], t[j][5] * g1[1]); o.w = cvt_pk_bf16(t[j][6] * g1[2], t[j][7] * g1[3]);
        *(GAS v4u*)(c.dst + (size_t)n * c.ldw + 8 * ch) = o; }
    asm volatile("" ::: "memory");
}
__device__ __forceinline__ void phase_convert_weights(Frame& F, const Args& a, int l, int it_lo, int it_hi, int nw = NWAVES) {
    const int tid = fresh_tid(), lane = tid & 63, wave = __builtin_amdgcn_readfirstlane(tid >> 6);
    LAS float* scr = (LAS float*)(F.lds + RING_OFF + wave * 8448);
    const int gw = F.vcu * nw + wave, NGW = F.G * nw;
    unsigned char* wset = F.ws + ((l & 1) ? WS_W1 : WS_W0);
    const int first = it_lo + gw;
    if (first >= it_hi) return;
    const int n = (it_hi - first + NGW - 1) / NGW;
#define CVT_ITEM(j) cvt_decode(a, wset, l, first + ((j) < n ? (j) : n - 1) * NGW)
    f32x4 wA[8], wB[8], wC[8], wD[8], gA[2], gB[2], gC[2], gD[2];
    CvtItem cA = CVT_ITEM(0), cB = CVT_ITEM(1), cC = CVT_ITEM(2), cD = cA;
    cvt_load(cA, lane, wA, gA); cvt_load(cB, lane, wB, gB); cvt_load(cC, lane, wC, gC);
    for (int j = 0;; j += 4) {
        cD = CVT_ITEM(j + 3); cvt_load(cD, lane, wD, gD); __builtin_amdgcn_sched_barrier(0); cvt_store(cA, lane, wA, gA, scr); if (j + 1 >= n) break;
        cA = CVT_ITEM(j + 4); cvt_load(cA, lane, wA, gA); __builtin_amdgcn_sched_barrier(0); cvt_store(cB, lane, wB, gB, scr); if (j + 2 >= n) break;
        cB = CVT_ITEM(j + 5); cvt_load(cB, lane, wB, gB); __builtin_amdgcn_sched_barrier(0); cvt_store(cC, lane, wC, gC, scr); if (j + 3 >= n) break;
        cC = CVT_ITEM(j + 6); cvt_load(cC, lane, wC, gC); __builtin_amdgcn_sched_barrier(0); cvt_store(cD, lane, wD, gD, scr); if (j + 4 >= n) break;
    }
#undef CVT_ITEM
}
__device__ __forceinline__ void phase_x_to_bf16(Frame& F, const float* x, int w0 = 0, int nw = NWAVES) {
    const int tid = fresh_tid(), lane = tid & 63, wave = __builtin_amdgcn_readfirstlane(tid >> 6) - w0;
    const int gw = F.vcu * nw + wave, NGW = F.G * nw;
    bf16* XB = (bf16*)(F.ws + WS_XB); float* SS = (float*)(F.ws + WS_SS);
    for (int m = gw; m < M; m += 2 * NGW) {
        const GAS f32x4* xr0 = (const GAS f32x4*)(x + (size_t)m * DM) + lane; const bool two = m + NGW < M; const GAS f32x4* xr1 = (const GAS f32x4*)(x + (size_t)(two ? m + NGW : m) * DM) + lane;
        f32x4 v0[8], v1[8];
#pragma unroll
        for (int j = 0; j < 8; ++j) v0[j] = __builtin_nontemporal_load(xr0 + 64 * j);
#pragma unroll
        for (int j = 0; j < 8; ++j) v1[j] = __builtin_nontemporal_load(xr1 + 64 * j);
        __builtin_amdgcn_sched_barrier(0);
#pragma unroll
        for (int h = 0; h < 2; ++h) { if (h && !two) break; const int mm = m + h * NGW; float s = 0.f;
            GAS u32x2* o8 = (GAS u32x2*)(XB + (size_t)mm * DM) + lane;
#pragma unroll
            for (int j = 0; j < 8; ++j) { const f32x4 v = h ? v1[j] : v0[j]; s += (v.x * v.x + v.y * v.y) + (v.z * v.z + v.w * v.w);
                u32x2 w; w.x = cvt_pk_bf16(v.x, v.y); w.y = cvt_pk_bf16(v.z, v.w); o8[64 * j] = w; }
            s = wave_sum(s);
            if (lane < 8) SS[(size_t)mm * 8 + lane] = lane == 0 ? s : 0.f; }
    }
}
__device__ __forceinline__ void phase_final_norm(Frame& F, const float* gain, float* out, int pm, int mi) {
    const int tid = fresh_tid(), lane = tid & 63, wave = __builtin_amdgcn_readfirstlane(tid >> 6);
    const int gw = pm >= 0 ? wave : F.vcu * NWAVES + wave, NGW = pm >= 0 ? NWAVES : F.G * NWAVES;
    const int mlo = pm >= 0 ? pm * 256 + mi * 64 : 0, mhi = pm >= 0 ? mlo + 64 : M;
    const bf16* XB = (const bf16*)(F.ws + WS_XB); const float* SS = (const float*)(F.ws + WS_SS);
    for (int m = mlo + gw; m < mhi; m += NGW) {
        float s = lane < 8 ? SS[(size_t)m * 8 + lane] : 0.f; s = wave_sum(s);
        const float r = __builtin_amdgcn_rsqf(s * (1.0f / DM) + RMS_EPS);
#pragma unroll
        for (int j = 0; j < 4; ++j) { const int c = 8 * (lane + 64 * j); const u32x4 w = __builtin_nontemporal_load((const GAS u32x4*)(XB + (size_t)m * DM + c));
            const f32x4 g0 = *(const f32x4*)(gain + c), g1 = *(const f32x4*)(gain + c + 4);
            f32x4 o0, o1; o0[0] = bf_lo(w.x) * r * g0[0]; o0[1] = bf_hi(w.x) * r * g0[1]; o0[2] = bf_lo(w.y) * r * g0[2]; o0[3] = bf_hi(w.y) * r * g0[3];
            o1[0] = bf_lo(w.z) * r * g1[0]; o1[1] = bf_hi(w.z) * r * g1[1]; o1[2] = bf_lo(w.w) * r * g1[2]; o1[3] = bf_hi(w.w) * r * g1[3];
            __builtin_nontemporal_store(o0, (GAS f32x4*)(out + (size_t)m * DM + c)); __builtin_nontemporal_store(o1, (GAS f32x4*)(out + (size_t)m * DM + c + 4)); }
    }
}
__device__ __forceinline__ void unpack8(const u32x4 w, float (&f)[8]) {
    f[0] = bf_lo(w.x); f[1] = bf_hi(w.x); f[2] = bf_lo(w.y); f[3] = bf_hi(w.y); f[4] = bf_lo(w.z); f[5] = bf_hi(w.z); f[6] = bf_lo(w.w); f[7] = bf_hi(w.w);
}
__device__ __forceinline__ void phase_conv(Frame& F, const float* conv_w  ) {
    const bf16* PROJ = (const bf16*)(F.ws + WS_PROJ); bf16* UA = (bf16*)(F.ws + WS_UA);
    const int tid = fresh_tid(), lane = tid & 63, wave = __builtin_amdgcn_readfirstlane(tid >> 6);
    const int gw = F.vcu * NWAVES + wave, NGW = F.G * NWAVES;
    for (int it = gw; it < (M / 16) * 2; it += NGW) {
        const int half = it & 1, rr = it >> 1, m0 = rr * 16, t0 = m0 % SEQ, c0 = half * 512 + lane * 8;
        float w0[8], w1[8], w2[8];
        { const f32x4 a0 = *(const f32x4*)(conv_w + c0), a1 = *(const f32x4*)(conv_w + c0 + 4), b0 = *(const f32x4*)(conv_w + CCH + c0), b1 = *(const f32x4*)(conv_w + CCH + c0 + 4),
                      d0 = *(const f32x4*)(conv_w + 2 * CCH + c0), d1 = *(const f32x4*)(conv_w + 2 * CCH + c0 + 4);
#pragma unroll
          for (int e = 0; e < 4; ++e) { w0[e] = a0[e]; w0[4 + e] = a1[e]; w1[e] = b0[e]; w1[4 + e] = b1[e]; w2[e] = d0[e]; w2[4 + e] = d1[e]; } }
        float p2[8], p1[8];
#pragma unroll
        for (int e = 0; e < 8; ++e) { p2[e] = 0.f; p1[e] = 0.f; }
        if (t0 != 0) {
            unpack8(*(const u32x4*)(PROJ + (size_t)(m0 - 2) * INC + C_H + c0), p2);
            unpack8(*(const u32x4*)(PROJ + (size_t)(m0 - 1) * INC + C_H + c0), p1);
        }
#pragma unroll 8
        for (int r = 0; r < 16; ++r) {
            const size_t m = (size_t)(m0 + r);
            float ch[8], b[8], y[8];
            unpack8(__builtin_nontemporal_load((const GAS u32x4*)(PROJ + m * INC + C_H + c0)), ch); unpack8(__builtin_nontemporal_load((const GAS u32x4*)(PROJ + m * INC + C_B + c0)), b);
#pragma unroll
            for (int e = 0; e < 8; ++e) { const float cu = ch[e]; float acc = w0[e] * p2[e]; acc = acc + w1[e] * p1[e]; acc = acc + w2[e] * cu; y[e] = b[e] * acc; p2[e] = p1[e]; p1[e] = cu; }
            u32x4 w; w.x = cvt_pk_bf16(y[0], y[1]); w.y = cvt_pk_bf16(y[2], y[3]); w.z = cvt_pk_bf16(y[4], y[5]); w.w = cvt_pk_bf16(y[6], y[7]);
            *(u32x4*)(UA + m * 2048 + c0) = w;
        }
    }
}
__device__ __forceinline__ int t5_bucket(int n) {
    if (n < 16) return n;
    int b = 16;
    b += (n >= 19); b += (n >= 21); b += (n >= 24); b += (n >= 27); b += (n >= 31); b += (n >= 35); b += (n >= 40); b += (n >= 46);
    b += (n >= 52); b += (n >= 59); b += (n >= 67); b += (n >= 77); b += (n >= 87); b += (n >= 99); b += (n >= 113);
    return b;
}
__device__ __forceinline__ void mixer_stream_work(Frame& F, const Args& a, int l) {
    for (int rep = 0; rep < REP_MISC; ++rep) {
        phase_conv(F, a.in[2] + (size_t)l * 3 * CCH);
        if (l == 0) phase_convert_weights(F, a, 0, CVT_I_IN, CVT_NITEMS);
        if (l + 1 < DEPTH) phase_convert_weights(F, a, l + 1, 0, CVT_NITEMS);
    }
}
__device__ __forceinline__ void phase_attention(Frame& F, char* lds, const float* rel_bias, const Args& a, int l) {
    const bf16* PROJ = (const bf16*)(F.ws + WS_PROJ); bf16* UA = (bf16*)(F.ws + WS_UA); const float* KPART = (const float*)(F.ws + WS_KPART);
    float* KM = (float*)(lds + att::LDS_KM); float* LUT = (float*)(lds + att::LDS_LUT);
    bool streamed = false;
    for (int L = F.vcu; L < BATCH * NH * 8; L += F.G) {
        const int tid = fresh_tid();
        const int bh = L >> 3, x = L & 7, b = bh / NH, h = bh % NH;
        const int qbA = (bh & 1) ? 15 - x : x, qbB = 15 - qbA;
        att::BlockRef bA, bB;
        { const size_t row0 = (size_t)b * SEQ + (size_t)qbA * 256; bA.Q = PROJ + row0 * INC + C_Q + h * HD; bA.O = UA + row0 * 2048 + 1024 + h * HD; bA.P0 = qbA * 256; }
        { const size_t row0 = (size_t)b * SEQ + (size_t)qbB * 256; bB.Q = PROJ + row0 * INC + C_Q + h * HD; bB.O = UA + row0 * 2048 + 1024 + h * HD; bB.P0 = qbB * 256; }
        bA.K = bB.K = PROJ + (size_t)b * SEQ * INC + C_K + h * HD; bA.V = bB.V = PROJ + (size_t)b * SEQ * INC + C_V + h * HD;
        att::Seam S;
        att::moba_prime(bA, lds, S, false);
        for (int idx = tid; idx < 16 * 128; idx += NWAVES * 64) { const int j = idx >> 7, d = idx & 127; float s = 0.f;
            s = KPART[(size_t)((b * 16 + j) * 2 + 0) * 1024 + h * 128 + d] + KPART[(size_t)((b * 16 + j) * 2 + 1) * 1024 + h * 128 + d];
            KM[idx] = s * (1.0f / 256.0f); }
        if (tid < 128) LUT[tid] = (rel_bias[t5_bucket(tid) * NH + h] - rel_bias[31 * NH + h]) * (1.0f / att::SCALE);
        asm volatile("s_waitcnt vmcnt(0)" ::: "memory"); __syncthreads();
        for (int rep = 0; rep < REP_ATT; ++rep) {
        if (rep > 0) att::moba_prime(bA, lds, S);
        att::moba_block(bA, lds, S);
        __syncthreads();
        if (!streamed) { mixer_stream_work(F, a, l); streamed = true; __syncthreads(); }
        att::moba_prime(bB, lds, S);
        att::moba_block(bB, lds, S);
        __syncthreads();
        }
    }
    if (!streamed) mixer_stream_work(F, a, l);
}
constexpr int PH_PER_LAYER = 6, N_PHASES = DEPTH * PH_PER_LAYER + 2;

__global__ void __launch_bounds__(NWAVES * 64, 2) trunk_fwd(Args args) {
    extern __shared__ __attribute__((aligned(16))) unsigned char lds[];
    Frame F;
    F.lds = (LAS unsigned char*)lds;
    volatile LAS unsigned* MISC = (volatile LAS unsigned*)(F.lds + MISC_OFF);
    F.G = gridDim.x; { const int bx = blockIdx.x; F.vcu = (F.G % 8 == 0) ? (bx % 8) * (F.G / 8) + bx / 8 : bx; }
    F.ws = args.ws;
    unsigned* ctl = (unsigned*)(F.ws + WS_CTL);
    for (int u = threadIdx.x; u < (LDS_BYTES - LDSCTL_OFF) / 4; u += NWAVES * 64) ((LAS unsigned*)(F.lds + LDSCTL_OFF))[u] = 0u;
    __syncthreads();
    const int lo = args.ph_lo, hi = args.ph_hi;
    const bool use_bar = (hi - lo) > 1;
    XcdBarrier bar; bar.bar = ctl + CW_BAR; bar.x = 0; bar.st = MISC + 8;
    if (use_bar) bar = xcd_barrier_post(ctl + CW_BAR, MISC + 8);
#define IN(k) (lo <= (k) && (k) < hi)
#define SEAM(k) do { if ((k) + 1 < hi) xcd_barrier(bar); } while (0)
    const bool paneled = (F.G == 256) && use_bar;
    const int my_pm = 8 * ((int)blockIdx.x % 8) + ((int)blockIdx.x / 8) % 8, my_mi = (int)blockIdx.x / 64;
    unsigned pb_epoch = 0u; bool pb_local = false;
    if (paneled && threadIdx.x == 0) __hip_atomic_store(ctl + 12288 + blockIdx.x, 0x100u | xb_xcc_id(), __ATOMIC_RELAXED, __HIP_MEMORY_SCOPE_AGENT);
#define SEAMG(k) do { if ((k) + 1 < hi) { if (paneled) { pb_epoch += 4u; panel_barrier(ctl + 8192 + 64 * my_pm, pb_epoch, ctl + CW_BAR + XB_TMO, pb_local); } else xcd_barrier(bar); } } while (0)

    bf16* XB = (bf16*)(F.ws + WS_XB); bf16* XB2 = (bf16*)(F.ws + WS_XB2); float* SS = (float*)(F.ws + WS_SS); bf16* PROJ = (bf16*)(F.ws + WS_PROJ); bf16* GU = (bf16*)(F.ws + WS_GU);
    bf16* UA = (bf16*)(F.ws + WS_UA); bf16* MG = (bf16*)(F.ws + WS_MG); float* KP = (float*)(F.ws + WS_KPART);

    if (IN(0)) { if (__builtin_amdgcn_readfirstlane((int)threadIdx.x >> 6) < 4) phase_convert_weights(F, args, 0, 0, CVT_I_IN, 4); else phase_x_to_bf16(F, args.in[0], 4, 4); SEAM(0); }
    if (paneled && lo == 0) {
        const unsigned b0 = (unsigned)blockIdx.x % 64u;
        const unsigned i0 = xb_ld(ctl + 12288 + b0), i1 = xb_ld(ctl + 12288 + b0 + 64), i2 = xb_ld(ctl + 12288 + b0 + 128), i3 = xb_ld(ctl + 12288 + b0 + 192);
        pb_local = (i0 & 0x100u) && i0 == i1 && i0 == i2 && i0 == i3;
    }
    for (int l = 0; l < DEPTH; ++l) {
        const int pb = 1 + l * PH_PER_LAYER;
        unsigned char* wset = F.ws + ((l & 1) ? WS_W1 : WS_W0);
        bf16* WIN = (bf16*)(wset + WO_IN); bf16* WCA = (bf16*)(wset + WO_CA); bf16* WMIX = (bf16*)(wset + WO_MIX); bf16* WGU = (bf16*)(wset + WO_GU); bf16* WDN = (bf16*)(wset + WO_DN);
        if (IN(pb + 0)) {
            pg8::Gemm g{XB, WIN, M, INC, DM, DM, DM}; pg8::WrapOrder S; S.init(M, INC * REP_IN, F.G, fresh_bid()); S.wrapN = INC / 256;
            pg8::EpiProj E{PROJ, INC, C_GC, SS, KP};
#if SPLIT_IN
            for (int hf = 0; hf < 2; ++hf) { S.i0 = hf * 5; S.i1 = hf * 5 + 5; pg8::gemm_phase<pg8::EpiProj, pg8::WrapOrder, true>(F.lds + RING_OFF, g, S, E); if (hf == 0) xcd_barrier(bar); }
#else
            pg8::gemm_phase<pg8::EpiProj, pg8::WrapOrder, true>(F.lds + RING_OFF, g, S, E);
#endif
            SEAM(pb + 0);
        }
        if (IN(pb + 1)) {
            phase_attention(F, (char*)lds + RING_OFF, args.in[6], args, l);
            SEAM(pb + 1);
        }
        if (IN(pb + 2)) {
            pg8::Gemm g{UA, WCA, M, DM, 2048, 2048, 2048}; pg8::WrapOrder S; S.init(M, DM * REP_EF, F.G, fresh_bid()); S.wrapN = DM / 256;
            pg8::EpiGateBf16 E{MG, DM, PROJ + C_GC, INC}; pg8::MidGateRatio MH{PROJ + C_GC, INC};
            pg8::gemm_phase<pg8::EpiGateBf16, pg8::WrapOrder, true, pg8::MidGateRatio>(F.lds + RING_OFF, g, S, E, MH);
            SEAMG(pb + 2);
        }
        if (IN(pb + 3)) {
            pg8::Gemm g{MG, WMIX, M, DM, DM, DM, DM}; pg8::WrapOrder S; S.init(M, DM * REP_G, F.G, fresh_bid()); S.wrapN = DM / 256;
            pg8::EpiResBf16 E{XB, XB2, DM, SS};
            pg8::gemm_phase<pg8::EpiResBf16, pg8::WrapOrder, true>(F.lds + RING_OFF, g, S, E);
            SEAMG(pb + 3);
        }
        if (IN(pb + 4)) {
            pg8::Gemm g{XB2, WGU, M, 2 * FF, DM, DM, DM}; pg8::WrapOrder S; S.init(M, 2 * FF * REP_GU, F.G, fresh_bid()); S.wrapN = 2 * FF / 256;
            pg8::EpiSwiGLU E{GU, (long)256 * INC, SS};
            pg8::gemm_phase<pg8::EpiSwiGLU, pg8::WrapOrder, true>(F.lds + RING_OFF, g, S, E);
            SEAMG(pb + 4);
        }
        if (IN(pb + 5)) {
            pg8::Gemm g{GU, WDN, M, DM, FF, 64, FF, 256 * 64 * 2, (long)256 * INC * 2, true, true};       pg8::WrapOrder S; S.init(M, DM * REP_J, F.G, fresh_bid()); S.wrapN = DM / 256;
            pg8::EpiResBf16 E{XB2, XB, DM, SS};
            pg8::gemm_phase<pg8::EpiResBf16, pg8::WrapOrder, true>(F.lds + RING_OFF, g, S, E);
            SEAMG(pb + 5);
        }
    }
    if (IN(1 + DEPTH * PH_PER_LAYER)) phase_final_norm(F, args.in[12], args.out, paneled ? my_pm : -1, my_mi);
#undef IN
#undef SEAM
#undef SEAMG
}

#ifndef MK_PER_PHASE
#define MK_PER_PHASE 0
#endif
extern "C" void kernel_launch(void* const* d_in, const int* in_sizes, int n_in, void* d_out, int out_size, void* d_ws, size_t ws_size, hipStream_t stream) {
    static int grid = 0;
    if (grid == 0) {
        if (n_in != 13 || in_sizes[0] != M * DM || out_size != M * DM || ws_size < WS_END) {
            fprintf(stderr, "kernel_launch: unexpected shapes (n_in %d, in0 %d, out %d, ws %zu); nothing launched\n", n_in, n_in > 0 ? in_sizes[0] : -1, out_size, ws_size); grid = -1; return; }
        int dev = 0, cus = 0;
        if (hipGetDevice(&dev) != hipSuccess || hipDeviceGetAttribute(&cus, hipDeviceAttributeMultiprocessorCount, dev) != hipSuccess) { grid = -1; return; }
        if (hipFuncSetAttribute((const void*)trunk_fwd, hipFuncAttributeMaxDynamicSharedMemorySize, LDS_BYTES) != hipSuccess) { fprintf(stderr, "kernel_launch: hipFuncSetAttribute failed\n"); grid = -1; return; }
        int per_cu = 0;
        if (hipOccupancyMaxActiveBlocksPerMultiprocessor(&per_cu, (const void*)trunk_fwd, NWAVES * 64, LDS_BYTES) != hipSuccess || per_cu < 1)
            fprintf(stderr, "kernel_launch: note: occupancy query reports %d workgroups per CU\n", per_cu);
        (void)hipGetLastError();
        grid = cus;
    }
    if (grid < 0) return;
    if (hipMemsetAsync((char*)d_ws + WS_CTL, 0, CTL_ZERO_BYTES, stream) != hipSuccess) { fprintf(stderr, "kernel_launch: hipMemsetAsync failed\n"); return; }
    Args a{};
    for (int i = 0; i < 13; ++i) a.in[i] = (const float*)d_in[i];
    a.out = (float*)d_out; a.ws = (unsigned char*)d_ws;
#if MK_PER_PHASE
    for (int p = 0; p < N_PHASES; ++p) { a.ph_lo = p; a.ph_hi = p + 1; hipLaunchKernelGGL(trunk_fwd, dim3(grid), dim3(NWAVES * 64), LDS_BYTES, stream, a); }
#else
    a.ph_lo = 0; a.ph_hi = N_PHASES;
    hipLaunchKernelGGL(trunk_fwd, dim3(grid), dim3(NWAVES * 64), LDS_BYTES, stream, a);
#endif
    const hipError_t le = hipPeekAtLastError();
    if (le != hipSuccess) fprintf(stderr, "kernel_launch: launch failed: %s\n", hipGetErrorName(le));
}
```

```cpp
#include <hip/hip_runtime.h>
#include <cstdio>
#include <cstdint>

#ifndef REP_ATT
#define REP_ATT 1
#endif
#ifndef REP_BIG
#define REP_BIG 1
#endif
#ifndef REP_IN
#define REP_IN 1
#endif
#ifndef REP_GU
#define REP_GU 1
#endif
#ifndef REP_EF
#define REP_EF 1
#endif
#ifndef REP_G
#define REP_G 1
#endif
#ifndef REP_J
#define REP_J 1
#endif
#ifndef SPLIT_IN
#define SPLIT_IN 0
#endif
#ifndef REP_MISC
#define REP_MISC 1
#endif
constexpr int BATCH = 4, SEQ = 4096, DM = 2048, DEPTH = 4, CCH = 1024, AW = 1024, NH = 8, HD = 128, FF = 5632, INC = 10240;
constexpr int M = BATCH * SEQ;
constexpr int C_H = 0, C_B = 1024, C_C = 2048, C_Q = 3072, C_K = 4096, C_V = 5120, C_GC = 6144, C_GA = 8192;
constexpr float RMS_EPS = 1e-6f;
constexpr int NWAVES = 8;

#define GAS __attribute__((address_space(1)))
#define LAS __attribute__((address_space(3)))
typedef unsigned short bf16;
typedef unsigned v4u __attribute__((ext_vector_type(4)));
typedef float f32x4 __attribute__((ext_vector_type(4)));
typedef float f32x2 __attribute__((ext_vector_type(2)));
typedef float f32x16 __attribute__((ext_vector_type(16)));
typedef short bf16x8 __attribute__((ext_vector_type(8)));
typedef short s16x4 __attribute__((ext_vector_type(4)));
typedef unsigned u32x4 __attribute__((ext_vector_type(4)));
typedef unsigned u32x2 __attribute__((ext_vector_type(2)));
typedef GAS unsigned gu32;
#define RLX_AGENT __ATOMIC_RELAXED, __HIP_MEMORY_SCOPE_AGENT
#define LDS_WAIT() asm volatile("s_waitcnt lgkmcnt(0)" ::: "memory")
#define VM_WAIT() asm volatile("s_waitcnt vmcnt(0)" ::: "memory")

__device__ __forceinline__ int fresh_tid() { int t = threadIdx.x; asm volatile("" : "+v"(t)); return t; }
__device__ __forceinline__ int fresh_bid() { int b = blockIdx.x; asm volatile("" : "+s"(b)); return b; }
__device__ __forceinline__ unsigned cvt_pk_bf16(float lo, float hi) { unsigned r; asm volatile("v_cvt_pk_bf16_f32 %0, %1, %2" : "=v"(r) : "v"(lo), "v"(hi)); return r; }
__device__ __forceinline__ float bf_lo(unsigned w) { return __uint_as_float(w << 16); }
__device__ __forceinline__ float bf_hi(unsigned w) { return __uint_as_float(w & 0xffff0000u); }
__device__ __forceinline__ unsigned q8(float s) { return (unsigned)(s * 255.0f + 0.5f); }
__device__ __forceinline__ unsigned pack4(unsigned a, unsigned b, unsigned c, unsigned d) { return a | (b << 8) | (c << 16) | (d << 24); }
__device__ __forceinline__ float ub0(unsigned w) { return (float)(w & 0xffu); }
__device__ __forceinline__ float ub1(unsigned w) { return (float)((w >> 8) & 0xffu); }
__device__ __forceinline__ float ub2(unsigned w) { return (float)((w >> 16) & 0xffu); }
__device__ __forceinline__ float ub3(unsigned w) { return (float)(w >> 24); }
__device__ __forceinline__ float fast_sigmoid(float x) { return __builtin_amdgcn_rcpf(1.0f + __builtin_amdgcn_exp2f(-1.4426950408889634f * x)); }

constexpr int LDS_RB_OFF = 132096, LDS_RB_BYTES = 8192;
constexpr int LDS_XT_OFF = LDS_RB_OFF + 2 * LDS_RB_BYTES;
constexpr int LDS_TOTAL = 163840;
static_assert(LDS_XT_OFF + 4096 <= LDS_TOTAL, "LDS map");
namespace pg8 {
constexpr int BM = 256, BK = 64, HALF = 128, HTB = HALF * BK * 2  , STAGE_BYTES = 8 * HTB, NXCD = 8, WGM = 8;

__host__ __device__ __forceinline__ int lds_byte(int r, int c) { const int st = (r >> 4) * 2 + (c >> 5), rr = r & 15, cc = c & 31, ob = rr * 64 + cc * 2; return st * 1024 + (ob ^ (((ob >> 9) & 1) << 5)); }
__host__ __device__ __forceinline__ void stage_rc(int b, int& R, int& C) { const int st = b / 1024, sb = b % 1024, swz = sb ^ (((sb >> 9) & 1) << 5); R = (st >> 1) * 16 + swz / 64; C = (st & 1) * 32 + (swz % 64) / 2; }
__host__ __device__ __forceinline__ int perm32(int rho) { const int n = rho >> 4, i = rho & 15; return 8 * (i >> 2) + 4 * n + (i & 3); }

struct Unit { int pm, pn; };
struct Gemm { const bf16* A; const bf16* Bt; int M, N, K, lda, ldb; int kstepA = 0; long tstepA = 0; bool snake = false; bool splitA = false; };

struct StaticOrder {
    int nM, nN, nwg, G, c;
    __host__ __device__ void init(int M_, int N_, int G_, int c_) { nM = M_ / BM; nN = N_ / BM; nwg = nM * nN; G = G_; c = c_; }
    __host__ __device__ bool next(int i, Unit& u) const {
        const long L = (long)i * G + c; if (L >= nwg) return false;
        int wgid = (int)L; { const int q = nwg / NXCD, r = nwg % NXCD, xcd = wgid % NXCD, off = wgid / NXCD; wgid = (xcd < r ? xcd * (q + 1) : r * (q + 1) + (xcd - r) * q) + off; }
        const int nig = WGM * nN, gid = wgid / nig, fm = gid * WGM, gsz = (nM - fm) < WGM ? (nM - fm) : WGM;
        u.pm = fm + ((wgid % nig) % gsz); u.pn = (wgid % nig) / gsz; return true;
    }
};

struct WrapOrder : StaticOrder { int wrapN; int i0 = 0, i1 = 1 << 30;
    __host__ __device__ bool next(int i, Unit& u) const { if (i + i0 >= i1) return false; if (!StaticOrder::next(i + i0, u)) return false; u.pn %= wrapN; return true; } };

__device__ __forceinline__ void rs_prefetch(LAS unsigned char* lds, const float* SS8, const Unit& u, int ui, int wid, int lane) {
    const float* src = SS8 + ((size_t)u.pm * BM + 32 * wid) * 8 + lane * 4;
    __builtin_amdgcn_global_load_lds((const unsigned*)src, (LAS unsigned*)(lds + LDS_RB_OFF + (ui & 1) * LDS_RB_BYTES + wid * 1024), 16, 0, 0);
}
__device__ __forceinline__ void row_scales(LAS unsigned char* lds, int ui, int wr, int fr, float (&rs)[2][4]) {
    const LAS f32x4* rb = (const LAS f32x4*)(lds + LDS_RB_OFF + (ui & 1) * LDS_RB_BYTES);
#pragma unroll
    for (int ai = 0; ai < 2; ++ai)
#pragma unroll
        for (int m = 0; m < 4; ++m) { const int r = ai * HALF + wr * 64 + m * 16 + fr; const f32x4 x = rb[2 * r], y = rb[2 * r + 1];
            const float s = ((x[0] + x[1]) + (x[2] + x[3])) + ((y[0] + y[1]) + (y[2] + y[3]));
            rs[ai][m] = __builtin_amdgcn_rsqf(s * (1.0f / DM) + RMS_EPS); }
}
__device__ __forceinline__ float row_scale1(LAS unsigned char* lds, int ui, int r) {
    const LAS f32x4* rb = (const LAS f32x4*)(lds + LDS_RB_OFF + (ui & 1) * LDS_RB_BYTES);
    const f32x4 x = rb[2 * r], y = rb[2 * r + 1];
    return __builtin_amdgcn_rsqf((((x[0] + x[1]) + (x[2] + x[3])) + ((y[0] + y[1]) + (y[2] + y[3]))) * (1.0f / DM) + RMS_EPS);
}
struct RsPipe { f32x4 x, y;
    __device__ __forceinline__ void load(LAS unsigned char* lds, int ui, int r) { const LAS f32x4* rb = (const LAS f32x4*)(lds + LDS_RB_OFF + (ui & 1) * LDS_RB_BYTES); x = rb[2 * r]; y = rb[2 * r + 1]; }
    __device__ __forceinline__ float msq() const { return (((x[0] + x[1]) + (x[2] + x[3])) + ((y[0] + y[1]) + (y[2] + y[3]))) * (1.0f / DM) + RMS_EPS; }
};
#define RS_PIPE_BEGIN() RsPipe rs_nxt; rs_nxt.load(lds, ui, rl0)
#define RS_PIPE_STEP(cur_) const RsPipe cur_ = rs_nxt; { const int gn_ = ai * 4 + m + 1; if (gn_ < 8) rs_nxt.load(lds, ui, rl0 + (gn_ >> 2) * HALF + (gn_ & 3) * 16); } __builtin_amdgcn_sched_barrier(0)
struct EpiProj {
    static constexpr bool PERM = true, PREFETCH = true;
    bf16* O; int ldc; int sig_from; const float* SS; float* KP;
    __device__ __forceinline__ void prefetch(LAS unsigned char* lds, const Unit& u, int ui, int wid, int lane) const { rs_prefetch(lds, SS, u, ui, wid, lane); }
    __device__ __forceinline__ void operator()(const f32x4 (&acc)[2][2][4][2], const Unit& u, int wr, int wc, int fr, int fq, LAS unsigned char* lds, int ui) const {
        int row0 = u.pm * BM + wr * 64 + fr; const int colt = u.pn * BM;
        const bool sig = colt >= sig_from; const bool isk = colt >= C_K && colt < C_V; const bool isch = colt < C_B || (colt >= C_C && colt < C_Q);
        int col0 = colt + wc * 32 + 8 * fq;
        asm volatile("" : "+v"(row0), "+v"(col0));
        const int rl0 = wr * 64 + fr;
        RS_PIPE_BEGIN();
        if (sig) {
            const int gc0 = ((colt - sig_from) >> 1) + wc * 32 + 8 * fq;
#pragma unroll
            for (int ai = 0; ai < 2; ++ai)
#pragma unroll
                for (int m = 0; m < 4; ++m) { RS_PIPE_STEP(rsc); bf16* rowp = O + (size_t)(row0 + ai * HALF + m * 16) * ldc + gc0; const float k1 = -1.4426950408889634f * __builtin_amdgcn_rsqf(rsc.msq());
                    unsigned qc[8], qa[8];
#define SG8(A_) ((unsigned)(__builtin_amdgcn_rcpf(__builtin_fmaf(__builtin_amdgcn_exp2f((A_) * k1), 1.0f / 255.0f, 1.0f / 255.0f)) + 0.5f))
#pragma unroll
                    for (int e = 0; e < 4; ++e) { qc[e] = SG8(acc[ai][0][m][0][e]); qc[4 + e] = SG8(acc[ai][0][m][1][e]);
                        const unsigned a0 = SG8(acc[ai][1][m][0][e]), a1 = SG8(acc[ai][1][m][1][e]);
                        qa[e] = a0 < 1u ? 1u : a0; qa[4 + e] = a1 < 1u ? 1u : a1; }
                    u32x4 w; w.x = pack4(qc[0], qc[1], qc[2], qc[3]); w.y = pack4(qc[4], qc[5], qc[6], qc[7]); w.z = pack4(qa[0], qa[1], qa[2], qa[3]); w.w = pack4(qa[4], qa[5], qa[6], qa[7]);
                    *(u32x4*)(rowp + C_GC) = w; }
#undef SG8
            return;
        }
        if (isch) {
            const int pk = u.pn < 4 ? u.pn : u.pn - 4, cc0 = 128 * pk + wc * 32 + 8 * fq;
#pragma unroll
            for (int ai = 0; ai < 2; ++ai)
#pragma unroll
                for (int m = 0; m < 4; ++m) { RS_PIPE_STEP(rsc); const float r2 = __builtin_amdgcn_rcpf(rsc.msq());
                    const f32x4 p0 = acc[ai][0][m][0] * acc[ai][1][m][0] * r2, p1 = acc[ai][0][m][1] * acc[ai][1][m][1] * r2;
                    u32x4 w; w.x = cvt_pk_bf16(p0[0], p0[1]); w.y = cvt_pk_bf16(p0[2], p0[3]); w.z = cvt_pk_bf16(p1[0], p1[1]); w.w = cvt_pk_bf16(p1[2], p1[3]);
                    *(u32x4*)(O + (size_t)(row0 + ai * HALF + m * 16) * ldc + C_H + cc0) = w; }
            return;
        }
#pragma unroll
        for (int ai = 0; ai < 2; ++ai)
#pragma unroll
            for (int m = 0; m < 4; ++m) { RS_PIPE_STEP(rsc); bf16* rowp = O + (size_t)(row0 + ai * HALF + m * 16) * ldc + col0; const float rsv = __builtin_amdgcn_rsqf(rsc.msq());
#pragma unroll
                for (int bj = 0; bj < 2; ++bj) { f32x4 v0 = acc[ai][bj][m][0] * rsv, v1 = acc[ai][bj][m][1] * rsv;
                    u32x4 w; w.x = cvt_pk_bf16(v0[0], v0[1]); w.y = cvt_pk_bf16(v0[2], v0[3]); w.z = cvt_pk_bf16(v1[0], v1[1]); w.w = cvt_pk_bf16(v1[2], v1[3]);
                    *(u32x4*)(rowp + bj * HALF) = w; }
                __builtin_amdgcn_sched_barrier(0); }
        if (isk) {
            f32x4 cs[2][2];
#pragma unroll
            for (int bj = 0; bj < 2; ++bj)
#pragma unroll
                for (int n = 0; n < 2; ++n) { f32x4 t = (f32x4){0.f, 0.f, 0.f, 0.f};
#pragma unroll
                    for (int ai = 0; ai < 2; ++ai)
#pragma unroll
                        for (int m = 0; m < 4; ++m) t += acc[ai][bj][m][n] * row_scale1(lds, ui, rl0 + ai * HALF + m * 16);
                    cs[bj][n] = t; }
#pragma unroll
            for (int bj = 0; bj < 2; ++bj)
#pragma unroll
                for (int n = 0; n < 2; ++n)
#pragma unroll
                    for (int e = 0; e < 4; ++e) { float x = cs[bj][n][e]; x += __shfl_xor(x, 1); x += __shfl_xor(x, 2); x += __shfl_xor(x, 4); x += __shfl_xor(x, 8); cs[bj][n][e] = x; }
            if (fr == 0) { float* kp = KP + (size_t)(u.pm * 2 + wr) * 1024 + (colt - C_K) + wc * 32 + 8 * fq;
#pragma unroll
                for (int bj = 0; bj < 2; ++bj) { *(f32x4*)(kp + bj * HALF) = cs[bj][0]; *(f32x4*)(kp + bj * HALF + 4) = cs[bj][1]; } }
        }
    }
};
struct MidGateRatio {
    static constexpr bool ENABLED = true;
    const bf16* R; int ldg;
    __device__ __forceinline__ void operator()(f32x4 (&acc)[2][2][4][2], const Unit& u, int wr, int wc, int fr, int fq) const {
        int row0 = u.pm * BM + wr * 64 + fr; int col0 = u.pn * BM + wc * 32 + 8 * fq;
        asm volatile("" : "+v"(row0), "+v"(col0));
        const char* base = (const char*)R + ((size_t)row0 * ldg + col0) * 2;
        const size_t rstep = (size_t)ldg * 32;
        u32x4 rr[2][4][2];
#pragma unroll
        for (int ai = 0; ai < 2; ++ai)
#pragma unroll
            for (int m = 0; m < 4; ++m) { const char* p = base + (size_t)(ai * 8 + m) * rstep;
#pragma unroll
                for (int bj = 0; bj < 2; ++bj) rr[ai][m][bj] = *(const u32x4*)(p + bj * 256); }
        __builtin_amdgcn_sched_barrier(0);
#pragma unroll
        for (int ai = 0; ai < 2; ++ai)
#pragma unroll
            for (int m = 0; m < 4; ++m)
#pragma unroll
                for (int bj = 0; bj < 2; ++bj) { const u32x4 c = rr[ai][m][bj];
                    acc[ai][bj][m][0] *= (f32x4){ub0(c.x) * __builtin_amdgcn_rcpf(ub0(c.z)), ub1(c.x) * __builtin_amdgcn_rcpf(ub1(c.z)), ub2(c.x) * __builtin_amdgcn_rcpf(ub2(c.z)), ub3(c.x) * __builtin_amdgcn_rcpf(ub3(c.z))};
                    acc[ai][bj][m][1] *= (f32x4){ub0(c.y) * __builtin_amdgcn_rcpf(ub0(c.w)), ub1(c.y) * __builtin_amdgcn_rcpf(ub1(c.w)), ub2(c.y) * __builtin_amdgcn_rcpf(ub2(c.w)), ub3(c.y) * __builtin_amdgcn_rcpf(ub3(c.w))}; }
        __builtin_amdgcn_sched_barrier(0);
    }
};
struct EpiGateBf16 {
    static constexpr bool PERM = true, PREFETCH = false;
    bf16* O; int ldc; const bf16* G; int ldg;
    __device__ __forceinline__ void operator()(const f32x4 (&acc)[2][2][4][2], const Unit& u, int wr, int wc, int fr, int fq, LAS unsigned char* lds, int ui) const {
        const int row0 = u.pm * BM + wr * 64 + fr; const int col0 = u.pn * BM + wc * 32 + 8 * fq;
        u32x2 gg[2][4][2];
#pragma unroll
        for (int ai = 0; ai < 2; ++ai)
#pragma unroll
            for (int m = 0; m < 4; ++m)
#pragma unroll
                for (int bj = 0; bj < 2; ++bj) gg[ai][m][bj] = *(const u32x2*)((const char*)(G + (size_t)(row0 + ai * HALF + m * 16) * ldg + col0 + bj * HALF) + 8);
        __builtin_amdgcn_sched_barrier(0);
        const float k = 1.0f / 255.0f;
#pragma unroll
        for (int ai = 0; ai < 2; ++ai)
#pragma unroll
            for (int m = 0; m < 4; ++m) { const size_t r = (size_t)(row0 + ai * HALF + m * 16);
#pragma unroll
                for (int bj = 0; bj < 2; ++bj) { const u32x2 g = gg[ai][m][bj];
                    f32x4 v0 = acc[ai][bj][m][0] * k, v1 = acc[ai][bj][m][1] * k;
                    v0[0] *= ub0(g.x); v0[1] *= ub1(g.x); v0[2] *= ub2(g.x); v0[3] *= ub3(g.x);
                    v1[0] *= ub0(g.y); v1[1] *= ub1(g.y); v1[2] *= ub2(g.y); v1[3] *= ub3(g.y);
                    u32x4 w; w.x = cvt_pk_bf16(v0[0], v0[1]); w.y = cvt_pk_bf16(v0[2], v0[3]); w.z = cvt_pk_bf16(v1[0], v1[1]); w.w = cvt_pk_bf16(v1[2], v1[3]);
                    *(u32x4*)(O + r * ldc + col0 + bj * HALF) = w; } }
    }
};
struct EpiResBf16 {
    static constexpr bool PERM = true, PREFETCH = false;
    const bf16* X; bf16* XO; int ldc; float* SS;
    __device__ __forceinline__ void operator()(const f32x4 (&acc)[2][2][4][2], const Unit& u, int wr, int wc, int fr, int fq, LAS unsigned char* lds, int ui) const {
        const int row0 = u.pm * BM + wr * 64 + fr; const int col0 = u.pn * BM + wc * 32 + 8 * fq;
        LAS float* XT = (LAS float*)(lds + LDS_XT_OFF);
        u32x4 xx[2][4][2];
#pragma unroll
        for (int ai = 0; ai < 2; ++ai)
#pragma unroll
            for (int m = 0; m < 4; ++m)
#pragma unroll
                for (int bj = 0; bj < 2; ++bj) xx[ai][m][bj] = *(const u32x4*)(X + (size_t)(row0 + ai * HALF + m * 16) * ldc + col0 + bj * HALF);
        __builtin_amdgcn_sched_barrier(0);
#pragma unroll
        for (int ai = 0; ai < 2; ++ai)
#pragma unroll
            for (int m = 0; m < 4; ++m) { const size_t r = (size_t)(row0 + ai * HALF + m * 16); float ss = 0.f;
#pragma unroll
                for (int bj = 0; bj < 2; ++bj) { bf16* xp = XO + r * ldc + col0 + bj * HALF; const u32x4 xo = xx[ai][m][bj];
                    f32x4 v0 = acc[ai][bj][m][0], v1 = acc[ai][bj][m][1];
                    v0[0] += bf_lo(xo.x); v0[1] += bf_hi(xo.x); v0[2] += bf_lo(xo.y); v0[3] += bf_hi(xo.y);
                    v1[0] += bf_lo(xo.z); v1[1] += bf_hi(xo.z); v1[2] += bf_lo(xo.w); v1[3] += bf_hi(xo.w);
                    ss += ((v0[0] * v0[0] + v0[1] * v0[1]) + (v0[2] * v0[2] + v0[3] * v0[3])) + ((v1[0] * v1[0] + v1[1] * v1[1]) + (v1[2] * v1[2] + v1[3] * v1[3]));
                    u32x4 w; w.x = cvt_pk_bf16(v0[0], v0[1]); w.y = cvt_pk_bf16(v0[2], v0[3]); w.z = cvt_pk_bf16(v1[0], v1[1]); w.w = cvt_pk_bf16(v1[2], v1[3]);
                    *(u32x4*)xp = w; }
                ss += __shfl_xor(ss, 16); ss += __shfl_xor(ss, 32);
                if (fq == 0) XT[(ai * HALF + wr * 64 + m * 16 + fr) * 4 + wc] = ss; }
        asm volatile("s_waitcnt lgkmcnt(0)" ::: "memory"); __builtin_amdgcn_s_barrier(); asm volatile("" ::: "memory");
        const int t = fresh_tid();
        if (t < 256) { const f32x4 p = *(const LAS f32x4*)(XT + t * 4); SS[((size_t)u.pm * BM + t) * 8 + u.pn] = (p[0] + p[1]) + (p[2] + p[3]); }
        asm volatile("s_waitcnt lgkmcnt(0)" ::: "memory");
    }
};
struct EpiSwiGLU {
    static constexpr bool PERM = true, PREFETCH = true;
    bf16* O; long pstep; const float* SS;
    __device__ __forceinline__ void prefetch(LAS unsigned char* lds, const Unit& u, int ui, int wid, int lane) const { rs_prefetch(lds, SS, u, ui, wid, lane); }
    __device__ __forceinline__ void operator()(const f32x4 (&acc)[2][2][4][2], const Unit& u, int wr, int wc, int fr, int fq, LAS unsigned char* lds, int ui) const {
        bf16* tbase = O + (size_t)u.pm * pstep + ((size_t)(u.pn * 4 + wc) * BM + wr * 64 + fr) * 32 + 8 * fq;
        const int rl0 = wr * 64 + fr;
        RS_PIPE_BEGIN();
#pragma unroll
        for (int ai = 0; ai < 2; ++ai)
#pragma unroll
            for (int m = 0; m < 4; ++m) { RS_PIPE_STEP(rsc); bf16* rowp = tbase + (ai * HALF + m * 16) * 32;
                const float irs2 = rsc.msq();
                const float k1 = -1.4426950408889634f * __builtin_amdgcn_rsqf(irs2);
                f32x4 v0, v1;
#pragma unroll
                for (int e = 0; e < 4; ++e) { const float a0 = acc[ai][0][m][0][e], a1 = acc[ai][0][m][1][e];
                    const float d0 = __builtin_fmaf(__builtin_amdgcn_exp2f(a0 * k1), irs2, irs2), d1 = __builtin_fmaf(__builtin_amdgcn_exp2f(a1 * k1), irs2, irs2);
                    v0[e] = (a0 * acc[ai][1][m][0][e]) * __builtin_amdgcn_rcpf(d0); v1[e] = (a1 * acc[ai][1][m][1][e]) * __builtin_amdgcn_rcpf(d1); }
                u32x4 w; w.x = cvt_pk_bf16(v0[0], v0[1]); w.y = cvt_pk_bf16(v0[2], v0[3]); w.z = cvt_pk_bf16(v1[0], v1[1]); w.w = cvt_pk_bf16(v1[2], v1[3]);
                *(u32x4*)rowp = w; }
    }
};

struct NoMid { static constexpr bool ENABLED = false; __device__ __forceinline__ void operator()(f32x4 (&)[2][2][4][2], const Unit&, int, int, int, int) const {} };
template <class Epi, class Sched, bool ALIGN_EPI, class Mid = NoMid>
__device__ __forceinline__ void gemm_phase(LAS unsigned char* lds, const Gemm g, const Sched& S, const Epi& E, const Mid& MH = Mid()) {
    int tid = fresh_tid(); const int wid = __builtin_amdgcn_readfirstlane(tid >> 6); int lane = tid & 63; const int wr = wid >> 2, wc = wid & 3; int fr = lane & 15, fq = lane >> 4;
    const int K = g.K, nt = K / BK;
    unsigned voffA[2], voffB[2]; int aoff, boff;
#define PG8_LANE_CONSTS() do { _Pragma("unroll") for (int i_ = 0; i_ < 2; ++i_) { int R_, C_; stage_rc(tid * 16 + i_ * 8192, R_, C_); const int Rb_ = Epi::PERM ? ((R_ & ~31) + perm32(R_ & 31)) : R_; \
        voffA[i_] = g.splitA ? (unsigned)((C_ >> 5) * 256 * 32 + R_ * 32 + (C_ & 31)) * 2u : (unsigned)(R_ * g.lda + C_) * 2u; voffB[i_] = (unsigned)(Rb_ * g.ldb + C_) * 2u; } \
        aoff = lds_byte(wr * 64 + fr, fq * 8); boff = lds_byte(wc * 32 + fr, fq * 8); } while (0)
    PG8_LANE_CONSTS();
    const size_t kstep = (size_t)(BK * 2);
    const size_t kstepA = g.kstepA ? (size_t)g.kstepA : kstep;
    const size_t hstepA = g.splitA ? (size_t)HALF * 32 * 2 : (size_t)HALF * g.lda * 2, hstepB = (size_t)HALF * g.ldb * 2;
    const size_t tstepA = g.tstepA ? (size_t)g.tstepA : 2 * hstepA, tstepB = 2 * hstepB;
    const unsigned ldsw = (unsigned)wid * 1024u;
#define PG8_SA(b, h) (((b) * 2 + (h)) * HTB)
#define PG8_SB(b, h) ((4 + (b) * 2 + (h)) * HTB)
#define PG8_STAGE(bufoff, gbase, voff) do { _Pragma("unroll") for (int _i = 0; _i < 2; ++_i) \
        __builtin_amdgcn_global_load_lds((const unsigned*)((const char*)(gbase) + (voff)[_i]), (LAS unsigned*)(lds + (bufoff) + ldsw + _i * 8192), 16, 0, 0); } while (0)
#define PG8_LDA(dst, b, h) do { _Pragma("unroll") for (int m = 0; m < 4; ++m) _Pragma("unroll") for (int k = 0; k < 2; ++k) dst[m][k] = *(const LAS bf16x8*)(lds + PG8_SA(b, h) + aoff + m * 2048 + k * 1024); } while (0)
#define PG8_LDB(dst, b, h) do { _Pragma("unroll") for (int n = 0; n < 2; ++n) _Pragma("unroll") for (int k = 0; k < 2; ++k) dst[n][k] = *(const LAS bf16x8*)(lds + PG8_SB(b, h) + boff + n * 2048 + k * 1024); } while (0)
#define PG8_MMA(ai, bj, At, Bt) do { __builtin_amdgcn_s_setprio(1); _Pragma("unroll") for (int m = 0; m < 4; ++m) _Pragma("unroll") for (int n = 0; n < 2; ++n) _Pragma("unroll") for (int k = 0; k < 2; ++k) \
        acc[ai][bj][m][n] = __builtin_amdgcn_mfma_f32_16x16x32_bf16(Bt[n][k], At[m][k], acc[ai][bj][m][n], 0, 0, 0); __builtin_amdgcn_s_setprio(0); } while (0)
#define PG8_WAIT_V(n) asm volatile("s_waitcnt vmcnt(" #n ")" ::: "memory")
#define PG8_WAIT_L(n) asm volatile("s_waitcnt lgkmcnt(" #n ")" ::: "memory")
#define PG8_BAR __builtin_amdgcn_s_barrier()
#define PG8_SCHED __builtin_amdgcn_sched_barrier(0)
    Unit cur, nxt; int ui = 0;
    if (!S.next(0, cur)) return;
    const bool snake = g.snake;
    const size_t spanA = (size_t)(nt - 1) * kstepA, spanB = (size_t)(nt - 1) * kstep;
    long sA = snake ? -(long)kstepA : (long)kstepA, sB = snake ? -(long)kstep : (long)kstep;
    f32x4 acc[2][2][4][2];
#pragma unroll
    for (int a = 0; a < 2; ++a)
#pragma unroll
        for (int b = 0; b < 2; ++b)
#pragma unroll
            for (int m = 0; m < 4; ++m)
#pragma unroll
                for (int n = 0; n < 2; ++n) acc[a][b][m][n] = (f32x4){0.f, 0.f, 0.f, 0.f};
    bf16x8 At[4][2], B0[2][2], B1[2][2];
    const char* cA = (const char*)g.A + (size_t)cur.pm * tstepA + (snake ? spanA : 0); const char* cB = (const char*)g.Bt + (size_t)cur.pn * tstepB + (snake ? spanB : 0);
    if constexpr (Epi::PREFETCH) E.prefetch(lds, cur, 0, wid, lane);
    PG8_STAGE(PG8_SB(0, 0), cB, voffB); PG8_STAGE(PG8_SB(0, 1), cB + hstepB, voffB); PG8_STAGE(PG8_SA(0, 0), cA, voffA); PG8_STAGE(PG8_SA(0, 1), cA + hstepA, voffA);
    if (wr == 1) PG8_BAR;
    PG8_WAIT_V(2); PG8_BAR;
    PG8_STAGE(PG8_SB(1, 0), cB + sB, voffB); PG8_STAGE(PG8_SA(1, 0), cA + sA, voffA); PG8_STAGE(PG8_SB(1, 1), cB + hstepB + sB, voffB);
    PG8_WAIT_V(6); PG8_BAR;
    for (;;) {
        if (ui > 0) { tid = fresh_tid(); lane = tid & 63; fr = lane & 15; fq = lane >> 4; PG8_LANE_CONSTS(); }
        const bool has_next = S.next(ui + 1, nxt);
        const long nsA = has_next ? (snake ? -sA : sA) : 0, nsB = has_next ? (snake ? -sB : sB) : 0;
        const char* nA = has_next ? (const char*)g.A + (size_t)nxt.pm * tstepA + (nsA < 0 ? spanA : 0) : cA; const char* nB = has_next ? (const char*)g.Bt + (size_t)nxt.pn * tstepB + (nsB < 0 ? spanB : 0) : cB;
        for (int t = 0; t < nt; t += 2) {
            if constexpr (Mid::ENABLED) { if (t == (nt >> 1)) MH(acc, cur, wr, wc, fr, fq); }
            const bool last = (t == nt - 2);
            const char* a1 = cA + (long)(t + 1) * sA;
            const char* a2 = last ? nA : cA + (long)(t + 2) * sA; const char* b2 = last ? nB : cB + (long)(t + 2) * sB;
            const char* a3 = a2 + (last ? nsA : sA); const char* b3 = b2 + (last ? nsB : sB);
            PG8_LDB(B0, 0, 0); PG8_LDB(B1, 0, 1); PG8_SCHED; PG8_LDA(At, 0, 0); PG8_STAGE(PG8_SA(1, 1), a1 + hstepA, voffA);
            PG8_WAIT_V(8); PG8_WAIT_L(0); PG8_BAR; PG8_MMA(0, 0, At, B0); PG8_MMA(0, 1, At, B1); PG8_BAR; PG8_SCHED;
            PG8_LDA(At, 0, 1); PG8_STAGE(PG8_SB(0, 0), b2, voffB); PG8_STAGE(PG8_SB(0, 1), b2 + hstepB, voffB); PG8_STAGE(PG8_SA(0, 0), a2, voffA);
            PG8_WAIT_V(8); PG8_WAIT_L(0); PG8_BAR; PG8_MMA(1, 0, At, B0); PG8_MMA(1, 1, At, B1); PG8_BAR; PG8_SCHED;
            PG8_LDB(B0, 1, 0); PG8_LDB(B1, 1, 1); PG8_SCHED; PG8_LDA(At, 1, 0); PG8_STAGE(PG8_SA(0, 1), a2 + hstepA, voffA);
            PG8_WAIT_V(8); PG8_WAIT_L(0); PG8_BAR; PG8_MMA(0, 0, At, B0); PG8_MMA(0, 1, At, B1); PG8_BAR; PG8_SCHED;
            PG8_LDA(At, 1, 1); PG8_STAGE(PG8_SB(1, 0), b3, voffB); PG8_STAGE(PG8_SB(1, 1), b3 + hstepB, voffB); PG8_STAGE(PG8_SA(1, 0), a3, voffA);
            PG8_WAIT_V(8); PG8_WAIT_L(0); PG8_BAR; PG8_MMA(1, 0, At, B0); PG8_MMA(1, 1, At, B1); PG8_BAR; PG8_SCHED;
        }
        if constexpr (ALIGN_EPI) { if (wr == 0) PG8_BAR; }
        E(acc, cur, wr, wc, fr, fq, lds, ui);
        if (!has_next) break;
#pragma unroll
        for (int a = 0; a < 2; ++a)
#pragma unroll
            for (int b = 0; b < 2; ++b)
#pragma unroll
                for (int m = 0; m < 4; ++m)
#pragma unroll
                    for (int n = 0; n < 2; ++n) acc[a][b][m][n] = (f32x4){0.f, 0.f, 0.f, 0.f};
        cur = nxt; cA = nA; cB = nB; sA = nsA; sB = nsB; ++ui;
        if constexpr (Epi::PREFETCH) E.prefetch(lds, cur, ui, wid, lane);
        if constexpr (ALIGN_EPI) { if (wr == 1) PG8_BAR; }
    }
    PG8_WAIT_V(0);
    if constexpr (!ALIGN_EPI) { if (wr == 0) PG8_BAR; }
    PG8_BAR;
#undef PG8_LANE_CONSTS
#undef PG8_SA
#undef PG8_SB
#undef PG8_STAGE
#undef PG8_LDA
#undef PG8_LDB
#undef PG8_MMA
#undef PG8_WAIT_V
#undef PG8_WAIT_L
#undef PG8_BAR
#undef PG8_SCHED
}
}

namespace att {
constexpr int D = 128, NW = 8, QBLK = 32, KVBLK = 64, QB = NW * QBLK;
constexpr int PQ = INC;
constexpr int PO = 2048;
constexpr int SHM_V = KVBLK * D * 2, SHM_K = KVBLK * D * 2;
constexpr int LDS_WS = 2 * SHM_V + 2 * SHM_K;
constexpr int LDS_KM = LDS_WS + NW * 64 * 4;
constexpr int LDS_LUT = LDS_KM + 16 * 128 * 4;
constexpr int LDS_BYTES = LDS_LUT + 128 * 4;
constexpr float SCALE = 0.08838834764831845f;
constexpr float THR = 8.f;

#define KSWZ(row, colB) ((row) * 256 + ((colB) ^ (((row) & 15) << 4)))
#define SBAR() __builtin_amdgcn_sched_barrier(0)
__device__ __forceinline__ int v_st(int k, int c) { const int kk = (k & ~0xC) | ((k & 4) << 1) | ((k & 8) >> 1); return ((kk >> 3) * 4 + (c >> 5)) * 512 + ((kk & 7) * 32 + (c & 31)) * 2; }
__device__ __forceinline__ int v_rd_base(int lane) { return ((lane & 3) << 3) | (((lane >> 2) & 3) << 6) | (((lane >> 4) & 1) << 5) | (((lane >> 5) & 1) << 8); }
constexpr int v_rd_off(int d0, int ks, int half) { return d0 * 512 + ks * 4096 + half * 2048; }
__device__ __forceinline__ int crow(int r, int hi) { return (r & 3) + 8 * (r >> 2) + 4 * hi; }
__device__ __forceinline__ unsigned cvtpk(float lo, float hi) { unsigned r; asm volatile("v_cvt_pk_bf16_f32 %0, %1, %2" : "=v"(r) : "v"(lo), "v"(hi)); return r; }
__device__ __forceinline__ bf16x8 load8(const bf16* p) { return *reinterpret_cast<const bf16x8*>(p); }

__device__ __forceinline__ bool moba_mask(f32x16& p0, f32x16& p1, int kb, int ib, int qm, unsigned selmask, const float* LUT, int qlo) {
    const float NEG = -__builtin_inff();
    const int jb = kb >> 8;
    if (kb + 63 + 113 <= qlo) {
        return jb != ib && ((selmask >> jb) & 1u) == 0u;
    } else {
        const bool ok = (jb == ib) || ((selmask >> jb) & 1u);
        const int dq = qm - kb;
#pragma unroll
        for (int g = 0; g < 4; ++g) {
#pragma unroll
            for (int e = 0; e < 4; ++e) { const int r = 4 * g + e;
                const int c = (r & 3) + 8 * (r >> 2);
                const int d0 = dq - c, d1 = d0 - 32;
                const int i0 = d0 < 0 ? 0 : (d0 > 127 ? 127 : d0), i1 = d1 < 0 ? 0 : (d1 > 127 ? 127 : d1);
                const float b0 = LUT[i0], b1 = LUT[i1];
                p0[r] = (ok && d0 >= 0) ? p0[r] + b0 : NEG;
                p1[r] = (ok && d1 >= 0) ? p1[r] + b1 : NEG; }
            SBAR();
        }
    }
    return false;
}
__device__ __forceinline__ void partialSM(f32x16& p0, f32x16& p1, float& m_reg, float& mn, float& alpha, bool dead) {
    float pmax;
    { float ma = p0[0], mb = p1[0];
#pragma unroll
      for (int r = 1; r < 16; ++r) { ma = fmaxf(ma, p0[r]); mb = fmaxf(mb, p1[r]); }
      pmax = fmaxf(ma, mb); }
    { auto rr = __builtin_amdgcn_permlane32_swap(__float_as_uint(pmax), __float_as_uint(pmax), false, false);
      pmax = fmaxf(__uint_as_float(rr[0]), __uint_as_float(rr[1])); }
    constexpr float C2 = 1.4426950408889634f * SCALE;
    if (__builtin_expect(__all((pmax - m_reg) * SCALE <= THR), 1)) { mn = m_reg; alpha = 1.f; }
    else { mn = fmaxf(m_reg, pmax); alpha = __builtin_amdgcn_exp2f((m_reg - mn) * C2); m_reg = mn; }
    const float mnL = dead ? -__builtin_inff() : -mn * C2;
    for (int r = 0; r < 16; ++r) p0[r] = fmaf(p0[r], C2, mnL); for (int r = 0; r < 16; ++r) p1[r] = fmaf(p1[r], C2, mnL);
    for (int r = 0; r < 16; ++r) p0[r] = __builtin_amdgcn_exp2f(p0[r]);
}
__device__ __forceinline__ void finishSM(f32x16& p0, f32x16& p1, float alpha, float& l_reg, bf16x8& pa0, bf16x8& pa1, bf16x8& pa2, bf16x8& pa3) {
    for (int r = 0; r < 16; ++r) p1[r] = __builtin_amdgcn_exp2f(p1[r]);
    float ps;
    { float s0 = p0[0], s1 = p0[1], s2 = p0[2], s3 = p0[3];
#define ADDF(a_, b_) asm("v_add_f32 %0, %0, %1" : "+v"(a_) : "v"(b_))
#pragma unroll
      for (int r = 4; r < 16; r += 4) { ADDF(s0, p0[r]); ADDF(s1, p0[r + 1]); ADDF(s2, p0[r + 2]); ADDF(s3, p0[r + 3]); }
#pragma unroll
      for (int r = 0; r < 16; r += 4) { ADDF(s0, p1[r]); ADDF(s1, p1[r + 1]); ADDF(s2, p1[r + 2]); ADDF(s3, p1[r + 3]); }
      ADDF(s0, s1); ADDF(s2, s3); ADDF(s0, s2); ps = s0; }
#undef ADDF
    { auto rr = __builtin_amdgcn_permlane32_swap(__float_as_uint(ps), __float_as_uint(ps), false, false);
      ps = __uint_as_float(rr[0]) + __uint_as_float(rr[1]); }
    l_reg = l_reg * alpha + ps;
#define PK4(P, B_, OUT) do { unsigned a0 = cvtpk(P[B_+0], P[B_+1]), a1 = cvtpk(P[B_+2], P[B_+3]);                          \
        unsigned b0 = cvtpk(P[B_+4], P[B_+5]), b1 = cvtpk(P[B_+6], P[B_+7]);                                             \
        auto r0 = __builtin_amdgcn_permlane32_swap(a0, b0, false, false); auto r1 = __builtin_amdgcn_permlane32_swap(a1, b1, false, false); \
        u32x4 w = {r0[0], r1[0], r0[1], r1[1]}; OUT = *reinterpret_cast<bf16x8*>(&w); } while (0)
    PK4(p0, 0, pa0); PK4(p0, 8, pa1); PK4(p1, 0, pa2); PK4(p1, 8, pa3);
#undef PK4
}
template <int KB>
__device__ __forceinline__ void qkt(f32x16& p0, f32x16& p1, const char* K_lds, int r32, int hi, const bf16x8* qr) {
    p0 = f32x16{}; p1 = f32x16{};
    const int base = (int)(uintptr_t)K_lds;
    int ad[4];
#pragma unroll
    for (int dd = 0; dd < 4; ++dd) ad[dd] = base + KSWZ(r32, (dd * 16 + hi * 8) * 2);
    const int d47 = 128 - ((r32 & 8) << 5);
#define KRD(dst, addr, off) asm volatile("ds_read_b128 %0, %1 offset:%2" : "=&v"(dst) : "v"(addr), "i"(off) : "memory")
#define KWAIT(n, x, y) asm volatile("s_waitcnt lgkmcnt(" #n ")" : "+v"(x), "+v"(y) :: "memory")
    bf16x8 fa0, fb0, fa1, fb1;
    KRD(fa0, ad[0], KB * SHM_K); KRD(fb0, ad[0], KB * SHM_K + 32 * 256);
#define QK_STEP(d0, FA, FB, NA, NB) do {                                                                                        \
        if ((d0) < 7) { const int an_ = ad[((d0) + 1) & 3] + ((((d0) + 1) >> 2) ? d47 : 0); KRD(NA, an_, KB * SHM_K); KRD(NB, an_, KB * SHM_K + 32 * 256); KWAIT(2, FA, FB); } \
        else KWAIT(0, FA, FB);                                                                                                  \
        p0 = __builtin_amdgcn_mfma_f32_32x32x16_bf16(FA, qr[d0], p0, 0, 0, 0);                                                 \
        p1 = __builtin_amdgcn_mfma_f32_32x32x16_bf16(FB, qr[d0], p1, 0, 0, 0); } while (0)
    QK_STEP(0, fa0, fb0, fa1, fb1); QK_STEP(1, fa1, fb1, fa0, fb0); QK_STEP(2, fa0, fb0, fa1, fb1); QK_STEP(3, fa1, fb1, fa0, fb0);
    QK_STEP(4, fa0, fb0, fa1, fb1); QK_STEP(5, fa1, fb1, fa0, fb0); QK_STEP(6, fa0, fb0, fa1, fb1); QK_STEP(7, fa1, fb1, fa0, fb0);
#undef QK_STEP
#undef KRD
#undef KWAIT
}
template <int VB>
__device__ __forceinline__ void pv_tile(f32x16* o, int vb0, bf16x8 pa0, bf16x8 pa1, bf16x8 pa2, bf16x8 pa3) {
#define TRRD(dst, off) asm volatile("ds_read_b64_tr_b16 %0, %1 offset:%2" : "=&v"(dst) : "v"(vb0), "i"(off) : "memory")
#define PV_D0(d0) do { s16x4 l0, l1, l2, l3, h0, h1, h2, h3; constexpr int b_ = VB * SHM_V + v_rd_off(d0, 0, 0); \
        TRRD(l0, b_); TRRD(h0, b_ + 2048); TRRD(l1, b_ + 4096); TRRD(h1, b_ + 6144); TRRD(l2, b_ + 8192); TRRD(h2, b_ + 10240); TRRD(l3, b_ + 12288); TRRD(h3, b_ + 14336); \
        asm volatile("s_waitcnt lgkmcnt(0)" ::: "memory"); SBAR();   \
        o[d0] = __builtin_amdgcn_mfma_f32_32x32x16_bf16(pa0, (bf16x8){l0[0], l0[1], l0[2], l0[3], h0[0], h0[1], h0[2], h0[3]}, o[d0], 0, 0, 0);   \
        o[d0] = __builtin_amdgcn_mfma_f32_32x32x16_bf16(pa1, (bf16x8){l1[0], l1[1], l1[2], l1[3], h1[0], h1[1], h1[2], h1[3]}, o[d0], 0, 0, 0);   \
        o[d0] = __builtin_amdgcn_mfma_f32_32x32x16_bf16(pa2, (bf16x8){l2[0], l2[1], l2[2], l2[3], h2[0], h2[1], h2[2], h2[3]}, o[d0], 0, 0, 0);   \
        o[d0] = __builtin_amdgcn_mfma_f32_32x32x16_bf16(pa3, (bf16x8){l3[0], l3[1], l3[2], l3[3], h3[0], h3[1], h3[2], h3[3]}, o[d0], 0, 0, 0); } while (0)
    PV_D0(0); PV_D0(1); PV_D0(2); PV_D0(3);
#undef PV_D0
#undef TRRD
}

struct BlockRef { const bf16* Q; const bf16* K; const bf16* V; bf16* O; int P0; };
struct Seam { bf16x8 qr[8]; };
#define VMW() asm volatile("s_waitcnt vmcnt(0)" ::: "memory")
struct DmaMap { unsigned koff, voff; };
__device__ __forceinline__ DmaMap dma_map(int wid, int lane) {
    DmaMap d;
    { const int row = 4 * wid + (lane >> 4), g = (lane & 15) ^ (row & 15); d.koff = (unsigned)(row * PQ + g * 8); }
    { const int B = 2 * wid + (lane >> 5), kk = (B >> 2) * 8 + ((lane & 31) >> 2), c = (B & 3) * 32 + (lane & 3) * 8;
      const int k = (kk & ~0xC) | ((kk & 4) << 1) | ((kk & 8) >> 1); d.voff = (unsigned)(k * PQ + c); }
    return d;
}
#define DMA16(g_, l_) __builtin_amdgcn_global_load_lds((const unsigned*)(g_), (LAS unsigned*)(l_), 16, 0, 0)
#define DMA_K(bf, k0) do { const bf16* g_ = Kh + (size_t)(k0) * PQ + dm.koff; DMA16(g_, KL + (bf) * SHM_K + wid * 1024); DMA16(g_ + 32 * PQ, KL + (bf) * SHM_K + 8192 + wid * 1024); } while (0)
#define DMA_V(bf, k0) do { const bf16* g_ = Vh + (size_t)(k0) * PQ + dm.voff; DMA16(g_, VL + (bf) * SHM_V + wid * 1024); DMA16(g_ + 32 * PQ, VL + (bf) * SHM_V + 8192 + wid * 1024); } while (0)

__device__ __forceinline__ void moba_prime(const BlockRef& cur, char* lds, Seam& S, bool wait = true) {
    const int tid = fresh_tid(), wid = __builtin_amdgcn_readfirstlane(tid >> 6), lane = tid & 63, r32 = lane & 31, hi = lane >> 5;
    LAS unsigned char* VL = (LAS unsigned char*)(unsigned)(uintptr_t)lds; LAS unsigned char* KL = VL + 2 * SHM_V;
    const bf16* Kh = cur.K; const bf16* Vh = cur.V; const DmaMap dm = dma_map(wid, lane);
    DMA_K(0, 0); DMA_V(0, 0);
    for (int d0 = 0; d0 < 8; ++d0) S.qr[d0] = load8(cur.Q + (size_t)(wid * QBLK + r32) * PQ + d0 * 16 + hi * 8);
    if (wait) { VMW(); __syncthreads(); }
}
__device__ __forceinline__ unsigned moba_select(const bf16x8* qr, const float* KM, int nblk, int hi) {
    float qf[64];
#pragma unroll
    for (int d0 = 0; d0 < 8; ++d0)
#pragma unroll
        for (int e = 0; e < 8; ++e) qf[d0 * 8 + e] = __uint_as_float(((unsigned)(unsigned short)qr[d0][e]) << 16);
    float v0 = -__builtin_inff(), v1 = v0, v2 = v0; int i0 = -1, i1 = -1, i2 = -1;
    for (int j = 0; j < nblk; ++j) {
        const float* km = KM + j * 128 + hi * 8;
        float a0 = 0.f, a1 = 0.f, a2 = 0.f, a3 = 0.f;
#pragma unroll
        for (int d0 = 0; d0 < 8; ++d0) { const f32x4 k0 = *(const f32x4*)(km + d0 * 16), k1 = *(const f32x4*)(km + d0 * 16 + 4);
            a0 = fmaf(qf[d0 * 8 + 0], k0[0], a0); a1 = fmaf(qf[d0 * 8 + 1], k0[1], a1); a2 = fmaf(qf[d0 * 8 + 2], k0[2], a2); a3 = fmaf(qf[d0 * 8 + 3], k0[3], a3);
            a0 = fmaf(qf[d0 * 8 + 4], k1[0], a0); a1 = fmaf(qf[d0 * 8 + 5], k1[1], a1); a2 = fmaf(qf[d0 * 8 + 6], k1[2], a2); a3 = fmaf(qf[d0 * 8 + 7], k1[3], a3); }
        float a = (a0 + a1) + (a2 + a3);
        { auto rr = __builtin_amdgcn_permlane32_swap(__float_as_uint(a), __float_as_uint(a), false, false); a = __uint_as_float(rr[0]) + __uint_as_float(rr[1]); }
        if (a > v0) { v2 = v1; i2 = i1; v1 = v0; i1 = i0; v0 = a; i0 = j; }
        else if (a > v1) { v2 = v1; i2 = i1; v1 = a; i1 = j; }
        else if (a > v2) { v2 = a; i2 = j; }
    }
    unsigned msk = 0u;
    if (i0 >= 0) msk |= 1u << i0; if (i1 >= 0) msk |= 1u << i1; if (i2 >= 0) msk |= 1u << i2;
    return msk;
}
__device__ __forceinline__ void moba_block(const BlockRef& cur, char* lds, Seam& S) {
    const int tid = fresh_tid(), wid = __builtin_amdgcn_readfirstlane(tid >> 6), lane = tid & 63, r32 = lane & 31, hi = lane >> 5;
    const int NT = (cur.P0 + QB) / KVBLK;
    const int ib = cur.P0 >> 8;
    const int qlo = cur.P0 + wid * QBLK, qm = qlo + r32 - 4 * hi;
    char* V_lds = lds; char* K_lds = lds + 2 * SHM_V;
    LAS unsigned char* VL = (LAS unsigned char*)(unsigned)(uintptr_t)lds; LAS unsigned char* KL = VL + 2 * SHM_V;
    float* ws = (float*)(lds + LDS_WS) + wid * 64; float* li_l = ws, * al_l = ws + 32;
    const float* KM = (const float*)(lds + LDS_KM); const float* LUT = (const float*)(lds + LDS_LUT);
    float m_reg = -1e30f, l_reg = 0; f32x16 o[4] = {};
    const int vb0 = (int)(uintptr_t)V_lds + v_rd_base(lane);
    const bf16* Kh = cur.K; const bf16* Vh = cur.V; const DmaMap dm = dma_map(wid, lane);
#define RESC(a) do { if (__any((a) < 1.f)) { if (hi == 0) al_l[r32] = (a); asm volatile("s_waitcnt lgkmcnt(0)" ::: "memory");              \
                     for (int d_ = 0; d_ < 4; ++d_) for (int r = 0; r < 16; ++r) o[d_][r] *= al_l[crow(r, hi)]; } } while (0)
#define KBASE(t) ((t) * KVBLK)
#define MASKT(P0_, P1_, t) const bool dead_ = moba_mask(P0_, P1_, KBASE(t), ib, qm, selmask, LUT, qlo)
    f32x16 pA0, pA1, pB0, pB1; float mnA, mnB, alA, alB; bf16x8 pa0, pa1, pa2, pa3;
    SBAR(); DMA_K(1, KBASE(1)); SBAR();
    const unsigned selmask = ib <= 3 ? (1u << ib) - 1u : moba_select(S.qr, KM, ib, hi);
    SBAR(); qkt<0>(pA0, pA1, K_lds, r32, hi, S.qr);
    { MASKT(pA0, pA1, 0); partialSM(pA0, pA1, m_reg, mnA, alA, dead_); }
    VMW();
    __syncthreads();
    const int Tw = NT - 4 + (wid >> 1);
#define HALF_STEP(PX0, PX1, mnX, alX, PY0, PY1, alY, t, KB, VB) do {                                                          \
        SBAR(); DMA_K(VB, KBASE((t) + 1)); DMA_V(KB, KBASE(t)); SBAR();                                                       \
        if ((t) <= Tw) qkt<KB>(PX0, PX1, K_lds, r32, hi, S.qr);                                                               \
        if ((t) - 1 <= Tw) { finishSM(PY0, PY1, alY, l_reg, pa0, pa1, pa2, pa3); SBAR();                                      \
            pv_tile<VB>(o, vb0, pa0, pa1, pa2, pa3); }                                                                        \
        if ((t) <= Tw) { MASKT(PX0, PX1, (t)); partialSM(PX0, PX1, m_reg, mnX, alX, dead_); RESC(alX); }                      \
        VMW();                                                                                                                \
        __syncthreads(); } while (0)
    for (int t = 1; t + 1 < NT; t += 2) {
        HALF_STEP(pB0, pB1, mnB, alB, pA0, pA1, alA, t, 1, 0);
        HALF_STEP(pA0, pA1, mnA, alA, pB0, pB1, alB, t + 1, 0, 1);
    }
    SBAR(); DMA_V(1, KBASE(NT - 1)); SBAR();
    if (NT - 1 <= Tw) { qkt<1>(pB0, pB1, K_lds, r32, hi, S.qr); SBAR(); }
    if (NT - 2 <= Tw) { finishSM(pA0, pA1, alA, l_reg, pa0, pa1, pa2, pa3); SBAR();
        pv_tile<0>(o, vb0, pa0, pa1, pa2, pa3); }
    if (NT - 1 <= Tw) { MASKT(pB0, pB1, NT - 1); partialSM(pB0, pB1, m_reg, mnB, alB, dead_); RESC(alB); }
    VMW(); __syncthreads();
    if (NT - 1 <= Tw) { finishSM(pB0, pB1, alB, l_reg, pa0, pa1, pa2, pa3); SBAR(); pv_tile<1>(o, vb0, pa0, pa1, pa2, pa3); }
    SBAR();
    if (hi == 0) li_l[r32] = l_reg; asm volatile("s_waitcnt lgkmcnt(0)" ::: "memory");
    float rli[16];
#pragma unroll
    for (int r = 0; r < 16; ++r) rli[r] = __builtin_amdgcn_rcpf(li_l[crow(r, hi)]);
    bf16* Ow = cur.O + (size_t)(wid * QBLK) * PO;
#pragma unroll
    for (int r = 0; r < 16; ++r) { const int orow = crow(r, hi);
#pragma unroll
        for (int d0 = 0; d0 < 4; ++d0) { const float v = o[d0][r] * rli[r];
            const float vn = __shfl_xor(v, 1);
            if ((r32 & 1) == 0) *(unsigned*)(Ow + (size_t)orow * PO + d0 * 32 + r32) = cvtpk(v, vn); } }
    __syncthreads();
#undef RESC
#undef KBASE
#undef MASKT
#undef HALF_STEP
}
#undef VMW
#undef DMA16
#undef DMA_K
#undef DMA_V
#undef SBAR
#undef KSWZ
}

constexpr size_t MiB = 1u << 20;
constexpr size_t WS_CTL = 0, CTL_ZERO_BYTES = 64 * 1024;
constexpr size_t WO_IN = 0;
constexpr size_t WO_CA = 40 * MiB;
constexpr size_t WO_MIX = 48 * MiB;
constexpr size_t WO_GU = 56 * MiB;
constexpr size_t WO_DN = 100 * MiB;
constexpr size_t WSET_BYTES = 122 * MiB;
constexpr size_t WS_W0 = 2 * MiB, WS_W1 = 702 * MiB;
constexpr size_t WS_KPART = 124 * MiB;
constexpr size_t WS_SS = 126 * MiB;
constexpr size_t WS_XB2 = 128 * MiB;
constexpr size_t WS_XB = 254 * MiB;
constexpr size_t WS_PROJ = 318 * MiB;
constexpr size_t WS_GU = WS_PROJ;
constexpr size_t WS_UA = 638 * MiB;
constexpr size_t WS_MG = 830 * MiB;
constexpr size_t WS_END = 894 * MiB;
static_assert(WS_W1 + WSET_BYTES <= WS_MG, "weight set 1");
constexpr int CW_BAR = 4096;

constexpr int RING_OFF = 0, RING_BYTES = 131072;
constexpr int LDSCTL_OFF = RING_BYTES, MISC_OFF = LDSCTL_OFF + 320;
constexpr int LDS_BYTES = LDS_TOTAL;
static_assert(att::LDS_BYTES <= RING_BYTES && MISC_OFF + 128 <= LDS_RB_OFF, "LDS map");

#define XB_TMO      128
#define XB_XCNT(j)  (256  + 64 * (j))
#define XB_XSUB(j)  (1280 + 64 * (j))
#define XB_XGEN(j)  (2304 + 64 * (j))
#define XB_TOP      3328
#define XB_TOPGEN   3392
#define XCD_BAR_WORDS 3456
#define XB_SPIN_CAP (1u << 18)

__device__ __forceinline__ unsigned xb_ld(unsigned* p)              { return __hip_atomic_load(p, __ATOMIC_RELAXED, __HIP_MEMORY_SCOPE_AGENT); }
__device__ __forceinline__ unsigned xb_add(unsigned* p, unsigned v) { return __hip_atomic_fetch_add(p, v, __ATOMIC_RELAXED, __HIP_MEMORY_SCOPE_AGENT); }
__device__ __forceinline__ unsigned xb_xcc_id() { return (unsigned)__builtin_amdgcn_s_getreg((3 << 11) | 20) & 0xFu; }
#define XB_SPIN(cond, bar) do { unsigned _sp = 0; while (cond) { __builtin_amdgcn_s_sleep(1); \
    if ((++_sp & 255u) == 0u) { if (xb_ld(&(bar)[XB_TMO])) break; if (_sp > XB_SPIN_CAP) { atomicAdd(&(bar)[XB_TMO], 1u); break; } } } } while (0)

struct XcdBarrier { unsigned* bar; unsigned x; volatile LAS unsigned* st; };

__device__ __forceinline__ XcdBarrier xcd_barrier_post(unsigned* bar, volatile LAS unsigned* st) {
    XcdBarrier b; b.bar = bar; b.x = xb_xcc_id(); b.st = st;
    if (threadIdx.x == 0) (void)xb_add(&bar[XB_XCNT(b.x)], 1u);
    return b;
}
__device__ __forceinline__ void xcd_barrier_complete(unsigned* bar, unsigned x, unsigned& nloc, unsigned& nx) {
    const unsigned G = gridDim.x * gridDim.y * gridDim.z;
    unsigned sum, cnt, mine, sp = 0u;
    for (;;) {
        sum = 0u; cnt = 0u; mine = 0u;
#pragma unroll
        for (unsigned j = 0; j < 16; ++j) { const unsigned c = xb_ld(&bar[XB_XCNT(j)]); sum += c; cnt += (c > 0u) ? 1u : 0u; mine = (j == x) ? c : mine; }
        if (sum == G) break;
        __builtin_amdgcn_s_sleep(1);
        if ((++sp & 255u) == 0u) { if (xb_ld(&bar[XB_TMO])) break; if (sp > XB_SPIN_CAP) { atomicAdd(&bar[XB_TMO], 1u); break; } }
    }
    nloc = mine > 0u ? mine : 1u; nx = cnt > 0u ? cnt : 1u;
}
__device__ __forceinline__ void xcd_barrier(const XcdBarrier& b) {
    asm volatile("s_waitcnt vmcnt(0)" ::: "memory");
    __syncthreads();
    if (threadIdx.x == 0) {
        unsigned* bar = b.bar;
        __builtin_amdgcn_s_waitcnt(0);
        unsigned nloc = b.st[0], nx = b.st[1];
        if (nloc == 0u) { xcd_barrier_complete(bar, b.x, nloc, nx); b.st[0] = nloc; b.st[1] = nx; }
        const unsigned old = xb_add(&bar[XB_XSUB(b.x)], 1u);
        const unsigned gen = old / nloc;
        if (old + 1u == (gen + 1u) * nloc) {
            __builtin_amdgcn_fence(__ATOMIC_RELEASE, "agent");
            asm volatile("s_waitcnt vmcnt(0)" ::: "memory");
            const unsigned og = xb_add(&bar[XB_TOP], 1u);
            const unsigned tg = og / nx;
            if (og + 1u == (tg + 1u) * nx) xb_add(&bar[XB_TOPGEN], 1u);
            else XB_SPIN(xb_ld(&bar[XB_TOPGEN]) == tg, bar);
            __builtin_amdgcn_fence(__ATOMIC_ACQUIRE, "agent");
            asm volatile("s_waitcnt vmcnt(0)" ::: "memory");
            xb_add(&bar[XB_XGEN(b.x)], 1u);
            asm volatile("s_waitcnt vmcnt(0)" ::: "memory");
        } else {
            XB_SPIN(xb_ld(&bar[XB_XGEN(b.x)]) == gen, bar);
            asm volatile("buffer_inv sc0\n\ts_waitcnt vmcnt(0)" ::: "memory");
        }
    }
    __syncthreads();
}

__device__ __forceinline__ void panel_barrier(unsigned* cnt, unsigned target, unsigned* tmo, bool local) {
    asm volatile("s_waitcnt vmcnt(0)" ::: "memory");
    __syncthreads();
    if (threadIdx.x == 0) {
        if (!local) { __builtin_amdgcn_fence(__ATOMIC_RELEASE, "agent"); asm volatile("s_waitcnt vmcnt(0)" ::: "memory"); }
        (void)xb_add(cnt, 1u);
        unsigned sp = 0u;
        while (xb_ld(cnt) < target) { __builtin_amdgcn_s_sleep(1); if ((++sp & 255u) == 0u) { if (xb_ld(tmo)) break; if (sp > XB_SPIN_CAP) { atomicAdd(tmo, 1u); break; } } }
        if (!local) { __builtin_amdgcn_fence(__ATOMIC_ACQUIRE, "agent"); asm volatile("s_waitcnt vmcnt(0)" ::: "memory"); }
    }
    __syncthreads();
    if (local) asm volatile("buffer_inv sc0\n\ts_waitcnt vmcnt(0)" ::: "memory");
}
struct Args { const float* in[13]; float* out; unsigned char* ws; int ph_lo, ph_hi; };
struct Frame {
    LAS unsigned char* lds;
    int vcu, G;
    unsigned char* ws;
};

__device__ __forceinline__ float wave_sum(float v) {
#pragma unroll
    for (int o = 1; o < 64; o <<= 1) v += __shfl_xor(v, o);
    return v;
}
struct CvtItem { const float* src; size_t rs2; bf16* dst; int ldw; const float* gain; int has_gain; };
constexpr int CVT_I_IN = (DM / 64) * (INC / 32), CVT_NITEMS = CVT_I_IN + 2 * (CCH / 64) * (DM / 32) + (DM / 64) * (DM / 32) + 2 * (DM / 64) * (FF / 32) + (FF / 64) * (DM / 32);
__device__ __forceinline__ CvtItem cvt_decode(const Args& a, unsigned char* wset, int l, int r) {
    constexpr int I_IN = (DM / 64) * (INC / 32), I_CO = (CCH / 64) * (DM / 32), I_AO = (AW / 64) * (DM / 32), I_MIX = (DM / 64) * (DM / 32),
                  I_G = (DM / 64) * (FF / 32), I_U = I_G, I_DN = (FF / 64) * (DM / 32);
    static_assert(I_IN == CVT_I_IN && I_IN + I_CO + I_AO + I_MIX + I_G + I_U + I_DN == CVT_NITEMS, "item counts");
    const float* W; int N, ldw, k0, n0; bf16* WT; const float* gain = nullptr; int dcol = 0, rowmode = 0;
#define CVT_KN(NB) do { k0 = 64 * (r / (NB)); n0 = 32 * (r % (NB)); } while (0)
    if (r < I_IN) { W = a.in[1] + (size_t)l * DM * INC; N = INC; WT = (bf16*)(wset + WO_IN); ldw = DM; gain = a.in[7] + (size_t)l * DM; rowmode = 3; CVT_KN(INC / 32); }
    else if ((r -= I_IN) < I_CO) { W = a.in[3] + (size_t)l * CCH * DM; N = DM; WT = (bf16*)(wset + WO_CA); ldw = 2048; CVT_KN(DM / 32); }
    else if ((r -= I_CO) < I_AO) { W = a.in[4] + (size_t)l * AW * DM; N = DM; WT = (bf16*)(wset + WO_CA); ldw = 2048; dcol = 1024; CVT_KN(DM / 32); }
    else if ((r -= I_AO) < I_MIX) { W = a.in[5] + (size_t)l * DM * DM; N = DM; WT = (bf16*)(wset + WO_MIX); ldw = DM; CVT_KN(DM / 32); }
    else if ((r -= I_MIX) < I_G) { W = a.in[9] + (size_t)l * DM * FF; N = FF; WT = (bf16*)(wset + WO_GU); ldw = DM; gain = a.in[8] + (size_t)l * DM; rowmode = 1; CVT_KN(FF / 32); }
    else if ((r -= I_G) < I_U) { W = a.in[10] + (size_t)l * DM * FF; N = FF; WT = (bf16*)(wset + WO_GU); ldw = DM; gain = a.in[8] + (size_t)l * DM; rowmode = 2; CVT_KN(FF / 32); }
    else { r -= I_U; W = a.in[11] + (size_t)l * FF * DM; N = DM; WT = (bf16*)(wset + WO_DN); ldw = FF; CVT_KN(DM / 32); }
#undef CVT_KN
    int drow = rowmode == 0 ? n0 : 256 * (n0 / 128) + (n0 % 128) + (rowmode == 2 ? 128 : 0);
    if (rowmode == 3) { const int isatt = n0 >= C_GA, gcol = n0 - (isatt ? C_GA : C_GC);
        drow = n0 < C_GC ? n0 : C_GC + 256 * (gcol / 128) + (gcol % 128) + (isatt ? 128 : 0);
        if (n0 < C_B || (n0 >= C_C && n0 < C_Q)) { const int isc = n0 >= C_C, ch = n0 - (isc ? C_C : 0), k = ch / 128, pk = k < 4 ? k : 4 + k;
            drow = 256 * pk + (ch % 128) + (isc ? 128 : 0); } }
    CvtItem c; c.src = W + (size_t)k0 * N + n0; c.rs2 = (size_t)2 * N; c.dst = WT + (size_t)drow * ldw + dcol + k0; c.ldw = ldw; c.gain = (gain ? gain : a.in[7]) + k0; c.has_gain = gain != nullptr;
    return c;
}
__device__ __forceinline__ void cvt_load(const CvtItem& c, int lane, f32x4 (&wv)[8], f32x4 (&gv)[2]) {
    const float* wp = c.src + (size_t)(lane >> 3) * (c.rs2 >> 1) + 4 * (lane & 7);
#pragma unroll
    for (int i = 0; i < 8; ++i) wv[i] = *(const GAS f32x4*)(wp + (size_t)i * 4 * c.rs2);
    gv[0] = *(const f32x4*)(c.gain + 8 * (lane & 7)); gv[1] = *(const f32x4*)(c.gain + 8 * (lane & 7) + 4);
}
__device__ __forceinline__ void cvt_store(const CvtItem& c, int lane, const f32x4 (&wv)[8], const f32x4 (&gv)[2], LAS float* scr) {
    const int ch = lane & 7;
    LAS float* wp = scr + (lane >> 3) * 33 + 4 * (lane & 7);
#pragma unroll
    for (int i = 0; i < 8; ++i)
#pragma unroll
        for (int q = 0; q < 4; ++q) wp[i * 8 * 33 + q] = wv[i][q];
    f32x4 g0 = gv[0], g1 = gv[1];
    if (!c.has_gain) { g0 = (f32x4){1.f, 1.f, 1.f, 1.f}; g1 = g0; }
    LDS_WAIT(); asm volatile("" ::: "memory");
    float t[4][8];
#pragma unroll
    for (int j = 0; j < 4; ++j) { const LAS float* sp = scr + (8 * ch) * 33 + (lane >> 3) + 8 * j;
#pragma unroll
        for (int e = 0; e < 8; ++e) t[j][e] = sp[e * 33]; }
    __builtin_amdgcn_sched_barrier(0);
    LDS_WAIT();
#pragma unroll
    for (int j = 0; j < 4; ++j) { const int n = (lane >> 3) + 8 * j;
        v4u o; o.x = cvt_pk_bf16(t[j][0] * g0[0], t[j][1] * g0[1]); o.y = cvt_pk_bf16(t[j][2] * g0[2], t[j][3] * g0[3]); o.z = cvt_pk_bf16(t[j][4] * g1[0], t[j][5] * g1[1]); o.w = cvt_pk_bf16(t[j][6] * g1[2], t[j][7] * g1[3]);
        *(GAS v4u*)(c.dst + (size_t)n * c.ldw + 8 * ch) = o; }
    asm volatile("" ::: "memory");
}
__device__ __forceinline__ void phase_convert_weights(Frame& F, const Args& a, int l, int it_lo, int it_hi) {
    const int tid = fresh_tid(), lane = tid & 63, wave = __builtin_amdgcn_readfirstlane(tid >> 6);
    LAS float* scr = (LAS float*)(F.lds + RING_OFF + wave * 8448);
    const int gw = F.vcu * NWAVES + wave, NGW = F.G * NWAVES;
    unsigned char* wset = F.ws + ((l & 1) ? WS_W1 : WS_W0);
    const int first = it_lo + gw;
    if (first >= it_hi) return;
    const int n = (it_hi - first + NGW - 1) / NGW;
#define CVT_ITEM(j) cvt_decode(a, wset, l, first + ((j) < n ? (j) : n - 1) * NGW)
    f32x4 wA[8], wB[8], wC[8], wD[8], gA[2], gB[2], gC[2], gD[2];
    CvtItem cA = CVT_ITEM(0), cB = CVT_ITEM(1), cC = CVT_ITEM(2), cD = cA;
    cvt_load(cA, lane, wA, gA); cvt_load(cB, lane, wB, gB); cvt_load(cC, lane, wC, gC);
    for (int j = 0;; j += 4) {
        cD = CVT_ITEM(j + 3); cvt_load(cD, lane, wD, gD); __builtin_amdgcn_sched_barrier(0); cvt_store(cA, lane, wA, gA, scr); if (j + 1 >= n) break;
        cA = CVT_ITEM(j + 4); cvt_load(cA, lane, wA, gA); __builtin_amdgcn_sched_barrier(0); cvt_store(cB, lane, wB, gB, scr); if (j + 2 >= n) break;
        cB = CVT_ITEM(j + 5); cvt_load(cB, lane, wB, gB); __builtin_amdgcn_sched_barrier(0); cvt_store(cC, lane, wC, gC, scr); if (j + 3 >= n) break;
        cC = CVT_ITEM(j + 6); cvt_load(cC, lane, wC, gC); __builtin_amdgcn_sched_barrier(0); cvt_store(cD, lane, wD, gD, scr); if (j + 4 >= n) break;
    }
#undef CVT_ITEM
}
__device__ __forceinline__ void phase_x_to_bf16(Frame& F, const float* x) {
    const int tid = fresh_tid(), lane = tid & 63, wave = __builtin_amdgcn_readfirstlane(tid >> 6);
    const int gw = F.vcu * NWAVES + wave, NGW = F.G * NWAVES;
    bf16* XB = (bf16*)(F.ws + WS_XB); float* SS = (float*)(F.ws + WS_SS);
    for (int m = gw; m < M; m += 2 * NGW) {
        const GAS f32x4* xr0 = (const GAS f32x4*)(x + (size_t)m * DM) + lane; const bool two = m + NGW < M; const GAS f32x4* xr1 = (const GAS f32x4*)(x + (size_t)(two ? m + NGW : m) * DM) + lane;
        f32x4 v0[8], v1[8];
#pragma unroll
        for (int j = 0; j < 8; ++j) v0[j] = __builtin_nontemporal_load(xr0 + 64 * j);
#pragma unroll
        for (int j = 0; j < 8; ++j) v1[j] = __builtin_nontemporal_load(xr1 + 64 * j);
        __builtin_amdgcn_sched_barrier(0);
#pragma unroll
        for (int h = 0; h < 2; ++h) { if (h && !two) break; const int mm = m + h * NGW; float s = 0.f;
            GAS u32x2* o8 = (GAS u32x2*)(XB + (size_t)mm * DM) + lane;
#pragma unroll
            for (int j = 0; j < 8; ++j) { const f32x4 v = h ? v1[j] : v0[j]; s += (v.x * v.x + v.y * v.y) + (v.z * v.z + v.w * v.w);
                u32x2 w; w.x = cvt_pk_bf16(v.x, v.y); w.y = cvt_pk_bf16(v.z, v.w); o8[64 * j] = w; }
            s = wave_sum(s);
            if (lane < 8) SS[(size_t)mm * 8 + lane] = lane == 0 ? s : 0.f; }
    }
}
__device__ __forceinline__ void phase_final_norm(Frame& F, const float* gain, float* out, int pm, int mi) {
    const int tid = fresh_tid(), lane = tid & 63, wave = __builtin_amdgcn_readfirstlane(tid >> 6);
    const int gw = pm >= 0 ? wave : F.vcu * NWAVES + wave, NGW = pm >= 0 ? NWAVES : F.G * NWAVES;
    const int mlo = pm >= 0 ? pm * 256 + mi * 64 : 0, mhi = pm >= 0 ? mlo + 64 : M;
    const bf16* XB = (const bf16*)(F.ws + WS_XB); const float* SS = (const float*)(F.ws + WS_SS);
    for (int m = mlo + gw; m < mhi; m += NGW) {
        float s = lane < 8 ? SS[(size_t)m * 8 + lane] : 0.f; s = wave_sum(s);
        const float r = __builtin_amdgcn_rsqf(s * (1.0f / DM) + RMS_EPS);
#pragma unroll
        for (int j = 0; j < 4; ++j) { const int c = 8 * (lane + 64 * j); const u32x4 w = __builtin_nontemporal_load((const GAS u32x4*)(XB + (size_t)m * DM + c));
            const f32x4 g0 = *(const f32x4*)(gain + c), g1 = *(const f32x4*)(gain + c + 4);
            f32x4 o0, o1; o0[0] = bf_lo(w.x) * r * g0[0]; o0[1] = bf_hi(w.x) * r * g0[1]; o0[2] = bf_lo(w.y) * r * g0[2]; o0[3] = bf_hi(w.y) * r * g0[3];
            o1[0] = bf_lo(w.z) * r * g1[0]; o1[1] = bf_hi(w.z) * r * g1[1]; o1[2] = bf_lo(w.w) * r * g1[2]; o1[3] = bf_hi(w.w) * r * g1[3];
            __builtin_nontemporal_store(o0, (GAS f32x4*)(out + (size_t)m * DM + c)); __builtin_nontemporal_store(o1, (GAS f32x4*)(out + (size_t)m * DM + c + 4)); }
    }
}
__device__ __forceinline__ void unpack8(const u32x4 w, float (&f)[8]) {
    f[0] = bf_lo(w.x); f[1] = bf_hi(w.x); f[2] = bf_lo(w.y); f[3] = bf_hi(w.y); f[4] = bf_lo(w.z); f[5] = bf_hi(w.z); f[6] = bf_lo(w.w); f[7] = bf_hi(w.w);
}
__device__ __forceinline__ void phase_conv(Frame& F, const float* conv_w  ) {
    const bf16* PROJ = (const bf16*)(F.ws + WS_PROJ); bf16* UA = (bf16*)(F.ws + WS_UA);
    const int tid = fresh_tid(), lane = tid & 63, wave = __builtin_amdgcn_readfirstlane(tid >> 6);
    const int gw = F.vcu * NWAVES + wave, NGW = F.G * NWAVES;
    for (int it = gw; it < (M / 16) * 2; it += NGW) {
        const int half = it & 1, rr = it >> 1, m0 = rr * 16, t0 = m0 % SEQ, c0 = half * 512 + lane * 8;
        float w0[8], w1[8], w2[8];
        { const f32x4 a0 = *(const f32x4*)(conv_w + c0), a1 = *(const f32x4*)(conv_w + c0 + 4), b0 = *(const f32x4*)(conv_w + CCH + c0), b1 = *(const f32x4*)(conv_w + CCH + c0 + 4),
                      d0 = *(const f32x4*)(conv_w + 2 * CCH + c0), d1 = *(const f32x4*)(conv_w + 2 * CCH + c0 + 4);
#pragma unroll
          for (int e = 0; e < 4; ++e) { w0[e] = a0[e]; w0[4 + e] = a1[e]; w1[e] = b0[e]; w1[4 + e] = b1[e]; w2[e] = d0[e]; w2[4 + e] = d1[e]; } }
        float p2[8], p1[8];
#pragma unroll
        for (int e = 0; e < 8; ++e) { p2[e] = 0.f; p1[e] = 0.f; }
        if (t0 != 0) {
            unpack8(*(const u32x4*)(PROJ + (size_t)(m0 - 2) * INC + C_H + c0), p2);
            unpack8(*(const u32x4*)(PROJ + (size_t)(m0 - 1) * INC + C_H + c0), p1);
        }
#pragma unroll 8
        for (int r = 0; r < 16; ++r) {
            const size_t m = (size_t)(m0 + r);
            float ch[8], b[8], y[8];
            unpack8(__builtin_nontemporal_load((const GAS u32x4*)(PROJ + m * INC + C_H + c0)), ch); unpack8(__builtin_nontemporal_load((const GAS u32x4*)(PROJ + m * INC + C_B + c0)), b);
#pragma unroll
            for (int e = 0; e < 8; ++e) { const float cu = ch[e]; float acc = w0[e] * p2[e]; acc = acc + w1[e] * p1[e]; acc = acc + w2[e] * cu; y[e] = b[e] * acc; p2[e] = p1[e]; p1[e] = cu; }
            u32x4 w; w.x = cvt_pk_bf16(y[0], y[1]); w.y = cvt_pk_bf16(y[2], y[3]); w.z = cvt_pk_bf16(y[4], y[5]); w.w = cvt_pk_bf16(y[6], y[7]);
            *(u32x4*)(UA + m * 2048 + c0) = w;
        }
    }
}
__device__ __forceinline__ int t5_bucket(int n) {
    if (n < 16) return n;
    int b = 16;
    b += (n >= 19); b += (n >= 21); b += (n >= 24); b += (n >= 27); b += (n >= 31); b += (n >= 35); b += (n >= 40); b += (n >= 46);
    b += (n >= 52); b += (n >= 59); b += (n >= 67); b += (n >= 77); b += (n >= 87); b += (n >= 99); b += (n >= 113);
    return b;
}
__device__ __forceinline__ void mixer_stream_work(Frame& F, const Args& a, int l) {
    for (int rep = 0; rep < REP_MISC; ++rep) {
        phase_conv(F, a.in[2] + (size_t)l * 3 * CCH);
        if (l == 0) phase_convert_weights(F, a, 0, CVT_I_IN, CVT_NITEMS);
        if (l + 1 < DEPTH) phase_convert_weights(F, a, l + 1, 0, CVT_NITEMS);
    }
}
__device__ __forceinline__ void phase_attention(Frame& F, char* lds, const float* rel_bias, const Args& a, int l) {
    const bf16* PROJ = (const bf16*)(F.ws + WS_PROJ); bf16* UA = (bf16*)(F.ws + WS_UA); const float* KPART = (const float*)(F.ws + WS_KPART);
    float* KM = (float*)(lds + att::LDS_KM); float* LUT = (float*)(lds + att::LDS_LUT);
    bool streamed = false;
    for (int L = F.vcu; L < BATCH * NH * 8; L += F.G) {
        const int tid = fresh_tid();
        const int bh = L >> 3, x = L & 7, b = bh / NH, h = bh % NH;
        const int qbA = (bh & 1) ? 15 - x : x, qbB = 15 - qbA;
        att::BlockRef bA, bB;
        { const size_t row0 = (size_t)b * SEQ + (size_t)qbA * 256; bA.Q = PROJ + row0 * INC + C_Q + h * HD; bA.O = UA + row0 * 2048 + 1024 + h * HD; bA.P0 = qbA * 256; }
        { const size_t row0 = (size_t)b * SEQ + (size_t)qbB * 256; bB.Q = PROJ + row0 * INC + C_Q + h * HD; bB.O = UA + row0 * 2048 + 1024 + h * HD; bB.P0 = qbB * 256; }
        bA.K = bB.K = PROJ + (size_t)b * SEQ * INC + C_K + h * HD; bA.V = bB.V = PROJ + (size_t)b * SEQ * INC + C_V + h * HD;
        att::Seam S;
        att::moba_prime(bA, lds, S, false);
        for (int idx = tid; idx < 16 * 128; idx += NWAVES * 64) { const int j = idx >> 7, d = idx & 127; float s = 0.f;
            s = KPART[(size_t)((b * 16 + j) * 2 + 0) * 1024 + h * 128 + d] + KPART[(size_t)((b * 16 + j) * 2 + 1) * 1024 + h * 128 + d];
            KM[idx] = s * (1.0f / 256.0f); }
        if (tid < 128) LUT[tid] = (rel_bias[t5_bucket(tid) * NH + h] - rel_bias[31 * NH + h]) * (1.0f / att::SCALE);
        asm volatile("s_waitcnt vmcnt(0)" ::: "memory"); __syncthreads();
        for (int rep = 0; rep < REP_ATT; ++rep) {
        if (rep > 0) att::moba_prime(bA, lds, S);
        att::moba_block(bA, lds, S);
        __syncthreads();
        if (!streamed) { mixer_stream_work(F, a, l); streamed = true; __syncthreads(); }
        att::moba_prime(bB, lds, S);
        att::moba_block(bB, lds, S);
        __syncthreads();
        }
    }
    if (!streamed) mixer_stream_work(F, a, l);
}
constexpr int PH_PER_LAYER = 6, N_PHASES = DEPTH * PH_PER_LAYER + 2;

__global__ void __launch_bounds__(NWAVES * 64, 2) trunk_fwd(Args args) {
    extern __shared__ __attribute__((aligned(16))) unsigned char lds[];
    Frame F;
    F.lds = (LAS unsigned char*)lds;
    volatile LAS unsigned* MISC = (volatile LAS unsigned*)(F.lds + MISC_OFF);
    F.G = gridDim.x; { const int bx = blockIdx.x; F.vcu = (F.G % 8 == 0) ? (bx % 8) * (F.G / 8) + bx / 8 : bx; }
    F.ws = args.ws;
    unsigned* ctl = (unsigned*)(F.ws + WS_CTL);
    for (int u = threadIdx.x; u < (LDS_BYTES - LDSCTL_OFF) / 4; u += NWAVES * 64) ((LAS unsigned*)(F.lds + LDSCTL_OFF))[u] = 0u;
    __syncthreads();
    const int lo = args.ph_lo, hi = args.ph_hi;
    const bool use_bar = (hi - lo) > 1;
    XcdBarrier bar; bar.bar = ctl + CW_BAR; bar.x = 0; bar.st = MISC + 8;
    if (use_bar) bar = xcd_barrier_post(ctl + CW_BAR, MISC + 8);
#define IN(k) (lo <= (k) && (k) < hi)
#define SEAM(k) do { if ((k) + 1 < hi) xcd_barrier(bar); } while (0)
    const bool paneled = (F.G == 256) && use_bar;
    const int my_pm = 8 * ((int)blockIdx.x % 8) + ((int)blockIdx.x / 8) % 8, my_mi = (int)blockIdx.x / 64;
    unsigned pb_epoch = 0u; bool pb_local = false;
    if (paneled && threadIdx.x == 0) __hip_atomic_store(ctl + 12288 + blockIdx.x, 0x100u | xb_xcc_id(), __ATOMIC_RELAXED, __HIP_MEMORY_SCOPE_AGENT);
#define SEAMG(k) do { if ((k) + 1 < hi) { if (paneled) { pb_epoch += 4u; panel_barrier(ctl + 8192 + 64 * my_pm, pb_epoch, ctl + CW_BAR + XB_TMO, pb_local); } else xcd_barrier(bar); } } while (0)

    bf16* XB = (bf16*)(F.ws + WS_XB); bf16* XB2 = (bf16*)(F.ws + WS_XB2); float* SS = (float*)(F.ws + WS_SS); bf16* PROJ = (bf16*)(F.ws + WS_PROJ); bf16* GU = (bf16*)(F.ws + WS_GU);
    bf16* UA = (bf16*)(F.ws + WS_UA); bf16* MG = (bf16*)(F.ws + WS_MG); float* KP = (float*)(F.ws + WS_KPART);

    if (IN(0)) { phase_x_to_bf16(F, args.in[0]); phase_convert_weights(F, args, 0, 0, CVT_I_IN); SEAM(0); }
    if (paneled && lo == 0) {
        const unsigned b0 = (unsigned)blockIdx.x % 64u;
        const unsigned i0 = xb_ld(ctl + 12288 + b0), i1 = xb_ld(ctl + 12288 + b0 + 64), i2 = xb_ld(ctl + 12288 + b0 + 128), i3 = xb_ld(ctl + 12288 + b0 + 192);
        pb_local = (i0 & 0x100u) && i0 == i1 && i0 == i2 && i0 == i3;
    }
    for (int l = 0; l < DEPTH; ++l) {
        const int pb = 1 + l * PH_PER_LAYER;
        unsigned char* wset = F.ws + ((l & 1) ? WS_W1 : WS_W0);
        bf16* WIN = (bf16*)(wset + WO_IN); bf16* WCA = (bf16*)(wset + WO_CA); bf16* WMIX = (bf16*)(wset + WO_MIX); bf16* WGU = (bf16*)(wset + WO_GU); bf16* WDN = (bf16*)(wset + WO_DN);
        if (IN(pb + 0)) {
            pg8::Gemm g{XB, WIN, M, INC, DM, DM, DM}; pg8::WrapOrder S; S.init(M, INC * REP_IN, F.G, fresh_bid()); S.wrapN = INC / 256;
            pg8::EpiProj E{PROJ, INC, C_GC, SS, KP};
#if SPLIT_IN
            for (int hf = 0; hf < 2; ++hf) { S.i0 = hf * 5; S.i1 = hf * 5 + 5; pg8::gemm_phase<pg8::EpiProj, pg8::WrapOrder, true>(F.lds + RING_OFF, g, S, E); if (hf == 0) xcd_barrier(bar); }
#else
            pg8::gemm_phase<pg8::EpiProj, pg8::WrapOrder, true>(F.lds + RING_OFF, g, S, E);
#endif
            SEAM(pb + 0);
        }
        if (IN(pb + 1)) {
            phase_attention(F, (char*)lds + RING_OFF, args.in[6], args, l);
            SEAM(pb + 1);
        }
        if (IN(pb + 2)) {
            pg8::Gemm g{UA, WCA, M, DM, 2048, 2048, 2048}; pg8::WrapOrder S; S.init(M, DM * REP_EF, F.G, fresh_bid()); S.wrapN = DM / 256;
            pg8::EpiGateBf16 E{MG, DM, PROJ + C_GC, INC}; pg8::MidGateRatio MH{PROJ + C_GC, INC};
            pg8::gemm_phase<pg8::EpiGateBf16, pg8::WrapOrder, true, pg8::MidGateRatio>(F.lds + RING_OFF, g, S, E, MH);
            SEAMG(pb + 2);
        }
        if (IN(pb + 3)) {
            pg8::Gemm g{MG, WMIX, M, DM, DM, DM, DM}; pg8::WrapOrder S; S.init(M, DM * REP_G, F.G, fresh_bid()); S.wrapN = DM / 256;
            pg8::EpiResBf16 E{XB, XB2, DM, SS};
            pg8::gemm_phase<pg8::EpiResBf16, pg8::WrapOrder, true>(F.lds + RING_OFF, g, S, E);
            SEAMG(pb + 3);
        }
        if (IN(pb + 4)) {
            pg8::Gemm g{XB2, WGU, M, 2 * FF, DM, DM, DM}; pg8::WrapOrder S; S.init(M, 2 * FF * REP_GU, F.G, fresh_bid()); S.wrapN = 2 * FF / 256;
            pg8::EpiSwiGLU E{GU, (long)256 * INC, SS};
            pg8::gemm_phase<pg8::EpiSwiGLU, pg8::WrapOrder, true>(F.lds + RING_OFF, g, S, E);
            SEAMG(pb + 4);
        }
        if (IN(pb + 5)) {
            pg8::Gemm g{GU, WDN, M, DM, FF, 64, FF, 256 * 64 * 2, (long)256 * INC * 2, true, true};       pg8::WrapOrder S; S.init(M, DM * REP_J, F.G, fresh_bid()); S.wrapN = DM / 256;
            pg8::EpiResBf16 E{XB2, XB, DM, SS};
            pg8::gemm_phase<pg8::EpiResBf16, pg8::WrapOrder, true>(F.lds + RING_OFF, g, S, E);
            SEAMG(pb + 5);
        }
    }
    if (IN(1 + DEPTH * PH_PER_LAYER)) phase_final_norm(F, args.in[12], args.out, paneled ? my_pm : -1, my_mi);
#undef IN
#undef SEAM
#undef SEAMG
}

#ifndef MK_PER_PHASE
#define MK_PER_PHASE 0
#endif
extern "C" void kernel_launch(void* const* d_in, const int* in_sizes, int n_in, void* d_out, int out_size, void* d_ws, size_t ws_size, hipStream_t stream) {
    static int grid = 0;
    if (grid == 0) {
        if (n_in != 13 || in_sizes[0] != M * DM || out_size != M * DM || ws_size < WS_END) {
            fprintf(stderr, "kernel_launch: unexpected shapes (n_in %d, in0 %d, out %d, ws %zu); nothing launched\n", n_in, n_in > 0 ? in_sizes[0] : -1, out_size, ws_size); grid = -1; return; }
        int dev = 0, cus = 0;
        if (hipGetDevice(&dev) != hipSuccess || hipDeviceGetAttribute(&cus, hipDeviceAttributeMultiprocessorCount, dev) != hipSuccess) { grid = -1; return; }
        if (hipFuncSetAttribute((const void*)trunk_fwd, hipFuncAttributeMaxDynamicSharedMemorySize, LDS_BYTES) != hipSuccess) { fprintf(stderr, "kernel_launch: hipFuncSetAttribute failed\n"); grid = -1; return; }
        int per_cu = 0;
        if (hipOccupancyMaxActiveBlocksPerMultiprocessor(&per_cu, (const void*)trunk_fwd, NWAVES * 64, LDS_BYTES) != hipSuccess || per_cu < 1)
            fprintf(stderr, "kernel_launch: note: occupancy query reports %d workgroups per CU\n", per_cu);
        (void)hipGetLastError();
        grid = cus;
    }
    if (grid < 0) return;
    if (hipMemsetAsync((char*)d_ws + WS_CTL, 0, CTL_ZERO_BYTES, stream) != hipSuccess) { fprintf(stderr, "kernel_launch: hipMemsetAsync failed\n"); return; }
    Args a{};
    for (int i = 0; i < 13; ++i) a.in[i] = (const float*)d_in[i];
    a.out = (float*)d_out; a.ws = (unsigned char*)d_ws;
#if MK_PER_PHASE
    for (int p = 0; p < N_PHASES; ++p) { a.ph_lo = p; a.ph_hi = p + 1; hipLaunchKernelGGL(trunk_fwd, dim3(grid), dim3(NWAVES * 64), LDS_BYTES, stream, a); }
#else
    a.ph_lo = 0; a.ph_hi = N_PHASES;
    hipLaunchKernelGGL(trunk_fwd, dim3(grid), dim3(NWAVES * 64), LDS_BYTES, stream, a);
#endif
    const hipError_t le = hipPeekAtLastError();
    if (le != hipSuccess) fprintf(stderr, "kernel_launch: launch failed: %s\n", hipGetErrorName(le));
}
```

```cpp
#include <hip/hip_runtime.h>
#include <cstdio>
#include <cstdint>

#ifndef REP_ATT
#define REP_ATT 1
#endif
#ifndef REP_BIG
#define REP_BIG 1
#endif
#ifndef REP_IN
#define REP_IN 1
#endif
#ifndef REP_GU
#define REP_GU 1
#endif
#ifndef REP_EF
#define REP_EF 1
#endif
#ifndef REP_G
#define REP_G 1
#endif
#ifndef REP_J
#define REP_J 1
#endif
#ifndef SPLIT_IN
#define SPLIT_IN 0
#endif
#ifndef REP_MISC
#define REP_MISC 1
#endif
constexpr int BATCH = 4, SEQ = 4096, DM = 2048, DEPTH = 4, CCH = 1024, AW = 1024, NH = 8, HD = 128, FF = 5632, INC = 10240;
constexpr int M = BATCH * SEQ;
constexpr int C_H = 0, C_B = 1024, C_C = 2048, C_Q = 3072, C_K = 4096, C_V = 5120, C_GC = 6144, C_GA = 8192;
constexpr float RMS_EPS = 1e-6f;
constexpr int NWAVES = 8;

#define GAS __attribute__((address_space(1)))
#define LAS __attribute__((address_space(3)))
typedef unsigned short bf16;
typedef unsigned v4u __attribute__((ext_vector_type(4)));
typedef float f32x4 __attribute__((ext_vector_type(4)));
typedef float f32x2 __attribute__((ext_vector_type(2)));
typedef float f32x16 __attribute__((ext_vector_type(16)));
typedef short bf16x8 __attribute__((ext_vector_type(8)));
typedef short s16x4 __attribute__((ext_vector_type(4)));
typedef unsigned u32x4 __attribute__((ext_vector_type(4)));
typedef unsigned u32x2 __attribute__((ext_vector_type(2)));
typedef GAS unsigned gu32;
#define RLX_AGENT __ATOMIC_RELAXED, __HIP_MEMORY_SCOPE_AGENT
#define LDS_WAIT() asm volatile("s_waitcnt lgkmcnt(0)" ::: "memory")
#define VM_WAIT() asm volatile("s_waitcnt vmcnt(0)" ::: "memory")

__device__ __forceinline__ int fresh_tid() { int t = threadIdx.x; asm volatile("" : "+v"(t)); return t; }
__device__ __forceinline__ int fresh_bid() { int b = blockIdx.x; asm volatile("" : "+s"(b)); return b; }
__device__ __forceinline__ unsigned cvt_pk_bf16(float lo, float hi) { unsigned r; asm volatile("v_cvt_pk_bf16_f32 %0, %1, %2" : "=v"(r) : "v"(lo), "v"(hi)); return r; }
__device__ __forceinline__ float bf_lo(unsigned w) { return __uint_as_float(w << 16); }
__device__ __forceinline__ float bf_hi(unsigned w) { return __uint_as_float(w & 0xffff0000u); }
__device__ __forceinline__ unsigned q8(float s) { return (unsigned)(s * 255.0f + 0.5f); }
__device__ __forceinline__ unsigned pack4(unsigned a, unsigned b, unsigned c, unsigned d) { return a | (b << 8) | (c << 16) | (d << 24); }
__device__ __forceinline__ float ub0(unsigned w) { return (float)(w & 0xffu); }
__device__ __forceinline__ float ub1(unsigned w) { return (float)((w >> 8) & 0xffu); }
__device__ __forceinline__ float ub2(unsigned w) { return (float)((w >> 16) & 0xffu); }
__device__ __forceinline__ float ub3(unsigned w) { return (float)(w >> 24); }
__device__ __forceinline__ float fast_sigmoid(float x) { return __builtin_amdgcn_rcpf(1.0f + __builtin_amdgcn_exp2f(-1.4426950408889634f * x)); }

constexpr int LDS_RB_OFF = 132096, LDS_RB_BYTES = 8192;
constexpr int LDS_XT_OFF = LDS_RB_OFF + 2 * LDS_RB_BYTES;
constexpr int LDS_TOTAL = 163840;
static_assert(LDS_XT_OFF + 4096 <= LDS_TOTAL, "LDS map");
namespace pg8 {
constexpr int BM = 256, BK = 64, HALF = 128, HTB = HALF * BK * 2  , STAGE_BYTES = 8 * HTB, NXCD = 8, WGM = 8;

__host__ __device__ __forceinline__ int lds_byte(int r, int c) { const int st = (r >> 4) * 2 + (c >> 5), rr = r & 15, cc = c & 31, ob = rr * 64 + cc * 2; return st * 1024 + (ob ^ (((ob >> 9) & 1) << 5)); }
__host__ __device__ __forceinline__ void stage_rc(int b, int& R, int& C) { const int st = b / 1024, sb = b % 1024, swz = sb ^ (((sb >> 9) & 1) << 5); R = (st >> 1) * 16 + swz / 64; C = (st & 1) * 32 + (swz % 64) / 2; }
__host__ __device__ __forceinline__ int perm32(int rho) { const int n = rho >> 4, i = rho & 15; return 8 * (i >> 2) + 4 * n + (i & 3); }

struct Unit { int pm, pn; };
struct Gemm { const bf16* A; const bf16* Bt; int M, N, K, lda, ldb; int kstepA = 0; long tstepA = 0; bool snake = false; bool splitA = false; };

struct StaticOrder {
    int nM, nN, nwg, G, c;
    __host__ __device__ void init(int M_, int N_, int G_, int c_) { nM = M_ / BM; nN = N_ / BM; nwg = nM * nN; G = G_; c = c_; }
    __host__ __device__ bool next(int i, Unit& u) const {
        const long L = (long)i * G + c; if (L >= nwg) return false;
        int wgid = (int)L; { const int q = nwg / NXCD, r = nwg % NXCD, xcd = wgid % NXCD, off = wgid / NXCD; wgid = (xcd < r ? xcd * (q + 1) : r * (q + 1) + (xcd - r) * q) + off; }
        const int nig = WGM * nN, gid = wgid / nig, fm = gid * WGM, gsz = (nM - fm) < WGM ? (nM - fm) : WGM;
        u.pm = fm + ((wgid % nig) % gsz); u.pn = (wgid % nig) / gsz; return true;
    }
};

struct WrapOrder : StaticOrder { int wrapN; int i0 = 0, i1 = 1 << 30;
    __host__ __device__ bool next(int i, Unit& u) const { if (i + i0 >= i1) return false; if (!StaticOrder::next(i + i0, u)) return false; u.pn %= wrapN; return true; } };

__device__ __forceinline__ void rs_prefetch(LAS unsigned char* lds, const float* SS8, const Unit& u, int ui, int wid, int lane) {
    const float* src = SS8 + ((size_t)u.pm * BM + 32 * wid) * 8 + lane * 4;
    __builtin_amdgcn_global_load_lds((const unsigned*)src, (LAS unsigned*)(lds + LDS_RB_OFF + (ui & 1) * LDS_RB_BYTES + wid * 1024), 16, 0, 0);
}
__device__ __forceinline__ void row_scales(LAS unsigned char* lds, int ui, int wr, int fr, float (&rs)[2][4]) {
    const LAS f32x4* rb = (const LAS f32x4*)(lds + LDS_RB_OFF + (ui & 1) * LDS_RB_BYTES);
#pragma unroll
    for (int ai = 0; ai < 2; ++ai)
#pragma unroll
        for (int m = 0; m < 4; ++m) { const int r = ai * HALF + wr * 64 + m * 16 + fr; const f32x4 x = rb[2 * r], y = rb[2 * r + 1];
            const float s = ((x[0] + x[1]) + (x[2] + x[3])) + ((y[0] + y[1]) + (y[2] + y[3]));
            rs[ai][m] = __builtin_amdgcn_rsqf(s * (1.0f / DM) + RMS_EPS); }
}
__device__ __forceinline__ float row_scale1(LAS unsigned char* lds, int ui, int r) {
    const LAS f32x4* rb = (const LAS f32x4*)(lds + LDS_RB_OFF + (ui & 1) * LDS_RB_BYTES);
    const f32x4 x = rb[2 * r], y = rb[2 * r + 1];
    return __builtin_amdgcn_rsqf((((x[0] + x[1]) + (x[2] + x[3])) + ((y[0] + y[1]) + (y[2] + y[3]))) * (1.0f / DM) + RMS_EPS);
}
struct RsPipe { f32x4 x, y;
    __device__ __forceinline__ void load(LAS unsigned char* lds, int ui, int r) { const LAS f32x4* rb = (const LAS f32x4*)(lds + LDS_RB_OFF + (ui & 1) * LDS_RB_BYTES); x = rb[2 * r]; y = rb[2 * r + 1]; }
    __device__ __forceinline__ float msq() const { return (((x[0] + x[1]) + (x[2] + x[3])) + ((y[0] + y[1]) + (y[2] + y[3]))) * (1.0f / DM) + RMS_EPS; }
};
#define RS_PIPE_BEGIN() RsPipe rs_nxt; rs_nxt.load(lds, ui, rl0)
#define RS_PIPE_STEP(cur_) const RsPipe cur_ = rs_nxt; { const int gn_ = ai * 4 + m + 1; if (gn_ < 8) rs_nxt.load(lds, ui, rl0 + (gn_ >> 2) * HALF + (gn_ & 3) * 16); } __builtin_amdgcn_sched_barrier(0)
struct EpiProj {
    static constexpr bool PERM = true, PREFETCH = true;
    bf16* O; int ldc; int sig_from; const float* SS; float* KP;
    __device__ __forceinline__ void prefetch(LAS unsigned char* lds, const Unit& u, int ui, int wid, int lane) const { rs_prefetch(lds, SS, u, ui, wid, lane); }
    __device__ __forceinline__ void operator()(const f32x4 (&acc)[2][2][4][2], const Unit& u, int wr, int wc, int fr, int fq, LAS unsigned char* lds, int ui) const {
        int row0 = u.pm * BM + wr * 64 + fr; const int colt = u.pn * BM;
        const bool sig = colt >= sig_from; const bool isk = colt >= C_K && colt < C_V; const bool isch = colt < C_B || (colt >= C_C && colt < C_Q);
        int col0 = colt + wc * 32 + 8 * fq;
        asm volatile("" : "+v"(row0), "+v"(col0));
        const int rl0 = wr * 64 + fr;
        RS_PIPE_BEGIN();
        if (sig) {
            const int gc0 = ((colt - sig_from) >> 1) + wc * 32 + 8 * fq;
#pragma unroll
            for (int ai = 0; ai < 2; ++ai)
#pragma unroll
                for (int m = 0; m < 4; ++m) { RS_PIPE_STEP(rsc); bf16* rowp = O + (size_t)(row0 + ai * HALF + m * 16) * ldc + gc0; const float k1 = -1.4426950408889634f * __builtin_amdgcn_rsqf(rsc.msq());
                    unsigned qc[8], qa[8];
#define SG8(A_) ((unsigned)(__builtin_amdgcn_rcpf(__builtin_fmaf(__builtin_amdgcn_exp2f((A_) * k1), 1.0f / 255.0f, 1.0f / 255.0f)) + 0.5f))
#pragma unroll
                    for (int e = 0; e < 4; ++e) { qc[e] = SG8(acc[ai][0][m][0][e]); qc[4 + e] = SG8(acc[ai][0][m][1][e]);
                        const unsigned a0 = SG8(acc[ai][1][m][0][e]), a1 = SG8(acc[ai][1][m][1][e]);
                        qa[e] = a0 < 1u ? 1u : a0; qa[4 + e] = a1 < 1u ? 1u : a1; }
                    u32x4 w; w.x = pack4(qc[0], qc[1], qc[2], qc[3]); w.y = pack4(qc[4], qc[5], qc[6], qc[7]); w.z = pack4(qa[0], qa[1], qa[2], qa[3]); w.w = pack4(qa[4], qa[5], qa[6], qa[7]);
                    *(u32x4*)(rowp + C_GC) = w; }
#undef SG8
            return;
        }
        if (isch) {
            const int pk = u.pn < 4 ? u.pn : u.pn - 4, cc0 = 128 * pk + wc * 32 + 8 * fq;
#pragma unroll
            for (int ai = 0; ai < 2; ++ai)
#pragma unroll
                for (int m = 0; m < 4; ++m) { RS_PIPE_STEP(rsc); const float r2 = __builtin_amdgcn_rcpf(rsc.msq());
                    const f32x4 p0 = acc[ai][0][m][0] * acc[ai][1][m][0] * r2, p1 = acc[ai][0][m][1] * acc[ai][1][m][1] * r2;
                    u32x4 w; w.x = cvt_pk_bf16(p0[0], p0[1]); w.y = cvt_pk_bf16(p0[2], p0[3]); w.z = cvt_pk_bf16(p1[0], p1[1]); w.w = cvt_pk_bf16(p1[2], p1[3]);
                    *(u32x4*)(O + (size_t)(row0 + ai * HALF + m * 16) * ldc + C_H + cc0) = w; }
            return;
        }
#pragma unroll
        for (int ai = 0; ai < 2; ++ai)
#pragma unroll
            for (int m = 0; m < 4; ++m) { RS_PIPE_STEP(rsc); bf16* rowp = O + (size_t)(row0 + ai * HALF + m * 16) * ldc + col0; const float rsv = __builtin_amdgcn_rsqf(rsc.msq());
#pragma unroll
                for (int bj = 0; bj < 2; ++bj) { f32x4 v0 = acc[ai][bj][m][0] * rsv, v1 = acc[ai][bj][m][1] * rsv;
                    u32x4 w; w.x = cvt_pk_bf16(v0[0], v0[1]); w.y = cvt_pk_bf16(v0[2], v0[3]); w.z = cvt_pk_bf16(v1[0], v1[1]); w.w = cvt_pk_bf16(v1[2], v1[3]);
                    *(u32x4*)(rowp + bj * HALF) = w; }
                __builtin_amdgcn_sched_barrier(0); }
        if (isk) {
            f32x4 cs[2][2];
#pragma unroll
            for (int bj = 0; bj < 2; ++bj)
#pragma unroll
                for (int n = 0; n < 2; ++n) { f32x4 t = (f32x4){0.f, 0.f, 0.f, 0.f};
#pragma unroll
                    for (int ai = 0; ai < 2; ++ai)
#pragma unroll
                        for (int m = 0; m < 4; ++m) t += acc[ai][bj][m][n] * row_scale1(lds, ui, rl0 + ai * HALF + m * 16);
                    cs[bj][n] = t; }
#pragma unroll
            for (int bj = 0; bj < 2; ++bj)
#pragma unroll
                for (int n = 0; n < 2; ++n)
#pragma unroll
                    for (int e = 0; e < 4; ++e) { float x = cs[bj][n][e]; x += __shfl_xor(x, 1); x += __shfl_xor(x, 2); x += __shfl_xor(x, 4); x += __shfl_xor(x, 8); cs[bj][n][e] = x; }
            if (fr == 0) { float* kp = KP + (size_t)(u.pm * 2 + wr) * 1024 + (colt - C_K) + wc * 32 + 8 * fq;
#pragma unroll
                for (int bj = 0; bj < 2; ++bj) { *(f32x4*)(kp + bj * HALF) = cs[bj][0]; *(f32x4*)(kp + bj * HALF + 4) = cs[bj][1]; } }
        }
    }
};
struct MidGateRatio {
    static constexpr bool ENABLED = true;
    const bf16* R; int ldg;
    __device__ __forceinline__ void operator()(f32x4 (&acc)[2][2][4][2], const Unit& u, int wr, int wc, int fr, int fq) const {
        int row0 = u.pm * BM + wr * 64 + fr; int col0 = u.pn * BM + wc * 32 + 8 * fq;
        asm volatile("" : "+v"(row0), "+v"(col0));
        const char* base = (const char*)R + ((size_t)row0 * ldg + col0) * 2;
        const size_t rstep = (size_t)ldg * 32;
        u32x4 rr[2][4][2];
#pragma unroll
        for (int ai = 0; ai < 2; ++ai)
#pragma unroll
            for (int m = 0; m < 4; ++m) { const char* p = base + (size_t)(ai * 8 + m) * rstep;
#pragma unroll
                for (int bj = 0; bj < 2; ++bj) rr[ai][m][bj] = *(const u32x4*)(p + bj * 256); }
        __builtin_amdgcn_sched_barrier(0);
#pragma unroll
        for (int ai = 0; ai < 2; ++ai)
#pragma unroll
            for (int m = 0; m < 4; ++m)
#pragma unroll
                for (int bj = 0; bj < 2; ++bj) { const u32x4 c = rr[ai][m][bj];
                    acc[ai][bj][m][0] *= (f32x4){ub0(c.x) * __builtin_amdgcn_rcpf(ub0(c.z)), ub1(c.x) * __builtin_amdgcn_rcpf(ub1(c.z)), ub2(c.x) * __builtin_amdgcn_rcpf(ub2(c.z)), ub3(c.x) * __builtin_amdgcn_rcpf(ub3(c.z))};
                    acc[ai][bj][m][1] *= (f32x4){ub0(c.y) * __builtin_amdgcn_rcpf(ub0(c.w)), ub1(c.y) * __builtin_amdgcn_rcpf(ub1(c.w)), ub2(c.y) * __builtin_amdgcn_rcpf(ub2(c.w)), ub3(c.y) * __builtin_amdgcn_rcpf(ub3(c.w))}; }
        __builtin_amdgcn_sched_barrier(0);
    }
};
struct EpiGateBf16 {
    static constexpr bool PERM = true, PREFETCH = false;
    bf16* O; int ldc; const bf16* G; int ldg;
    __device__ __forceinline__ void operator()(const f32x4 (&acc)[2][2][4][2], const Unit& u, int wr, int wc, int fr, int fq, LAS unsigned char* lds, int ui) const {
        const int row0 = u.pm * BM + wr * 64 + fr; const int col0 = u.pn * BM + wc * 32 + 8 * fq;
        u32x2 gg[2][4][2];
#pragma unroll
        for (int ai = 0; ai < 2; ++ai)
#pragma unroll
            for (int m = 0; m < 4; ++m)
#pragma unroll
                for (int bj = 0; bj < 2; ++bj) gg[ai][m][bj] = *(const u32x2*)((const char*)(G + (size_t)(row0 + ai * HALF + m * 16) * ldg + col0 + bj * HALF) + 8);
        __builtin_amdgcn_sched_barrier(0);
        const float k = 1.0f / 255.0f;
#pragma unroll
        for (int ai = 0; ai < 2; ++ai)
#pragma unroll
            for (int m = 0; m < 4; ++m) { const size_t r = (size_t)(row0 + ai * HALF + m * 16);
#pragma unroll
                for (int bj = 0; bj < 2; ++bj) { const u32x2 g = gg[ai][m][bj];
                    f32x4 v0 = acc[ai][bj][m][0] * k, v1 = acc[ai][bj][m][1] * k;
                    v0[0] *= ub0(g.x); v0[1] *= ub1(g.x); v0[2] *= ub2(g.x); v0[3] *= ub3(g.x);
                    v1[0] *= ub0(g.y); v1[1] *= ub1(g.y); v1[2] *= ub2(g.y); v1[3] *= ub3(g.y);
                    u32x4 w; w.x = cvt_pk_bf16(v0[0], v0[1]); w.y = cvt_pk_bf16(v0[2], v0[3]); w.z = cvt_pk_bf16(v1[0], v1[1]); w.w = cvt_pk_bf16(v1[2], v1[3]);
                    *(u32x4*)(O + r * ldc + col0 + bj * HALF) = w; } }
    }
};
struct EpiResBf16 {
    static constexpr bool PERM = true, PREFETCH = false;
    const bf16* X; bf16* XO; int ldc; float* SS;
    __device__ __forceinline__ void operator()(const f32x4 (&acc)[2][2][4][2], const Unit& u, int wr, int wc, int fr, int fq, LAS unsigned char* lds, int ui) const {
        const int row0 = u.pm * BM + wr * 64 + fr; const int col0 = u.pn * BM + wc * 32 + 8 * fq;
        LAS float* XT = (LAS float*)(lds + LDS_XT_OFF);
        u32x4 xx[2][4][2];
#pragma unroll
        for (int ai = 0; ai < 2; ++ai)
#pragma unroll
            for (int m = 0; m < 4; ++m)
#pragma unroll
                for (int bj = 0; bj < 2; ++bj) xx[ai][m][bj] = *(const u32x4*)(X + (size_t)(row0 + ai * HALF + m * 16) * ldc + col0 + bj * HALF);
        __builtin_amdgcn_sched_barrier(0);
#pragma unroll
        for (int ai = 0; ai < 2; ++ai)
#pragma unroll
            for (int m = 0; m < 4; ++m) { const size_t r = (size_t)(row0 + ai * HALF + m * 16); float ss = 0.f;
#pragma unroll
                for (int bj = 0; bj < 2; ++bj) { bf16* xp = XO + r * ldc + col0 + bj * HALF; const u32x4 xo = xx[ai][m][bj];
                    f32x4 v0 = acc[ai][bj][m][0], v1 = acc[ai][bj][m][1];
                    v0[0] += bf_lo(xo.x); v0[1] += bf_hi(xo.x); v0[2] += bf_lo(xo.y); v0[3] += bf_hi(xo.y);
                    v1[0] += bf_lo(xo.z); v1[1] += bf_hi(xo.z); v1[2] += bf_lo(xo.w); v1[3] += bf_hi(xo.w);
                    ss += ((v0[0] * v0[0] + v0[1] * v0[1]) + (v0[2] * v0[2] + v0[3] * v0[3])) + ((v1[0] * v1[0] + v1[1] * v1[1]) + (v1[2] * v1[2] + v1[3] * v1[3]));
                    u32x4 w; w.x = cvt_pk_bf16(v0[0], v0[1]); w.y = cvt_pk_bf16(v0[2], v0[3]); w.z = cvt_pk_bf16(v1[0], v1[1]); w.w = cvt_pk_bf16(v1[2], v1[3]);
                    *(u32x4*)xp = w; }
                ss += __shfl_xor(ss, 16); ss += __shfl_xor(ss, 32);
                if (fq == 0) XT[(ai * HALF + wr * 64 + m * 16 + fr) * 4 + wc] = ss; }
        asm volatile("s_waitcnt lgkmcnt(0)" ::: "memory"); __builtin_amdgcn_s_barrier(); asm volatile("" ::: "memory");
        const int t = fresh_tid();
        if (t < 256) { const f32x4 p = *(const LAS f32x4*)(XT + t * 4); SS[((size_t)u.pm * BM + t) * 8 + u.pn] = (p[0] + p[1]) + (p[2] + p[3]); }
        asm volatile("s_waitcnt lgkmcnt(0)" ::: "memory");
    }
};
struct EpiSwiGLU {
    static constexpr bool PERM = true, PREFETCH = true;
    bf16* O; long pstep; const float* SS;
    __device__ __forceinline__ void prefetch(LAS unsigned char* lds, const Unit& u, int ui, int wid, int lane) const { rs_prefetch(lds, SS, u, ui, wid, lane); }
    __device__ __forceinline__ void operator()(const f32x4 (&acc)[2][2][4][2], const Unit& u, int wr, int wc, int fr, int fq, LAS unsigned char* lds, int ui) const {
        bf16* tbase = O + (size_t)u.pm * pstep + ((size_t)(u.pn * 4 + wc) * BM + wr * 64 + fr) * 32 + 8 * fq;
        const int rl0 = wr * 64 + fr;
        RS_PIPE_BEGIN();
#pragma unroll
        for (int ai = 0; ai < 2; ++ai)
#pragma unroll
            for (int m = 0; m < 4; ++m) { RS_PIPE_STEP(rsc); bf16* rowp = tbase + (ai * HALF + m * 16) * 32;
                const float irs2 = rsc.msq();
                const float k1 = -1.4426950408889634f * __builtin_amdgcn_rsqf(irs2);
                f32x4 v0, v1;
#pragma unroll
                for (int e = 0; e < 4; ++e) { const float a0 = acc[ai][0][m][0][e], a1 = acc[ai][0][m][1][e];
                    const float d0 = __builtin_fmaf(__builtin_amdgcn_exp2f(a0 * k1), irs2, irs2), d1 = __builtin_fmaf(__builtin_amdgcn_exp2f(a1 * k1), irs2, irs2);
                    v0[e] = (a0 * acc[ai][1][m][0][e]) * __builtin_amdgcn_rcpf(d0); v1[e] = (a1 * acc[ai][1][m][1][e]) * __builtin_amdgcn_rcpf(d1); }
                u32x4 w; w.x = cvt_pk_bf16(v0[0], v0[1]); w.y = cvt_pk_bf16(v0[2], v0[3]); w.z = cvt_pk_bf16(v1[0], v1[1]); w.w = cvt_pk_bf16(v1[2], v1[3]);
                *(u32x4*)rowp = w; }
    }
};

struct NoMid { static constexpr bool ENABLED = false; __device__ __forceinline__ void operator()(f32x4 (&)[2][2][4][2], const Unit&, int, int, int, int) const {} };
template <class Epi, class Sched, bool ALIGN_EPI, class Mid = NoMid>
__device__ __forceinline__ void gemm_phase(LAS unsigned char* lds, const Gemm g, const Sched& S, const Epi& E, const Mid& MH = Mid()) {
    int tid = fresh_tid(); const int wid = __builtin_amdgcn_readfirstlane(tid >> 6); int lane = tid & 63; const int wr = wid >> 2, wc = wid & 3; int fr = lane & 15, fq = lane >> 4;
    const int K = g.K, nt = K / BK;
    unsigned voffA[2], voffB[2]; int aoff, boff;
#define PG8_LANE_CONSTS() do { _Pragma("unroll") for (int i_ = 0; i_ < 2; ++i_) { int R_, C_; stage_rc(tid * 16 + i_ * 8192, R_, C_); const int Rb_ = Epi::PERM ? ((R_ & ~31) + perm32(R_ & 31)) : R_; \
        voffA[i_] = g.splitA ? (unsigned)((C_ >> 5) * 256 * 32 + R_ * 32 + (C_ & 31)) * 2u : (unsigned)(R_ * g.lda + C_) * 2u; voffB[i_] = (unsigned)(Rb_ * g.ldb + C_) * 2u; } \
        aoff = lds_byte(wr * 64 + fr, fq * 8); boff = lds_byte(wc * 32 + fr, fq * 8); } while (0)
    PG8_LANE_CONSTS();
    const size_t kstep = (size_t)(BK * 2);
    const size_t kstepA = g.kstepA ? (size_t)g.kstepA : kstep;
    const size_t hstepA = g.splitA ? (size_t)HALF * 32 * 2 : (size_t)HALF * g.lda * 2, hstepB = (size_t)HALF * g.ldb * 2;
    const size_t tstepA = g.tstepA ? (size_t)g.tstepA : 2 * hstepA, tstepB = 2 * hstepB;
    const unsigned ldsw = (unsigned)wid * 1024u;
#define PG8_SA(b, h) (((b) * 2 + (h)) * HTB)
#define PG8_SB(b, h) ((4 + (b) * 2 + (h)) * HTB)
#define PG8_STAGE(bufoff, gbase, voff) do { _Pragma("unroll") for (int _i = 0; _i < 2; ++_i) \
        __builtin_amdgcn_global_load_lds((const unsigned*)((const char*)(gbase) + (voff)[_i]), (LAS unsigned*)(lds + (bufoff) + ldsw + _i * 8192), 16, 0, 0); } while (0)
#define PG8_LDA(dst, b, h) do { _Pragma("unroll") for (int m = 0; m < 4; ++m) _Pragma("unroll") for (int k = 0; k < 2; ++k) dst[m][k] = *(const LAS bf16x8*)(lds + PG8_SA(b, h) + aoff + m * 2048 + k * 1024); } while (0)
#define PG8_LDB(dst, b, h) do { _Pragma("unroll") for (int n = 0; n < 2; ++n) _Pragma("unroll") for (int k = 0; k < 2; ++k) dst[n][k] = *(const LAS bf16x8*)(lds + PG8_SB(b, h) + boff + n * 2048 + k * 1024); } while (0)
#define PG8_MMA(ai, bj, At, Bt) do { __builtin_amdgcn_s_setprio(1); _Pragma("unroll") for (int m = 0; m < 4; ++m) _Pragma("unroll") for (int n = 0; n < 2; ++n) _Pragma("unroll") for (int k = 0; k < 2; ++k) \
        acc[ai][bj][m][n] = __builtin_amdgcn_mfma_f32_16x16x32_bf16(Bt[n][k], At[m][k], acc[ai][bj][m][n], 0, 0, 0); __builtin_amdgcn_s_setprio(0); } while (0)
#define PG8_WAIT_V(n) asm volatile("s_waitcnt vmcnt(" #n ")" ::: "memory")
#define PG8_WAIT_L(n) asm volatile("s_waitcnt lgkmcnt(" #n ")" ::: "memory")
#define PG8_BAR __builtin_amdgcn_s_barrier()
#define PG8_SCHED __builtin_amdgcn_sched_barrier(0)
    Unit cur, nxt; int ui = 0;
    if (!S.next(0, cur)) return;
    const bool snake = g.snake;
    const size_t spanA = (size_t)(nt - 1) * kstepA, spanB = (size_t)(nt - 1) * kstep;
    long sA = snake ? -(long)kstepA : (long)kstepA, sB = snake ? -(long)kstep : (long)kstep;
    f32x4 acc[2][2][4][2];
#pragma unroll
    for (int a = 0; a < 2; ++a)
#pragma unroll
        for (int b = 0; b < 2; ++b)
#pragma unroll
            for (int m = 0; m < 4; ++m)
#pragma unroll
                for (int n = 0; n < 2; ++n) acc[a][b][m][n] = (f32x4){0.f, 0.f, 0.f, 0.f};
    bf16x8 At[4][2], B0[2][2], B1[2][2];
    const char* cA = (const char*)g.A + (size_t)cur.pm * tstepA + (snake ? spanA : 0); const char* cB = (const char*)g.Bt + (size_t)cur.pn * tstepB + (snake ? spanB : 0);
    if constexpr (Epi::PREFETCH) E.prefetch(lds, cur, 0, wid, lane);
    PG8_STAGE(PG8_SB(0, 0), cB, voffB); PG8_STAGE(PG8_SB(0, 1), cB + hstepB, voffB); PG8_STAGE(PG8_SA(0, 0), cA, voffA); PG8_STAGE(PG8_SA(0, 1), cA + hstepA, voffA);
    PG8_STAGE(PG8_SB(1, 0), cB + sB, voffB); PG8_STAGE(PG8_SA(1, 0), cA + sA, voffA); PG8_STAGE(PG8_SB(1, 1), cB + hstepB + sB, voffB);
    if (wr == 1) PG8_BAR;
    PG8_WAIT_V(8); PG8_BAR;
    PG8_WAIT_V(6); PG8_BAR;
    for (;;) {
        if (ui > 0) { tid = fresh_tid(); lane = tid & 63; fr = lane & 15; fq = lane >> 4; PG8_LANE_CONSTS(); }
        const bool has_next = S.next(ui + 1, nxt);
        const long nsA = has_next ? (snake ? -sA : sA) : 0, nsB = has_next ? (snake ? -sB : sB) : 0;
        const char* nA = has_next ? (const char*)g.A + (size_t)nxt.pm * tstepA + (nsA < 0 ? spanA : 0) : cA; const char* nB = has_next ? (const char*)g.Bt + (size_t)nxt.pn * tstepB + (nsB < 0 ? spanB : 0) : cB;
        for (int t = 0; t < nt; t += 2) {
            if constexpr (Mid::ENABLED) { if (t == (nt >> 1)) MH(acc, cur, wr, wc, fr, fq); }
            const bool last = (t == nt - 2);
            const char* a1 = cA + (long)(t + 1) * sA;
            const char* a2 = last ? nA : cA + (long)(t + 2) * sA; const char* b2 = last ? nB : cB + (long)(t + 2) * sB;
            const char* a3 = a2 + (last ? nsA : sA); const char* b3 = b2 + (last ? nsB : sB);
            PG8_LDB(B0, 0, 0); PG8_LDB(B1, 0, 1); PG8_SCHED; PG8_LDA(At, 0, 0); PG8_STAGE(PG8_SA(1, 1), a1 + hstepA, voffA);
            PG8_WAIT_V(8); PG8_WAIT_L(0); PG8_BAR; PG8_MMA(0, 0, At, B0); PG8_MMA(0, 1, At, B1); PG8_BAR; PG8_SCHED;
            PG8_LDA(At, 0, 1); PG8_STAGE(PG8_SB(0, 0), b2, voffB); PG8_STAGE(PG8_SB(0, 1), b2 + hstepB, voffB); PG8_STAGE(PG8_SA(0, 0), a2, voffA);
            PG8_WAIT_V(8); PG8_WAIT_L(0); PG8_BAR; PG8_MMA(1, 0, At, B0); PG8_MMA(1, 1, At, B1); PG8_BAR; PG8_SCHED;
            PG8_LDB(B0, 1, 0); PG8_LDB(B1, 1, 1); PG8_SCHED; PG8_LDA(At, 1, 0); PG8_STAGE(PG8_SA(0, 1), a2 + hstepA, voffA);
            PG8_WAIT_V(8); PG8_WAIT_L(0); PG8_BAR; PG8_MMA(0, 0, At, B0); PG8_MMA(0, 1, At, B1); PG8_BAR; PG8_SCHED;
            PG8_LDA(At, 1, 1); PG8_STAGE(PG8_SB(1, 0), b3, voffB); PG8_STAGE(PG8_SB(1, 1), b3 + hstepB, voffB); PG8_STAGE(PG8_SA(1, 0), a3, voffA);
            PG8_WAIT_V(8); PG8_WAIT_L(0); PG8_BAR; PG8_MMA(1, 0, At, B0); PG8_MMA(1, 1, At, B1); PG8_BAR; PG8_SCHED;
        }
        if constexpr (ALIGN_EPI) { if (wr == 0) PG8_BAR; }
        E(acc, cur, wr, wc, fr, fq, lds, ui);
        if (!has_next) break;
#pragma unroll
        for (int a = 0; a < 2; ++a)
#pragma unroll
            for (int b = 0; b < 2; ++b)
#pragma unroll
                for (int m = 0; m < 4; ++m)
#pragma unroll
                    for (int n = 0; n < 2; ++n) acc[a][b][m][n] = (f32x4){0.f, 0.f, 0.f, 0.f};
        cur = nxt; cA = nA; cB = nB; sA = nsA; sB = nsB; ++ui;
        if constexpr (Epi::PREFETCH) E.prefetch(lds, cur, ui, wid, lane);
        if constexpr (ALIGN_EPI) { if (wr == 1) PG8_BAR; }
    }
    PG8_WAIT_V(0);
    if constexpr (!ALIGN_EPI) { if (wr == 0) PG8_BAR; }
    PG8_BAR;
#undef PG8_LANE_CONSTS
#undef PG8_SA
#undef PG8_SB
#undef PG8_STAGE
#undef PG8_LDA
#undef PG8_LDB
#undef PG8_MMA
#undef PG8_WAIT_V
#undef PG8_WAIT_L
#undef PG8_BAR
#undef PG8_SCHED
}
}

namespace att {
constexpr int D = 128, NW = 8, QBLK = 32, KVBLK = 64, QB = NW * QBLK;
constexpr int PQ = INC;
constexpr int PO = 2048;
constexpr int SHM_V = KVBLK * D * 2, SHM_K = KVBLK * D * 2;
constexpr int LDS_WS = 2 * SHM_V + 2 * SHM_K;
constexpr int LDS_KM = LDS_WS + NW * 64 * 4;
constexpr int LDS_LUT = LDS_KM + 16 * 128 * 4;
constexpr int LDS_BYTES = LDS_LUT + 128 * 4;
constexpr float SCALE = 0.08838834764831845f;
constexpr float THR = 8.f;

#define KSWZ(row, colB) ((row) * 256 + ((colB) ^ (((row) & 15) << 4)))
#define SBAR() __builtin_amdgcn_sched_barrier(0)
__device__ __forceinline__ int v_st(int k, int c) { const int kk = (k & ~0xC) | ((k & 4) << 1) | ((k & 8) >> 1); return ((kk >> 3) * 4 + (c >> 5)) * 512 + ((kk & 7) * 32 + (c & 31)) * 2; }
__device__ __forceinline__ int v_rd_base(int lane) { return ((lane & 3) << 3) | (((lane >> 2) & 3) << 6) | (((lane >> 4) & 1) << 5) | (((lane >> 5) & 1) << 8); }
constexpr int v_rd_off(int d0, int ks, int half) { return d0 * 512 + ks * 4096 + half * 2048; }
__device__ __forceinline__ int crow(int r, int hi) { return (r & 3) + 8 * (r >> 2) + 4 * hi; }
__device__ __forceinline__ unsigned cvtpk(float lo, float hi) { unsigned r; asm volatile("v_cvt_pk_bf16_f32 %0, %1, %2" : "=v"(r) : "v"(lo), "v"(hi)); return r; }
__device__ __forceinline__ bf16x8 load8(const bf16* p) { return *reinterpret_cast<const bf16x8*>(p); }

__device__ __forceinline__ bool moba_mask(f32x16& p0, f32x16& p1, int kb, int ib, int qm, unsigned selmask, const float* LUT, int qlo) {
    const float NEG = -__builtin_inff();
    const int jb = kb >> 8;
    if (kb + 63 + 113 <= qlo) {
        return jb != ib && ((selmask >> jb) & 1u) == 0u;
    } else {
        const bool ok = (jb == ib) || ((selmask >> jb) & 1u);
        const int dq = qm - kb;
#pragma unroll
        for (int g = 0; g < 4; ++g) {
#pragma unroll
            for (int e = 0; e < 4; ++e) { const int r = 4 * g + e;
                const int c = (r & 3) + 8 * (r >> 2);
                const int d0 = dq - c, d1 = d0 - 32;
                const int i0 = d0 < 0 ? 0 : (d0 > 127 ? 127 : d0), i1 = d1 < 0 ? 0 : (d1 > 127 ? 127 : d1);
                const float b0 = LUT[i0], b1 = LUT[i1];
                p0[r] = (ok && d0 >= 0) ? p0[r] + b0 : NEG;
                p1[r] = (ok && d1 >= 0) ? p1[r] + b1 : NEG; }
            SBAR();
        }
    }
    return false;
}
__device__ __forceinline__ void partialSM(f32x16& p0, f32x16& p1, float& m_reg, float& mn, float& alpha, bool dead) {
    float pmax;
    { float ma = p0[0], mb = p1[0];
#pragma unroll
      for (int r = 1; r < 16; ++r) { ma = fmaxf(ma, p0[r]); mb = fmaxf(mb, p1[r]); }
      pmax = fmaxf(ma, mb); }
    { auto rr = __builtin_amdgcn_permlane32_swap(__float_as_uint(pmax), __float_as_uint(pmax), false, false);
      pmax = fmaxf(__uint_as_float(rr[0]), __uint_as_float(rr[1])); }
    constexpr float C2 = 1.4426950408889634f * SCALE;
    mn = ((pmax - m_reg) * SCALE <= THR) ? m_reg : pmax;
    alpha = __builtin_amdgcn_exp2f((m_reg - mn) * C2);
    m_reg = mn;
    const float mnL = dead ? -__builtin_inff() : -mn * C2;
    for (int r = 0; r < 16; ++r) p0[r] = fmaf(p0[r], C2, mnL); for (int r = 0; r < 16; ++r) p1[r] = fmaf(p1[r], C2, mnL);
    for (int r = 0; r < 16; ++r) p0[r] = __builtin_amdgcn_exp2f(p0[r]);
}
__device__ __forceinline__ void finishSM(f32x16& p0, f32x16& p1, float alpha, float& l_reg, bf16x8& pa0, bf16x8& pa1, bf16x8& pa2, bf16x8& pa3) {
    for (int r = 0; r < 16; ++r) p1[r] = __builtin_amdgcn_exp2f(p1[r]);
    float ps;
    { float s0 = p0[0], s1 = p0[1], s2 = p0[2], s3 = p0[3];
#define ADDF(a_, b_) asm("v_add_f32 %0, %0, %1" : "+v"(a_) : "v"(b_))
#pragma unroll
      for (int r = 4; r < 16; r += 4) { ADDF(s0, p0[r]); ADDF(s1, p0[r + 1]); ADDF(s2, p0[r + 2]); ADDF(s3, p0[r + 3]); }
#pragma unroll
      for (int r = 0; r < 16; r += 4) { ADDF(s0, p1[r]); ADDF(s1, p1[r + 1]); ADDF(s2, p1[r + 2]); ADDF(s3, p1[r + 3]); }
      ADDF(s0, s1); ADDF(s2, s3); ADDF(s0, s2); ps = s0; }
#undef ADDF
    { auto rr = __builtin_amdgcn_permlane32_swap(__float_as_uint(ps), __float_as_uint(ps), false, false);
      ps = __uint_as_float(rr[0]) + __uint_as_float(rr[1]); }
    l_reg = l_reg * alpha + ps;
#define PK4(P, B_, OUT) do { unsigned a0 = cvtpk(P[B_+0], P[B_+1]), a1 = cvtpk(P[B_+2], P[B_+3]);                          \
        unsigned b0 = cvtpk(P[B_+4], P[B_+5]), b1 = cvtpk(P[B_+6], P[B_+7]);                                             \
        auto r0 = __builtin_amdgcn_permlane32_swap(a0, b0, false, false); auto r1 = __builtin_amdgcn_permlane32_swap(a1, b1, false, false); \
        u32x4 w = {r0[0], r1[0], r0[1], r1[1]}; OUT = *reinterpret_cast<bf16x8*>(&w); } while (0)
    PK4(p0, 0, pa0); PK4(p0, 8, pa1); PK4(p1, 0, pa2); PK4(p1, 8, pa3);
#undef PK4
}
template <int KB>
__device__ __forceinline__ void qkt(f32x16& p0, f32x16& p1, const char* K_lds, int r32, int hi, const bf16x8* qr) {
    p0 = f32x16{}; p1 = f32x16{};
    const int base = (int)(uintptr_t)K_lds;
    int ad[4];
#pragma unroll
    for (int dd = 0; dd < 4; ++dd) ad[dd] = base + KSWZ(r32, (dd * 16 + hi * 8) * 2);
    const int d47 = 128 - ((r32 & 8) << 5);
#define KRD(dst, addr, off) asm volatile("ds_read_b128 %0, %1 offset:%2" : "=&v"(dst) : "v"(addr), "i"(off) : "memory")
#define KWAIT(n, x, y) asm volatile("s_waitcnt lgkmcnt(" #n ")" : "+v"(x), "+v"(y) :: "memory")
    bf16x8 fa0, fb0, fa1, fb1;
    KRD(fa0, ad[0], KB * SHM_K); KRD(fb0, ad[0], KB * SHM_K + 32 * 256);
#define QK_STEP(d0, FA, FB, NA, NB) do {                                                                                        \
        if ((d0) < 7) { const int an_ = ad[((d0) + 1) & 3] + ((((d0) + 1) >> 2) ? d47 : 0); KRD(NA, an_, KB * SHM_K); KRD(NB, an_, KB * SHM_K + 32 * 256); KWAIT(2, FA, FB); } \
        else KWAIT(0, FA, FB);                                                                                                  \
        p0 = __builtin_amdgcn_mfma_f32_32x32x16_bf16(FA, qr[d0], p0, 0, 0, 0);                                                 \
        p1 = __builtin_amdgcn_mfma_f32_32x32x16_bf16(FB, qr[d0], p1, 0, 0, 0); } while (0)
    QK_STEP(0, fa0, fb0, fa1, fb1); QK_STEP(1, fa1, fb1, fa0, fb0); QK_STEP(2, fa0, fb0, fa1, fb1); QK_STEP(3, fa1, fb1, fa0, fb0);
    QK_STEP(4, fa0, fb0, fa1, fb1); QK_STEP(5, fa1, fb1, fa0, fb0); QK_STEP(6, fa0, fb0, fa1, fb1); QK_STEP(7, fa1, fb1, fa0, fb0);
#undef QK_STEP
#undef KRD
#undef KWAIT
}
template <int VB>
__device__ __forceinline__ void pv_tile(f32x16* o, int vb0, bf16x8 pa0, bf16x8 pa1, bf16x8 pa2, bf16x8 pa3) {
#define TRRD(dst, off) asm volatile("ds_read_b64_tr_b16 %0, %1 offset:%2" : "=&v"(dst) : "v"(vb0), "i"(off) : "memory")
#define PV_D0(d0) do { s16x4 l0, l1, l2, l3, h0, h1, h2, h3; constexpr int b_ = VB * SHM_V + v_rd_off(d0, 0, 0); \
        TRRD(l0, b_); TRRD(h0, b_ + 2048); TRRD(l1, b_ + 4096); TRRD(h1, b_ + 6144); TRRD(l2, b_ + 8192); TRRD(h2, b_ + 10240); TRRD(l3, b_ + 12288); TRRD(h3, b_ + 14336); \
        asm volatile("s_waitcnt lgkmcnt(0)" ::: "memory"); SBAR();   \
        o[d0] = __builtin_amdgcn_mfma_f32_32x32x16_bf16(pa0, (bf16x8){l0[0], l0[1], l0[2], l0[3], h0[0], h0[1], h0[2], h0[3]}, o[d0], 0, 0, 0);   \
        o[d0] = __builtin_amdgcn_mfma_f32_32x32x16_bf16(pa1, (bf16x8){l1[0], l1[1], l1[2], l1[3], h1[0], h1[1], h1[2], h1[3]}, o[d0], 0, 0, 0);   \
        o[d0] = __builtin_amdgcn_mfma_f32_32x32x16_bf16(pa2, (bf16x8){l2[0], l2[1], l2[2], l2[3], h2[0], h2[1], h2[2], h2[3]}, o[d0], 0, 0, 0);   \
        o[d0] = __builtin_amdgcn_mfma_f32_32x32x16_bf16(pa3, (bf16x8){l3[0], l3[1], l3[2], l3[3], h3[0], h3[1], h3[2], h3[3]}, o[d0], 0, 0, 0); } while (0)
    PV_D0(0); PV_D0(1); PV_D0(2); PV_D0(3);
#undef PV_D0
#undef TRRD
}

struct BlockRef { const bf16* Q; const bf16* K; const bf16* V; bf16* O; int P0; };
struct Seam { bf16x8 qr[8]; };
#define VMW() asm volatile("s_waitcnt vmcnt(0)" ::: "memory")
struct DmaMap { unsigned koff, voff; };
__device__ __forceinline__ DmaMap dma_map(int wid, int lane) {
    DmaMap d;
    { const int row = 4 * wid + (lane >> 4), g = (lane & 15) ^ (row & 15); d.koff = (unsigned)(row * PQ + g * 8); }
    { const int B = 2 * wid + (lane >> 5), kk = (B >> 2) * 8 + ((lane & 31) >> 2), c = (B & 3) * 32 + (lane & 3) * 8;
      const int k = (kk & ~0xC) | ((kk & 4) << 1) | ((kk & 8) >> 1); d.voff = (unsigned)(k * PQ + c); }
    return d;
}
#define DMA16(g_, l_) __builtin_amdgcn_global_load_lds((const unsigned*)(g_), (LAS unsigned*)(l_), 16, 0, 0)
#define DMA_K(bf, k0) do { const bf16* g_ = Kh + (size_t)(k0) * PQ + dm.koff; DMA16(g_, KL + (bf) * SHM_K + wid * 1024); DMA16(g_ + 32 * PQ, KL + (bf) * SHM_K + 8192 + wid * 1024); } while (0)
#define DMA_V(bf, k0) do { const bf16* g_ = Vh + (size_t)(k0) * PQ + dm.voff; DMA16(g_, VL + (bf) * SHM_V + wid * 1024); DMA16(g_ + 32 * PQ, VL + (bf) * SHM_V + 8192 + wid * 1024); } while (0)

__device__ __forceinline__ void moba_prime(const BlockRef& cur, char* lds, Seam& S, bool wait = true) {
    const int tid = fresh_tid(), wid = __builtin_amdgcn_readfirstlane(tid >> 6), lane = tid & 63, r32 = lane & 31, hi = lane >> 5;
    LAS unsigned char* VL = (LAS unsigned char*)(unsigned)(uintptr_t)lds; LAS unsigned char* KL = VL + 2 * SHM_V;
    const bf16* Kh = cur.K; const bf16* Vh = cur.V; const DmaMap dm = dma_map(wid, lane);
    DMA_K(0, 0); DMA_V(0, 0);
    for (int d0 = 0; d0 < 8; ++d0) S.qr[d0] = load8(cur.Q + (size_t)(wid * QBLK + r32) * PQ + d0 * 16 + hi * 8);
    if (wait) { VMW(); __syncthreads(); }
}
__device__ __forceinline__ unsigned moba_select(const bf16x8* qr, const float* KM, int nblk, int hi) {
    float qf[64];
#pragma unroll
    for (int d0 = 0; d0 < 8; ++d0)
#pragma unroll
        for (int e = 0; e < 8; ++e) qf[d0 * 8 + e] = __uint_as_float(((unsigned)(unsigned short)qr[d0][e]) << 16);
    float v0 = -__builtin_inff(), v1 = v0, v2 = v0; int i0 = -1, i1 = -1, i2 = -1;
    for (int j = 0; j < nblk; ++j) {
        const float* km = KM + j * 128 + hi * 8;
        float a0 = 0.f, a1 = 0.f, a2 = 0.f, a3 = 0.f;
#pragma unroll
        for (int d0 = 0; d0 < 8; ++d0) { const f32x4 k0 = *(const f32x4*)(km + d0 * 16), k1 = *(const f32x4*)(km + d0 * 16 + 4);
            a0 = fmaf(qf[d0 * 8 + 0], k0[0], a0); a1 = fmaf(qf[d0 * 8 + 1], k0[1], a1); a2 = fmaf(qf[d0 * 8 + 2], k0[2], a2); a3 = fmaf(qf[d0 * 8 + 3], k0[3], a3);
            a0 = fmaf(qf[d0 * 8 + 4], k1[0], a0); a1 = fmaf(qf[d0 * 8 + 5], k1[1], a1); a2 = fmaf(qf[d0 * 8 + 6], k1[2], a2); a3 = fmaf(qf[d0 * 8 + 7], k1[3], a3); }
        float a = (a0 + a1) + (a2 + a3);
        { auto rr = __builtin_amdgcn_permlane32_swap(__float_as_uint(a), __float_as_uint(a), false, false); a = __uint_as_float(rr[0]) + __uint_as_float(rr[1]); }
        if (a > v0) { v2 = v1; i2 = i1; v1 = v0; i1 = i0; v0 = a; i0 = j; }
        else if (a > v1) { v2 = v1; i2 = i1; v1 = a; i1 = j; }
        else if (a > v2) { v2 = a; i2 = j; }
    }
    unsigned msk = 0u;
    if (i0 >= 0) msk |= 1u << i0; if (i1 >= 0) msk |= 1u << i1; if (i2 >= 0) msk |= 1u << i2;
    return msk;
}
__device__ __forceinline__ void moba_block(const BlockRef& cur, char* lds, Seam& S) {
    const int tid = fresh_tid(), wid = __builtin_amdgcn_readfirstlane(tid >> 6), lane = tid & 63, r32 = lane & 31, hi = lane >> 5;
    const int NT = (cur.P0 + QB) / KVBLK;
    const int ib = cur.P0 >> 8;
    const int qlo = cur.P0 + wid * QBLK, qm = qlo + r32 - 4 * hi;
    char* V_lds = lds; char* K_lds = lds + 2 * SHM_V;
    LAS unsigned char* VL = (LAS unsigned char*)(unsigned)(uintptr_t)lds; LAS unsigned char* KL = VL + 2 * SHM_V;
    float* ws = (float*)(lds + LDS_WS) + wid * 64; float* li_l = ws, * al_l = ws + 32;
    const float* KM = (const float*)(lds + LDS_KM); const float* LUT = (const float*)(lds + LDS_LUT);
    float m_reg = -1e30f, l_reg = 0; f32x16 o[4] = {};
    const int vb0 = (int)(uintptr_t)V_lds + v_rd_base(lane);
    const bf16* Kh = cur.K; const bf16* Vh = cur.V; const DmaMap dm = dma_map(wid, lane);
#define RESC(a) do { if (__any((a) < 1.f)) { if (hi == 0) al_l[r32] = (a); asm volatile("s_waitcnt lgkmcnt(0)" ::: "memory");              \
                     for (int d_ = 0; d_ < 4; ++d_) for (int r = 0; r < 16; ++r) o[d_][r] *= al_l[crow(r, hi)]; } } while (0)
#define KBASE(t) ((t) * KVBLK)
#define MASKT(P0_, P1_, t) const bool dead_ = moba_mask(P0_, P1_, KBASE(t), ib, qm, selmask, LUT, qlo)
    f32x16 pA0, pA1, pB0, pB1; float mnA, mnB, alA, alB; bf16x8 pa0, pa1, pa2, pa3;
    SBAR(); DMA_K(1, KBASE(1)); SBAR();
    const unsigned selmask = ib <= 3 ? (1u << ib) - 1u : moba_select(S.qr, KM, ib, hi);
    SBAR(); qkt<0>(pA0, pA1, K_lds, r32, hi, S.qr);
    { MASKT(pA0, pA1, 0); partialSM(pA0, pA1, m_reg, mnA, alA, dead_); }
    VMW();
    __syncthreads();
    const int Tw = NT - 4 + (wid >> 1);
#define HALF_STEP(PX0, PX1, mnX, alX, PY0, PY1, alY, t, KB, VB) do {                                                          \
        SBAR(); DMA_K(VB, KBASE((t) + 1)); DMA_V(KB, KBASE(t)); SBAR();                                                       \
        if ((t) <= Tw) qkt<KB>(PX0, PX1, K_lds, r32, hi, S.qr);                                                               \
        if ((t) - 1 <= Tw) { finishSM(PY0, PY1, alY, l_reg, pa0, pa1, pa2, pa3); SBAR();                                      \
            pv_tile<VB>(o, vb0, pa0, pa1, pa2, pa3); }                                                                        \
        if ((t) <= Tw) { MASKT(PX0, PX1, (t)); partialSM(PX0, PX1, m_reg, mnX, alX, dead_); RESC(alX); }                      \
        VMW();                                                                                                                \
        __syncthreads(); } while (0)
    for (int t = 1; t + 1 < NT; t += 2) {
        HALF_STEP(pB0, pB1, mnB, alB, pA0, pA1, alA, t, 1, 0);
        HALF_STEP(pA0, pA1, mnA, alA, pB0, pB1, alB, t + 1, 0, 1);
    }
    SBAR(); DMA_V(1, KBASE(NT - 1)); SBAR();
    if (NT - 1 <= Tw) { qkt<1>(pB0, pB1, K_lds, r32, hi, S.qr); SBAR(); }
    if (NT - 2 <= Tw) { finishSM(pA0, pA1, alA, l_reg, pa0, pa1, pa2, pa3); SBAR();
        pv_tile<0>(o, vb0, pa0, pa1, pa2, pa3); }
    if (NT - 1 <= Tw) { MASKT(pB0, pB1, NT - 1); partialSM(pB0, pB1, m_reg, mnB, alB, dead_); RESC(alB); }
    VMW(); __syncthreads();
    if (NT - 1 <= Tw) { finishSM(pB0, pB1, alB, l_reg, pa0, pa1, pa2, pa3); SBAR(); pv_tile<1>(o, vb0, pa0, pa1, pa2, pa3); }
    SBAR();
    if (hi == 0) li_l[r32] = l_reg; asm volatile("s_waitcnt lgkmcnt(0)" ::: "memory");
    float rli[16];
#pragma unroll
    for (int r = 0; r < 16; ++r) rli[r] = __builtin_amdgcn_rcpf(li_l[crow(r, hi)]);
    bf16* Ow = cur.O + (size_t)(wid * QBLK) * PO;
#pragma unroll
    for (int r = 0; r < 16; ++r) { const int orow = crow(r, hi);
#pragma unroll
        for (int d0 = 0; d0 < 4; ++d0) { const float v = o[d0][r] * rli[r];
            const float vn = __shfl_xor(v, 1);
            if ((r32 & 1) == 0) *(unsigned*)(Ow + (size_t)orow * PO + d0 * 32 + r32) = cvtpk(v, vn); } }
    __syncthreads();
#undef RESC
#undef KBASE
#undef MASKT
#undef HALF_STEP
}
#undef VMW
#undef DMA16
#undef DMA_K
#undef DMA_V
#undef SBAR
#undef KSWZ
}

constexpr size_t MiB = 1u << 20;
constexpr size_t WS_CTL = 0, CTL_ZERO_BYTES = 64 * 1024;
constexpr size_t WO_IN = 0;
constexpr size_t WO_CA = 40 * MiB;
constexpr size_t WO_MIX = 48 * MiB;
constexpr size_t WO_GU = 56 * MiB;
constexpr size_t WO_DN = 100 * MiB;
constexpr size_t WSET_BYTES = 122 * MiB;
constexpr size_t WS_W0 = 2 * MiB, WS_W1 = 702 * MiB;
constexpr size_t WS_KPART = 124 * MiB;
constexpr size_t WS_SS = 126 * MiB;
constexpr size_t WS_XB2 = 128 * MiB;
constexpr size_t WS_XB = 254 * MiB;
constexpr size_t WS_PROJ = 318 * MiB;
constexpr size_t WS_GU = WS_PROJ;
constexpr size_t WS_UA = 638 * MiB;
constexpr size_t WS_MG = 830 * MiB;
constexpr size_t WS_END = 894 * MiB;
static_assert(WS_W1 + WSET_BYTES <= WS_MG, "weight set 1");
constexpr int CW_BAR = 4096;

constexpr int RING_OFF = 0, RING_BYTES = 131072;
constexpr int LDSCTL_OFF = RING_BYTES, MISC_OFF = LDSCTL_OFF + 320;
constexpr int LDS_BYTES = LDS_TOTAL;
static_assert(att::LDS_BYTES <= RING_BYTES && MISC_OFF + 128 <= LDS_RB_OFF, "LDS map");

#define XB_TMO      128
#define XB_XCNT(j)  (256  + 64 * (j))
#define XB_XSUB(j)  (1280 + 64 * (j))
#define XB_XGEN(j)  (2304 + 64 * (j))
#define XB_TOP      3328
#define XB_TOPGEN   3392
#define XCD_BAR_WORDS 3456
#define XB_SPIN_CAP (1u << 18)

__device__ __forceinline__ unsigned xb_ld(unsigned* p)              { return __hip_atomic_load(p, __ATOMIC_RELAXED, __HIP_MEMORY_SCOPE_AGENT); }
__device__ __forceinline__ unsigned xb_add(unsigned* p, unsigned v) { return __hip_atomic_fetch_add(p, v, __ATOMIC_RELAXED, __HIP_MEMORY_SCOPE_AGENT); }
__device__ __forceinline__ unsigned xb_xcc_id() { return (unsigned)__builtin_amdgcn_s_getreg((3 << 11) | 20) & 0xFu; }
#define XB_SPIN(cond, bar) do { unsigned _sp = 0; while (cond) { __builtin_amdgcn_s_sleep(1); \
    if ((++_sp & 255u) == 0u) { if (xb_ld(&(bar)[XB_TMO])) break; if (_sp > XB_SPIN_CAP) { atomicAdd(&(bar)[XB_TMO], 1u); break; } } } } while (0)

struct XcdBarrier { unsigned* bar; unsigned x; volatile LAS unsigned* st; };

__device__ __forceinline__ XcdBarrier xcd_barrier_post(unsigned* bar, volatile LAS unsigned* st) {
    XcdBarrier b; b.bar = bar; b.x = xb_xcc_id(); b.st = st;
    if (threadIdx.x == 0) (void)xb_add(&bar[XB_XCNT(b.x)], 1u);
    return b;
}
__device__ __forceinline__ void xcd_barrier_complete(unsigned* bar, unsigned x, unsigned& nloc, unsigned& nx) {
    const unsigned G = gridDim.x * gridDim.y * gridDim.z;
    unsigned sum, cnt, mine, sp = 0u;
    for (;;) {
        sum = 0u; cnt = 0u; mine = 0u;
#pragma unroll
        for (unsigned j = 0; j < 16; ++j) { const unsigned c = xb_ld(&bar[XB_XCNT(j)]); sum += c; cnt += (c > 0u) ? 1u : 0u; mine = (j == x) ? c : mine; }
        if (sum == G) break;
        __builtin_amdgcn_s_sleep(1);
        if ((++sp & 255u) == 0u) { if (xb_ld(&bar[XB_TMO])) break; if (sp > XB_SPIN_CAP) { atomicAdd(&bar[XB_TMO], 1u); break; } }
    }
    nloc = mine > 0u ? mine : 1u; nx = cnt > 0u ? cnt : 1u;
}
__device__ __forceinline__ void xcd_barrier(const XcdBarrier& b) {
    asm volatile("s_waitcnt vmcnt(0)" ::: "memory");
    __syncthreads();
    if (threadIdx.x == 0) {
        unsigned* bar = b.bar;
        __builtin_amdgcn_s_waitcnt(0);
        unsigned nloc = b.st[0], nx = b.st[1];
        if (nloc == 0u) { xcd_barrier_complete(bar, b.x, nloc, nx); b.st[0] = nloc; b.st[1] = nx; }
        const unsigned old = xb_add(&bar[XB_XSUB(b.x)], 1u);
        const unsigned gen = old / nloc;
        if (old + 1u == (gen + 1u) * nloc) {
            __builtin_amdgcn_fence(__ATOMIC_RELEASE, "agent");
            asm volatile("s_waitcnt vmcnt(0)" ::: "memory");
            const unsigned og = xb_add(&bar[XB_TOP], 1u);
            const unsigned tg = og / nx;
            if (og + 1u == (tg + 1u) * nx) xb_add(&bar[XB_TOPGEN], 1u);
            else XB_SPIN(xb_ld(&bar[XB_TOPGEN]) == tg, bar);
            __builtin_amdgcn_fence(__ATOMIC_ACQUIRE, "agent");
            asm volatile("s_waitcnt vmcnt(0)" ::: "memory");
            xb_add(&bar[XB_XGEN(b.x)], 1u);
            asm volatile("s_waitcnt vmcnt(0)" ::: "memory");
        } else {
            XB_SPIN(xb_ld(&bar[XB_XGEN(b.x)]) == gen, bar);
            asm volatile("buffer_inv sc0\n\ts_waitcnt vmcnt(0)" ::: "memory");
        }
    }
    __syncthreads();
}

__device__ __forceinline__ void panel_barrier(unsigned* cnt, unsigned target, unsigned* tmo, bool local) {
    asm volatile("s_waitcnt vmcnt(0)" ::: "memory");
    __syncthreads();
    if (threadIdx.x == 0) {
        if (!local) { __builtin_amdgcn_fence(__ATOMIC_RELEASE, "agent"); asm volatile("s_waitcnt vmcnt(0)" ::: "memory"); }
        (void)xb_add(cnt, 1u);
        unsigned sp = 0u;
        while (xb_ld(cnt) < target) { __builtin_amdgcn_s_sleep(1); if ((++sp & 255u) == 0u) { if (xb_ld(tmo)) break; if (sp > XB_SPIN_CAP) { atomicAdd(tmo, 1u); break; } } }
        if (!local) { __builtin_amdgcn_fence(__ATOMIC_ACQUIRE, "agent"); asm volatile("s_waitcnt vmcnt(0)" ::: "memory"); }
    }
    __syncthreads();
    if (local) asm volatile("buffer_inv sc0\n\ts_waitcnt vmcnt(0)" ::: "memory");
}
struct Args { const float* in[13]; float* out; unsigned char* ws; int ph_lo, ph_hi; };
struct Frame {
    LAS unsigned char* lds;
    int vcu, G;
    unsigned char* ws;
};

__device__ __forceinline__ float wave_sum(float v) {
#pragma unroll
    for (int o = 1; o < 64; o <<= 1) v += __shfl_xor(v, o);
    return v;
}
struct CvtItem { const float* src; size_t rs2; bf16* dst; int ldw; const float* gain; int has_gain; };
constexpr int CVT_I_IN = (DM / 64) * (INC / 32), CVT_NITEMS = CVT_I_IN + 2 * (CCH / 64) * (DM / 32) + (DM / 64) * (DM / 32) + 2 * (DM / 64) * (FF / 32) + (FF / 64) * (DM / 32);
__device__ __forceinline__ CvtItem cvt_decode(const Args& a, unsigned char* wset, int l, int r) {
    constexpr int I_IN = (DM / 64) * (INC / 32), I_CO = (CCH / 64) * (DM / 32), I_AO = (AW / 64) * (DM / 32), I_MIX = (DM / 64) * (DM / 32),
                  I_G = (DM / 64) * (FF / 32), I_U = I_G, I_DN = (FF / 64) * (DM / 32);
    static_assert(I_IN == CVT_I_IN && I_IN + I_CO + I_AO + I_MIX + I_G + I_U + I_DN == CVT_NITEMS, "item counts");
    const float* W; int N, ldw, k0, n0; bf16* WT; const float* gain = nullptr; int dcol = 0, rowmode = 0;
#define CVT_KN(NB) do { k0 = 64 * (r / (NB)); n0 = 32 * (r % (NB)); } while (0)
    if (r < I_IN) { W = a.in[1] + (size_t)l * DM * INC; N = INC; WT = (bf16*)(wset + WO_IN); ldw = DM; gain = a.in[7] + (size_t)l * DM; rowmode = 3; CVT_KN(INC / 32); }
    else if ((r -= I_IN) < I_CO) { W = a.in[3] + (size_t)l * CCH * DM; N = DM; WT = (bf16*)(wset + WO_CA); ldw = 2048; CVT_KN(DM / 32); }
    else if ((r -= I_CO) < I_AO) { W = a.in[4] + (size_t)l * AW * DM; N = DM; WT = (bf16*)(wset + WO_CA); ldw = 2048; dcol = 1024; CVT_KN(DM / 32); }
    else if ((r -= I_AO) < I_MIX) { W = a.in[5] + (size_t)l * DM * DM; N = DM; WT = (bf16*)(wset + WO_MIX); ldw = DM; CVT_KN(DM / 32); }
    else if ((r -= I_MIX) < I_G) { W = a.in[9] + (size_t)l * DM * FF; N = FF; WT = (bf16*)(wset + WO_GU); ldw = DM; gain = a.in[8] + (size_t)l * DM; rowmode = 1; CVT_KN(FF / 32); }
    else if ((r -= I_G) < I_U) { W = a.in[10] + (size_t)l * DM * FF; N = FF; WT = (bf16*)(wset + WO_GU); ldw = DM; gain = a.in[8] + (size_t)l * DM; rowmode = 2; CVT_KN(FF / 32); }
    else { r -= I_U; W = a.in[11] + (size_t)l * FF * DM; N = DM; WT = (bf16*)(wset + WO_DN); ldw = FF; CVT_KN(DM / 32); }
#undef CVT_KN
    int drow = rowmode == 0 ? n0 : 256 * (n0 / 128) + (n0 % 128) + (rowmode == 2 ? 128 : 0);
    if (rowmode == 3) { const int isatt = n0 >= C_GA, gcol = n0 - (isatt ? C_GA : C_GC);
        drow = n0 < C_GC ? n0 : C_GC + 256 * (gcol / 128) + (gcol % 128) + (isatt ? 128 : 0);
        if (n0 < C_B || (n0 >= C_C && n0 < C_Q)) { const int isc = n0 >= C_C, ch = n0 - (isc ? C_C : 0), k = ch / 128, pk = k < 4 ? k : 4 + k;
            drow = 256 * pk + (ch % 128) + (isc ? 128 : 0); } }
    CvtItem c; c.src = W + (size_t)k0 * N + n0; c.rs2 = (size_t)2 * N; c.dst = WT + (size_t)drow * ldw + dcol + k0; c.ldw = ldw; c.gain = (gain ? gain : a.in[7]) + k0; c.has_gain = gain != nullptr;
    return c;
}
__device__ __forceinline__ void cvt_load(const CvtItem& c, int lane, f32x4 (&wv)[8], f32x4 (&gv)[2]) {
    const float* wp = c.src + (size_t)(lane >> 3) * (c.rs2 >> 1) + 4 * (lane & 7);
#pragma unroll
    for (int i = 0; i < 8; ++i) wv[i] = *(const GAS f32x4*)(wp + (size_t)i * 4 * c.rs2);
    gv[0] = *(const f32x4*)(c.gain + 8 * (lane & 7)); gv[1] = *(const f32x4*)(c.gain + 8 * (lane & 7) + 4);
}
__device__ __forceinline__ void cvt_store(const CvtItem& c, int lane, const f32x4 (&wv)[8], const f32x4 (&gv)[2], LAS float* scr) {
    const int ch = lane & 7;
    LAS float* wp = scr + (lane >> 3) * 33 + 4 * (lane & 7);
#pragma unroll
    for (int i = 0; i < 8; ++i)
#pragma unroll
        for (int q = 0; q < 4; ++q) wp[i * 8 * 33 + q] = wv[i][q];
    f32x4 g0 = gv[0], g1 = gv[1];
    if (!c.has_gain) { g0 = (f32x4){1.f, 1.f, 1.f, 1.f}; g1 = g0; }
    LDS_WAIT(); asm volatile("" ::: "memory");
    float t[4][8];
#pragma unroll
    for (int j = 0; j < 4; ++j) { const LAS float* sp = scr + (8 * ch) * 33 + (lane >> 3) + 8 * j;
#pragma unroll
        for (int e = 0; e < 8; ++e) t[j][e] = sp[e * 33]; }
    __builtin_amdgcn_sched_barrier(0);
    LDS_WAIT();
#pragma unroll
    for (int j = 0; j < 4; ++j) { const int n = (lane >> 3) + 8 * j;
        v4u o; o.x = cvt_pk_bf16(t[j][0] * g0[0], t[j][1] * g0[1]); o.y = cvt_pk_bf16(t[j][2] * g0[2], t[j][3] * g0[3]); o.z = cvt_pk_bf16(t[j][4] * g1[0], t[j][5] * g1[1]); o.w = cvt_pk_bf16(t[j][6] * g1[2], t[j][7] * g1[3]);
        *(GAS v4u*)(c.dst + (size_t)n * c.ldw + 8 * ch) = o; }
    asm volatile("" ::: "memory");
}
__device__ __forceinline__ void phase_convert_weights(Frame& F, const Args& a, int l, int it_lo, int it_hi) {
    const int tid = fresh_tid(), lane = tid & 63, wave = __builtin_amdgcn_readfirstlane(tid >> 6);
    LAS float* scr = (LAS float*)(F.lds + RING_OFF + wave * 8448);
    const int gw = F.vcu * NWAVES + wave, NGW = F.G * NWAVES;
    unsigned char* wset = F.ws + ((l & 1) ? WS_W1 : WS_W0);
    const int first = it_lo + gw;
    if (first >= it_hi) return;
    const int n = (it_hi - first + NGW - 1) / NGW;
#define CVT_ITEM(j) cvt_decode(a, wset, l, first + ((j) < n ? (j) : n - 1) * NGW)
    f32x4 wA[8], wB[8], wC[8], wD[8], gA[2], gB[2], gC[2], gD[2];
    CvtItem cA = CVT_ITEM(0), cB = CVT_ITEM(1), cC = CVT_ITEM(2), cD = cA;
    cvt_load(cA, lane, wA, gA); cvt_load(cB, lane, wB, gB); cvt_load(cC, lane, wC, gC);
    for (int j = 0;; j += 4) {
        cD = CVT_ITEM(j + 3); cvt_load(cD, lane, wD, gD); __builtin_amdgcn_sched_barrier(0); cvt_store(cA, lane, wA, gA, scr); if (j + 1 >= n) break;
        cA = CVT_ITEM(j + 4); cvt_load(cA, lane, wA, gA); __builtin_amdgcn_sched_barrier(0); cvt_store(cB, lane, wB, gB, scr); if (j + 2 >= n) break;
        cB = CVT_ITEM(j + 5); cvt_load(cB, lane, wB, gB); __builtin_amdgcn_sched_barrier(0); cvt_store(cC, lane, wC, gC, scr); if (j + 3 >= n) break;
        cC = CVT_ITEM(j + 6); cvt_load(cC, lane, wC, gC); __builtin_amdgcn_sched_barrier(0); cvt_store(cD, lane, wD, gD, scr); if (j + 4 >= n) break;
    }
#undef CVT_ITEM
}
__device__ __forceinline__ void phase_x_to_bf16(Frame& F, const float* x) {
    const int tid = fresh_tid(), lane = tid & 63, wave = __builtin_amdgcn_readfirstlane(tid >> 6);
    const int gw = F.vcu * NWAVES + wave, NGW = F.G * NWAVES;
    bf16* XB = (bf16*)(F.ws + WS_XB); float* SS = (float*)(F.ws + WS_SS);
    for (int m = gw; m < M; m += 2 * NGW) {
        const GAS f32x4* xr0 = (const GAS f32x4*)(x + (size_t)m * DM) + lane; const bool two = m + NGW < M; const GAS f32x4* xr1 = (const GAS f32x4*)(x + (size_t)(two ? m + NGW : m) * DM) + lane;
        f32x4 v0[8], v1[8];
#pragma unroll
        for (int j = 0; j < 8; ++j) v0[j] = __builtin_nontemporal_load(xr0 + 64 * j);
#pragma unroll
        for (int j = 0; j < 8; ++j) v1[j] = __builtin_nontemporal_load(xr1 + 64 * j);
        __builtin_amdgcn_sched_barrier(0);
#pragma unroll
        for (int h = 0; h < 2; ++h) { if (h && !two) break; const int mm = m + h * NGW; float s = 0.f;
            GAS u32x2* o8 = (GAS u32x2*)(XB + (size_t)mm * DM) + lane;
#pragma unroll
            for (int j = 0; j < 8; ++j) { const f32x4 v = h ? v1[j] : v0[j]; s += (v.x * v.x + v.y * v.y) + (v.z * v.z + v.w * v.w);
                u32x2 w; w.x = cvt_pk_bf16(v.x, v.y); w.y = cvt_pk_bf16(v.z, v.w); o8[64 * j] = w; }
            s = wave_sum(s);
            if (lane < 8) SS[(size_t)mm * 8 + lane] = lane == 0 ? s : 0.f; }
    }
}
__device__ __forceinline__ void phase_final_norm(Frame& F, const float* gain, float* out, int pm, int mi) {
    const int tid = fresh_tid(), lane = tid & 63, wave = __builtin_amdgcn_readfirstlane(tid >> 6);
    const int gw = pm >= 0 ? wave : F.vcu * NWAVES + wave, NGW = pm >= 0 ? NWAVES : F.G * NWAVES;
    const int mlo = pm >= 0 ? pm * 256 + mi * 64 : 0, mhi = pm >= 0 ? mlo + 64 : M;
    const bf16* XB = (const bf16*)(F.ws + WS_XB); const float* SS = (const float*)(F.ws + WS_SS);
    for (int m = mlo + gw; m < mhi; m += NGW) {
        float s = lane < 8 ? SS[(size_t)m * 8 + lane] : 0.f; s = wave_sum(s);
        const float r = __builtin_amdgcn_rsqf(s * (1.0f / DM) + RMS_EPS);
#pragma unroll
        for (int j = 0; j < 4; ++j) { const int c = 8 * (lane + 64 * j); const u32x4 w = __builtin_nontemporal_load((const GAS u32x4*)(XB + (size_t)m * DM + c));
            const f32x4 g0 = *(const f32x4*)(gain + c), g1 = *(const f32x4*)(gain + c + 4);
            f32x4 o0, o1; o0[0] = bf_lo(w.x) * r * g0[0]; o0[1] = bf_hi(w.x) * r * g0[1]; o0[2] = bf_lo(w.y) * r * g0[2]; o0[3] = bf_hi(w.y) * r * g0[3];
            o1[0] = bf_lo(w.z) * r * g1[0]; o1[1] = bf_hi(w.z) * r * g1[1]; o1[2] = bf_lo(w.w) * r * g1[2]; o1[3] = bf_hi(w.w) * r * g1[3];
            __builtin_nontemporal_store(o0, (GAS f32x4*)(out + (size_t)m * DM + c)); __builtin_nontemporal_store(o1, (GAS f32x4*)(out + (size_t)m * DM + c + 4)); }
    }
}
__device__ __forceinline__ void unpack8(const u32x4 w, float (&f)[8]) {
    f[0] = bf_lo(w.x); f[1] = bf_hi(w.x); f[2] = bf_lo(w.y); f[3] = bf_hi(w.y); f[4] = bf_lo(w.z); f[5] = bf_hi(w.z); f[6] = bf_lo(w.w); f[7] = bf_hi(w.w);
}
__device__ __forceinline__ void phase_conv(Frame& F, const float* conv_w  ) {
    const bf16* PROJ = (const bf16*)(F.ws + WS_PROJ); bf16* UA = (bf16*)(F.ws + WS_UA);
    const int tid = fresh_tid(), lane = tid & 63, wave = __builtin_amdgcn_readfirstlane(tid >> 6);
    const int gw = F.vcu * NWAVES + wave, NGW = F.G * NWAVES;
    for (int it = gw; it < (M / 16) * 2; it += NGW) {
        const int half = it & 1, rr = it >> 1, m0 = rr * 16, t0 = m0 % SEQ, c0 = half * 512 + lane * 8;
        float w0[8], w1[8], w2[8];
        { const f32x4 a0 = *(const f32x4*)(conv_w + c0), a1 = *(const f32x4*)(conv_w + c0 + 4), b0 = *(const f32x4*)(conv_w + CCH + c0), b1 = *(const f32x4*)(conv_w + CCH + c0 + 4),
                      d0 = *(const f32x4*)(conv_w + 2 * CCH + c0), d1 = *(const f32x4*)(conv_w + 2 * CCH + c0 + 4);
#pragma unroll
          for (int e = 0; e < 4; ++e) { w0[e] = a0[e]; w0[4 + e] = a1[e]; w1[e] = b0[e]; w1[4 + e] = b1[e]; w2[e] = d0[e]; w2[4 + e] = d1[e]; } }
        float p2[8], p1[8];
#pragma unroll
        for (int e = 0; e < 8; ++e) { p2[e] = 0.f; p1[e] = 0.f; }
        if (t0 != 0) {
            unpack8(*(const u32x4*)(PROJ + (size_t)(m0 - 2) * INC + C_H + c0), p2);
            unpack8(*(const u32x4*)(PROJ + (size_t)(m0 - 1) * INC + C_H + c0), p1);
        }
#pragma unroll 8
        for (int r = 0; r < 16; ++r) {
            const size_t m = (size_t)(m0 + r);
            float ch[8], b[8], y[8];
            unpack8(__builtin_nontemporal_load((const GAS u32x4*)(PROJ + m * INC + C_H + c0)), ch); unpack8(__builtin_nontemporal_load((const GAS u32x4*)(PROJ + m * INC + C_B + c0)), b);
#pragma unroll
            for (int e = 0; e < 8; ++e) { const float cu = ch[e]; float acc = w0[e] * p2[e]; acc = acc + w1[e] * p1[e]; acc = acc + w2[e] * cu; y[e] = b[e] * acc; p2[e] = p1[e]; p1[e] = cu; }
            u32x4 w; w.x = cvt_pk_bf16(y[0], y[1]); w.y = cvt_pk_bf16(y[2], y[3]); w.z = cvt_pk_bf16(y[4], y[5]); w.w = cvt_pk_bf16(y[6], y[7]);
            *(u32x4*)(UA + m * 2048 + c0) = w;
        }
    }
}
__device__ __forceinline__ int t5_bucket(int n) {
    if (n < 16) return n;
    int b = 16;
    b += (n >= 19); b += (n >= 21); b += (n >= 24); b += (n >= 27); b += (n >= 31); b += (n >= 35); b += (n >= 40); b += (n >= 46);
    b += (n >= 52); b += (n >= 59); b += (n >= 67); b += (n >= 77); b += (n >= 87); b += (n >= 99); b += (n >= 113);
    return b;
}
__device__ __forceinline__ void mixer_stream_work(Frame& F, const Args& a, int l) {
    for (int rep = 0; rep < REP_MISC; ++rep) {
        phase_conv(F, a.in[2] + (size_t)l * 3 * CCH);
        if (l == 0) phase_convert_weights(F, a, 0, CVT_I_IN, CVT_NITEMS);
        if (l + 1 < DEPTH) phase_convert_weights(F, a, l + 1, 0, CVT_NITEMS);
    }
}
__device__ __forceinline__ void phase_attention(Frame& F, char* lds, const float* rel_bias, const Args& a, int l) {
    const bf16* PROJ = (const bf16*)(F.ws + WS_PROJ); bf16* UA = (bf16*)(F.ws + WS_UA); const float* KPART = (const float*)(F.ws + WS_KPART);
    float* KM = (float*)(lds + att::LDS_KM); float* LUT = (float*)(lds + att::LDS_LUT);
    bool streamed = false;
    for (int L = F.vcu; L < BATCH * NH * 8; L += F.G) {
        const int tid = fresh_tid();
        const int bh = L >> 3, x = L & 7, b = bh / NH, h = bh % NH;
        const int qbA = (bh & 1) ? 15 - x : x, qbB = 15 - qbA;
        att::BlockRef bA, bB;
        { const size_t row0 = (size_t)b * SEQ + (size_t)qbA * 256; bA.Q = PROJ + row0 * INC + C_Q + h * HD; bA.O = UA + row0 * 2048 + 1024 + h * HD; bA.P0 = qbA * 256; }
        { const size_t row0 = (size_t)b * SEQ + (size_t)qbB * 256; bB.Q = PROJ + row0 * INC + C_Q + h * HD; bB.O = UA + row0 * 2048 + 1024 + h * HD; bB.P0 = qbB * 256; }
        bA.K = bB.K = PROJ + (size_t)b * SEQ * INC + C_K + h * HD; bA.V = bB.V = PROJ + (size_t)b * SEQ * INC + C_V + h * HD;
        att::Seam S;
        att::moba_prime(bA, lds, S, false);
        for (int idx = tid; idx < 16 * 128; idx += NWAVES * 64) { const int j = idx >> 7, d = idx & 127; float s = 0.f;
            s = KPART[(size_t)((b * 16 + j) * 2 + 0) * 1024 + h * 128 + d] + KPART[(size_t)((b * 16 + j) * 2 + 1) * 1024 + h * 128 + d];
            KM[idx] = s * (1.0f / 256.0f); }
        if (tid < 128) LUT[tid] = (rel_bias[t5_bucket(tid) * NH + h] - rel_bias[31 * NH + h]) * (1.0f / att::SCALE);
        asm volatile("s_waitcnt vmcnt(0)" ::: "memory"); __syncthreads();
        for (int rep = 0; rep < REP_ATT; ++rep) {
        if (rep > 0) att::moba_prime(bA, lds, S);
        att::moba_block(bA, lds, S);
        __syncthreads();
        if (!streamed) { mixer_stream_work(F, a, l); streamed = true; __syncthreads(); }
        att::moba_prime(bB, lds, S);
        att::moba_block(bB, lds, S);
        __syncthreads();
        }
    }
    if (!streamed) mixer_stream_work(F, a, l);
}
constexpr int PH_PER_LAYER = 6, N_PHASES = DEPTH * PH_PER_LAYER + 2;

__global__ void __launch_bounds__(NWAVES * 64, 2) trunk_fwd(Args args) {
    extern __shared__ __attribute__((aligned(16))) unsigned char lds[];
    Frame F;
    F.lds = (LAS unsigned char*)lds;
    volatile LAS unsigned* MISC = (volatile LAS unsigned*)(F.lds + MISC_OFF);
    F.G = gridDim.x; { const int bx = blockIdx.x; F.vcu = (F.G % 8 == 0) ? (bx % 8) * (F.G / 8) + bx / 8 : bx; }
    F.ws = args.ws;
    unsigned* ctl = (unsigned*)(F.ws + WS_CTL);
    for (int u = threadIdx.x; u < (LDS_BYTES - LDSCTL_OFF) / 4; u += NWAVES * 64) ((LAS unsigned*)(F.lds + LDSCTL_OFF))[u] = 0u;
    __syncthreads();
    const int lo = args.ph_lo, hi = args.ph_hi;
    const bool use_bar = (hi - lo) > 1;
    XcdBarrier bar; bar.bar = ctl + CW_BAR; bar.x = 0; bar.st = MISC + 8;
    if (use_bar) bar = xcd_barrier_post(ctl + CW_BAR, MISC + 8);
#define IN(k) (lo <= (k) && (k) < hi)
#define SEAM(k) do { if ((k) + 1 < hi) xcd_barrier(bar); } while (0)
    const bool paneled = (F.G == 256) && use_bar;
    const int my_pm = 8 * ((int)blockIdx.x % 8) + ((int)blockIdx.x / 8) % 8, my_mi = (int)blockIdx.x / 64;
    unsigned pb_epoch = 0u; bool pb_local = false;
    if (paneled && threadIdx.x == 0) __hip_atomic_store(ctl + 12288 + blockIdx.x, 0x100u | xb_xcc_id(), __ATOMIC_RELAXED, __HIP_MEMORY_SCOPE_AGENT);
#define SEAMG(k) do { if ((k) + 1 < hi) { if (paneled) { pb_epoch += 4u; panel_barrier(ctl + 8192 + 64 * my_pm, pb_epoch, ctl + CW_BAR + XB_TMO, pb_local); } else xcd_barrier(bar); } } while (0)

    bf16* XB = (bf16*)(F.ws + WS_XB); bf16* XB2 = (bf16*)(F.ws + WS_XB2); float* SS = (float*)(F.ws + WS_SS); bf16* PROJ = (bf16*)(F.ws + WS_PROJ); bf16* GU = (bf16*)(F.ws + WS_GU);
    bf16* UA = (bf16*)(F.ws + WS_UA); bf16* MG = (bf16*)(F.ws + WS_MG); float* KP = (float*)(F.ws + WS_KPART);

    if (IN(0)) { phase_convert_weights(F, args, 0, 0, CVT_I_IN); phase_x_to_bf16(F, args.in[0]); SEAM(0); }
    if (paneled && lo == 0) {
        const unsigned b0 = (unsigned)blockIdx.x % 64u;
        const unsigned i0 = xb_ld(ctl + 12288 + b0), i1 = xb_ld(ctl + 12288 + b0 + 64), i2 = xb_ld(ctl + 12288 + b0 + 128), i3 = xb_ld(ctl + 12288 + b0 + 192);
        pb_local = (i0 & 0x100u) && i0 == i1 && i0 == i2 && i0 == i3;
    }
    for (int l = 0; l < DEPTH; ++l) {
        const int pb = 1 + l * PH_PER_LAYER;
        unsigned char* wset = F.ws + ((l & 1) ? WS_W1 : WS_W0);
        bf16* WIN = (bf16*)(wset + WO_IN); bf16* WCA = (bf16*)(wset + WO_CA); bf16* WMIX = (bf16*)(wset + WO_MIX); bf16* WGU = (bf16*)(wset + WO_GU); bf16* WDN = (bf16*)(wset + WO_DN);
        if (IN(pb + 0)) {
            pg8::Gemm g{XB, WIN, M, INC, DM, DM, DM}; pg8::WrapOrder S; S.init(M, INC * REP_IN, F.G, fresh_bid()); S.wrapN = INC / 256;
            pg8::EpiProj E{PROJ, INC, C_GC, SS, KP};
#if SPLIT_IN
            for (int hf = 0; hf < 2; ++hf) { S.i0 = hf * 5; S.i1 = hf * 5 + 5; pg8::gemm_phase<pg8::EpiProj, pg8::WrapOrder, true>(F.lds + RING_OFF, g, S, E); if (hf == 0) xcd_barrier(bar); }
#else
            pg8::gemm_phase<pg8::EpiProj, pg8::WrapOrder, true>(F.lds + RING_OFF, g, S, E);
#endif
            SEAM(pb + 0);
        }
        if (IN(pb + 1)) {
            phase_attention(F, (char*)lds + RING_OFF, args.in[6], args, l);
            SEAM(pb + 1);
        }
        if (IN(pb + 2)) {
            pg8::Gemm g{UA, WCA, M, DM, 2048, 2048, 2048}; pg8::WrapOrder S; S.init(M, DM * REP_EF, F.G, fresh_bid()); S.wrapN = DM / 256;
            pg8::EpiGateBf16 E{MG, DM, PROJ + C_GC, INC}; pg8::MidGateRatio MH{PROJ + C_GC, INC};
            pg8::gemm_phase<pg8::EpiGateBf16, pg8::WrapOrder, true, pg8::MidGateRatio>(F.lds + RING_OFF, g, S, E, MH);
            SEAMG(pb + 2);
        }
        if (IN(pb + 3)) {
            pg8::Gemm g{MG, WMIX, M, DM, DM, DM, DM}; pg8::WrapOrder S; S.init(M, DM * REP_G, F.G, fresh_bid()); S.wrapN = DM / 256;
            pg8::EpiResBf16 E{XB, XB2, DM, SS};
            pg8::gemm_phase<pg8::EpiResBf16, pg8::WrapOrder, true>(F.lds + RING_OFF, g, S, E);
            SEAMG(pb + 3);
        }
        if (IN(pb + 4)) {
            pg8::Gemm g{XB2, WGU, M, 2 * FF, DM, DM, DM}; pg8::WrapOrder S; S.init(M, 2 * FF * REP_GU, F.G, fresh_bid()); S.wrapN = 2 * FF / 256;
            pg8::EpiSwiGLU E{GU, (long)256 * INC, SS};
            pg8::gemm_phase<pg8::EpiSwiGLU, pg8::WrapOrder, true>(F.lds + RING_OFF, g, S, E);
            SEAMG(pb + 4);
        }
        if (IN(pb + 5)) {
            pg8::Gemm g{GU, WDN, M, DM, FF, 64, FF, 256 * 64 * 2, (long)256 * INC * 2, true, true};       pg8::WrapOrder S; S.init(M, DM * REP_J, F.G, fresh_bid()); S.wrapN = DM / 256;
            pg8::EpiResBf16 E{XB2, XB, DM, SS};
            pg8::gemm_phase<pg8::EpiResBf16, pg8::WrapOrder, true>(F.lds + RING_OFF, g, S, E);
            SEAMG(pb + 5);
        }
    }
    if (IN(1 + DEPTH * PH_PER_LAYER)) phase_final_norm(F, args.in[12], args.out, paneled ? my_pm : -1, my_mi);
#undef IN
#undef SEAM
#undef SEAMG
}

#ifndef MK_PER_PHASE
#define MK_PER_PHASE 0
#endif
extern "C" void kernel_launch(void* const* d_in, const int* in_sizes, int n_in, void* d_out, int out_size, void* d_ws, size_t ws_size, hipStream_t stream) {
    static int grid = 0;
    if (grid == 0) {
        if (n_in != 13 || in_sizes[0] != M * DM || out_size != M * DM || ws_size < WS_END) {
            fprintf(stderr, "kernel_launch: unexpected shapes (n_in %d, in0 %d, out %d, ws %zu); nothing launched\n", n_in, n_in > 0 ? in_sizes[0] : -1, out_size, ws_size); grid = -1; return; }
        int dev = 0, cus = 0;
        if (hipGetDevice(&dev) != hipSuccess || hipDeviceGetAttribute(&cus, hipDeviceAttributeMultiprocessorCount, dev) != hipSuccess) { grid = -1; return; }
        if (hipFuncSetAttribute((const void*)trunk_fwd, hipFuncAttributeMaxDynamicSharedMemorySize, LDS_BYTES) != hipSuccess) { fprintf(stderr, "kernel_launch: hipFuncSetAttribute failed\n"); grid = -1; return; }
        int per_cu = 0;
        if (hipOccupancyMaxActiveBlocksPerMultiprocessor(&per_cu, (const void*)trunk_fwd, NWAVES * 64, LDS_BYTES) != hipSuccess || per_cu < 1)
            fprintf(stderr, "kernel_launch: note: occupancy query reports %d workgroups per CU\n", per_cu);
        (void)hipGetLastError();
        grid = cus;
    }
    if (grid < 0) return;
    if (hipMemsetAsync((char*)d_ws + WS_CTL, 0, CTL_ZERO_BYTES, stream) != hipSuccess) { fprintf(stderr, "kernel_launch: hipMemsetAsync failed\n"); return; }
    Args a{};
    for (int i = 0; i < 13; ++i) a.in[i] = (const float*)d_in[i];
    a.out = (float*)d_out; a.ws = (unsigned char*)d_ws;
#if MK_PER_PHASE
    for (int p = 0; p < N_PHASES; ++p) { a.ph_lo = p; a.ph_hi = p + 1; hipLaunchKernelGGL(trunk_fwd, dim3(grid), dim3(NWAVES * 64), LDS_BYTES, stream, a); }
#else
    a.ph_lo = 0; a.ph_hi = N_PHASES;
    hipLaunchKernelGGL(trunk_fwd, dim3(grid), dim3(NWAVES * 64), LDS_BYTES, stream, a);
#endif
    const hipError_t le = hipPeekAtLastError();
    if (le != hipSuccess) fprintf(stderr, "kernel_launch: launch failed: %s\n", hipGetErrorName(le));
}
```

```cpp
#include <hip/hip_runtime.h>
#include <cstdio>
#include <cstdint>

#ifndef REP_ATT
#define REP_ATT 1
#endif
#ifndef REP_BIG
#define REP_BIG 1
#endif
#ifndef REP_IN
#define REP_IN 1
#endif
#ifndef REP_GU
#define REP_GU 1
#endif
#ifndef REP_EF
#define REP_EF 1
#endif
#ifndef REP_G
#define REP_G 1
#endif
#ifndef REP_J
#define REP_J 1
#endif
#ifndef SPLIT_IN
#define SPLIT_IN 0
#endif
#ifndef REP_MISC
#define REP_MISC 1
#endif
constexpr int BATCH = 4, SEQ = 4096, DM = 2048, DEPTH = 4, CCH = 1024, AW = 1024, NH = 8, HD = 128, FF = 5632, INC = 10240;
constexpr int M = BATCH * SEQ;
constexpr int C_H = 0, C_B = 1024, C_C = 2048, C_Q = 3072, C_K = 4096, C_V = 5120, C_GC = 6144, C_GA = 8192;
constexpr float RMS_EPS = 1e-6f;
constexpr int NWAVES = 8;

#define GAS __attribute__((address_space(1)))
#define LAS __attribute__((address_space(3)))
typedef unsigned short bf16;
typedef unsigned v4u __attribute__((ext_vector_type(4)));
typedef float f32x4 __attribute__((ext_vector_type(4)));
typedef float f32x2 __attribute__((ext_vector_type(2)));
typedef float f32x16 __attribute__((ext_vector_type(16)));
typedef short bf16x8 __attribute__((ext_vector_type(8)));
typedef short s16x4 __attribute__((ext_vector_type(4)));
typedef unsigned u32x4 __attribute__((ext_vector_type(4)));
typedef unsigned u32x2 __attribute__((ext_vector_type(2)));
typedef GAS unsigned gu32;
#define RLX_AGENT __ATOMIC_RELAXED, __HIP_MEMORY_SCOPE_AGENT
#define LDS_WAIT() asm volatile("s_waitcnt lgkmcnt(0)" ::: "memory")
#define VM_WAIT() asm volatile("s_waitcnt vmcnt(0)" ::: "memory")

__device__ __forceinline__ int fresh_tid() { int t = threadIdx.x; asm volatile("" : "+v"(t)); return t; }
__device__ __forceinline__ int fresh_bid() { int b = blockIdx.x; asm volatile("" : "+s"(b)); return b; }
__device__ __forceinline__ unsigned cvt_pk_bf16(float lo, float hi) { unsigned r; asm volatile("v_cvt_pk_bf16_f32 %0, %1, %2" : "=v"(r) : "v"(lo), "v"(hi)); return r; }
__device__ __forceinline__ float bf_lo(unsigned w) { return __uint_as_float(w << 16); }
__device__ __forceinline__ float bf_hi(unsigned w) { return __uint_as_float(w & 0xffff0000u); }
__device__ __forceinline__ unsigned q8(float s) { return (unsigned)(s * 255.0f + 0.5f); }
__device__ __forceinline__ unsigned pack4(unsigned a, unsigned b, unsigned c, unsigned d) { return a | (b << 8) | (c << 16) | (d << 24); }
__device__ __forceinline__ float ub0(unsigned w) { return (float)(w & 0xffu); }
__device__ __forceinline__ float ub1(unsigned w) { return (float)((w >> 8) & 0xffu); }
__device__ __forceinline__ float ub2(unsigned w) { return (float)((w >> 16) & 0xffu); }
__device__ __forceinline__ float ub3(unsigned w) { return (float)(w >> 24); }
__device__ __forceinline__ float fast_sigmoid(float x) { return __builtin_amdgcn_rcpf(1.0f + __builtin_amdgcn_exp2f(-1.4426950408889634f * x)); }

constexpr int LDS_RB_OFF = 132096, LDS_RB_BYTES = 8192;
constexpr int LDS_XT_OFF = LDS_RB_OFF + 2 * LDS_RB_BYTES;
constexpr int LDS_TOTAL = 163840;
static_assert(LDS_XT_OFF + 4096 <= LDS_TOTAL, "LDS map");
namespace pg8 {
constexpr int BM = 256, BK = 64, HALF = 128, HTB = HALF * BK * 2  , STAGE_BYTES = 8 * HTB, NXCD = 8, WGM = 8;

__host__ __device__ __forceinline__ int lds_byte(int r, int c) { const int st = (r >> 4) * 2 + (c >> 5), rr = r & 15, cc = c & 31, ob = rr * 64 + cc * 2; return st * 1024 + (ob ^ (((ob >> 9) & 1) << 5)); }
__host__ __device__ __forceinline__ void stage_rc(int b, int& R, int& C) { const int st = b / 1024, sb = b % 1024, swz = sb ^ (((sb >> 9) & 1) << 5); R = (st >> 1) * 16 + swz / 64; C = (st & 1) * 32 + (swz % 64) / 2; }
__host__ __device__ __forceinline__ int perm32(int rho) { const int n = rho >> 4, i = rho & 15; return 8 * (i >> 2) + 4 * n + (i & 3); }

struct Unit { int pm, pn; };
struct Gemm { const bf16* A; const bf16* Bt; int M, N, K, lda, ldb; int kstepA = 0; long tstepA = 0; bool snake = false; bool splitA = false; };

struct StaticOrder {
    int nM, nN, nwg, G, c;
    __host__ __device__ void init(int M_, int N_, int G_, int c_) { nM = M_ / BM; nN = N_ / BM; nwg = nM * nN; G = G_; c = c_; }
    __host__ __device__ bool next(int i, Unit& u) const {
        const long L = (long)i * G + c; if (L >= nwg) return false;
        int wgid = (int)L; { const int q = nwg / NXCD, r = nwg % NXCD, xcd = wgid % NXCD, off = wgid / NXCD; wgid = (xcd < r ? xcd * (q + 1) : r * (q + 1) + (xcd - r) * q) + off; }
        const int nig = WGM * nN, gid = wgid / nig, fm = gid * WGM, gsz = (nM - fm) < WGM ? (nM - fm) : WGM;
        u.pm = fm + ((wgid % nig) % gsz); u.pn = (wgid % nig) / gsz; return true;
    }
};

struct WrapOrder : StaticOrder { int wrapN; int i0 = 0, i1 = 1 << 30;
    __host__ __device__ bool next(int i, Unit& u) const { if (i + i0 >= i1) return false; if (!StaticOrder::next(i + i0, u)) return false; u.pn %= wrapN; return true; } };

__device__ __forceinline__ void rs_prefetch(LAS unsigned char* lds, const float* SS8, const Unit& u, int ui, int wid, int lane) {
    const float* src = SS8 + ((size_t)u.pm * BM + 32 * wid) * 8 + lane * 4;
    __builtin_amdgcn_global_load_lds((const unsigned*)src, (LAS unsigned*)(lds + LDS_RB_OFF + (ui & 1) * LDS_RB_BYTES + wid * 1024), 16, 0, 0);
}
__device__ __forceinline__ void row_scales(LAS unsigned char* lds, int ui, int wr, int fr, float (&rs)[2][4]) {
    const LAS f32x4* rb = (const LAS f32x4*)(lds + LDS_RB_OFF + (ui & 1) * LDS_RB_BYTES);
#pragma unroll
    for (int ai = 0; ai < 2; ++ai)
#pragma unroll
        for (int m = 0; m < 4; ++m) { const int r = ai * HALF + wr * 64 + m * 16 + fr; const f32x4 x = rb[2 * r], y = rb[2 * r + 1];
            const float s = ((x[0] + x[1]) + (x[2] + x[3])) + ((y[0] + y[1]) + (y[2] + y[3]));
            rs[ai][m] = __builtin_amdgcn_rsqf(s * (1.0f / DM) + RMS_EPS); }
}
__device__ __forceinline__ float row_scale1(LAS unsigned char* lds, int ui, int r) {
    const LAS f32x4* rb = (const LAS f32x4*)(lds + LDS_RB_OFF + (ui & 1) * LDS_RB_BYTES);
    const f32x4 x = rb[2 * r], y = rb[2 * r + 1];
    return __builtin_amdgcn_rsqf((((x[0] + x[1]) + (x[2] + x[3])) + ((y[0] + y[1]) + (y[2] + y[3]))) * (1.0f / DM) + RMS_EPS);
}
struct RsPipe { f32x4 x, y;
    __device__ __forceinline__ void load(LAS unsigned char* lds, int ui, int r) { const LAS f32x4* rb = (const LAS f32x4*)(lds + LDS_RB_OFF + (ui & 1) * LDS_RB_BYTES); x = rb[2 * r]; y = rb[2 * r + 1]; }
    __device__ __forceinline__ float msq() const { return (((x[0] + x[1]) + (x[2] + x[3])) + ((y[0] + y[1]) + (y[2] + y[3]))) * (1.0f / DM) + RMS_EPS; }
};
#define RS_PIPE_BEGIN() RsPipe rs_nxt; rs_nxt.load(lds, ui, rl0)
#define RS_PIPE_STEP(cur_) const RsPipe cur_ = rs_nxt; { const int gn_ = ai * 4 + m + 1; if (gn_ < 8) rs_nxt.load(lds, ui, rl0 + (gn_ >> 2) * HALF + (gn_ & 3) * 16); } __builtin_amdgcn_sched_barrier(0)
struct EpiProj {
    static constexpr bool PERM = true, PREFETCH = true;
    bf16* O; int ldc; int sig_from; const float* SS; float* KP;
    __device__ __forceinline__ void prefetch(LAS unsigned char* lds, const Unit& u, int ui, int wid, int lane) const { rs_prefetch(lds, SS, u, ui, wid, lane); }
    __device__ __forceinline__ void operator()(const f32x4 (&acc)[2][2][4][2], const Unit& u, int wr, int wc, int fr, int fq, LAS unsigned char* lds, int ui) const {
        int row0 = u.pm * BM + wr * 64 + fr; const int colt = u.pn * BM;
        const bool sig = colt >= sig_from; const bool isk = colt >= C_K && colt < C_V; const bool isch = colt < C_B || (colt >= C_C && colt < C_Q);
        int col0 = colt + wc * 32 + 8 * fq;
        asm volatile("" : "+v"(row0), "+v"(col0));
        const int rl0 = wr * 64 + fr;
        RS_PIPE_BEGIN();
        if (sig) {
            const int gc0 = ((colt - sig_from) >> 1) + wc * 32 + 8 * fq;
#pragma unroll
            for (int ai = 0; ai < 2; ++ai)
#pragma unroll
                for (int m = 0; m < 4; ++m) { RS_PIPE_STEP(rsc); bf16* rowp = O + (size_t)(row0 + ai * HALF + m * 16) * ldc + gc0; const float k1 = -1.4426950408889634f * __builtin_amdgcn_rsqf(rsc.msq());
                    unsigned qc[8], qa[8];
#define SG8(A_) ((unsigned)(__builtin_amdgcn_rcpf(__builtin_fmaf(__builtin_amdgcn_exp2f((A_) * k1), 1.0f / 255.0f, 1.0f / 255.0f)) + 0.5f))
#pragma unroll
                    for (int e = 0; e < 4; ++e) { qc[e] = SG8(acc[ai][0][m][0][e]); qc[4 + e] = SG8(acc[ai][0][m][1][e]);
                        const unsigned a0 = SG8(acc[ai][1][m][0][e]), a1 = SG8(acc[ai][1][m][1][e]);
                        qa[e] = a0 < 1u ? 1u : a0; qa[4 + e] = a1 < 1u ? 1u : a1; }
                    u32x4 w; w.x = pack4(qc[0], qc[1], qc[2], qc[3]); w.y = pack4(qc[4], qc[5], qc[6], qc[7]); w.z = pack4(qa[0], qa[1], qa[2], qa[3]); w.w = pack4(qa[4], qa[5], qa[6], qa[7]);
                    *(u32x4*)(rowp + C_GC) = w; }
#undef SG8
            return;
        }
        if (isch) {
            const int pk = u.pn < 4 ? u.pn : u.pn - 4, cc0 = 128 * pk + wc * 32 + 8 * fq;
#pragma unroll
            for (int ai = 0; ai < 2; ++ai)
#pragma unroll
                for (int m = 0; m < 4; ++m) { RS_PIPE_STEP(rsc); const float r2 = __builtin_amdgcn_rcpf(rsc.msq());
                    const f32x4 p0 = acc[ai][0][m][0] * acc[ai][1][m][0] * r2, p1 = acc[ai][0][m][1] * acc[ai][1][m][1] * r2;
                    u32x4 w; w.x = cvt_pk_bf16(p0[0], p0[1]); w.y = cvt_pk_bf16(p0[2], p0[3]); w.z = cvt_pk_bf16(p1[0], p1[1]); w.w = cvt_pk_bf16(p1[2], p1[3]);
                    *(u32x4*)(O + (size_t)(row0 + ai * HALF + m * 16) * ldc + C_H + cc0) = w; }
            return;
        }
#pragma unroll
        for (int ai = 0; ai < 2; ++ai)
#pragma unroll
            for (int m = 0; m < 4; ++m) { RS_PIPE_STEP(rsc); bf16* rowp = O + (size_t)(row0 + ai * HALF + m * 16) * ldc + col0; const float rsv = __builtin_amdgcn_rsqf(rsc.msq());
#pragma unroll
                for (int bj = 0; bj < 2; ++bj) { f32x4 v0 = acc[ai][bj][m][0] * rsv, v1 = acc[ai][bj][m][1] * rsv;
                    u32x4 w; w.x = cvt_pk_bf16(v0[0], v0[1]); w.y = cvt_pk_bf16(v0[2], v0[3]); w.z = cvt_pk_bf16(v1[0], v1[1]); w.w = cvt_pk_bf16(v1[2], v1[3]);
                    *(u32x4*)(rowp + bj * HALF) = w; }
                __builtin_amdgcn_sched_barrier(0); }
        if (isk) {
            f32x4 cs[2][2];
#pragma unroll
            for (int bj = 0; bj < 2; ++bj)
#pragma unroll
                for (int n = 0; n < 2; ++n) { f32x4 t = (f32x4){0.f, 0.f, 0.f, 0.f};
#pragma unroll
                    for (int ai = 0; ai < 2; ++ai)
#pragma unroll
                        for (int m = 0; m < 4; ++m) t += acc[ai][bj][m][n] * row_scale1(lds, ui, rl0 + ai * HALF + m * 16);
                    cs[bj][n] = t; }
#pragma unroll
            for (int bj = 0; bj < 2; ++bj)
#pragma unroll
                for (int n = 0; n < 2; ++n)
#pragma unroll
                    for (int e = 0; e < 4; ++e) { float x = cs[bj][n][e]; x += __shfl_xor(x, 1); x += __shfl_xor(x, 2); x += __shfl_xor(x, 4); x += __shfl_xor(x, 8); cs[bj][n][e] = x; }
            if (fr == 0) { float* kp = KP + (size_t)(u.pm * 2 + wr) * 1024 + (colt - C_K) + wc * 32 + 8 * fq;
#pragma unroll
                for (int bj = 0; bj < 2; ++bj) { *(f32x4*)(kp + bj * HALF) = cs[bj][0]; *(f32x4*)(kp + bj * HALF + 4) = cs[bj][1]; } }
        }
    }
};
struct MidGateRatio {
    static constexpr bool ENABLED = true;
    const bf16* R; int ldg;
    __device__ __forceinline__ void operator()(f32x4 (&acc)[2][2][4][2], const Unit& u, int wr, int wc, int fr, int fq) const {
        int row0 = u.pm * BM + wr * 64 + fr; int col0 = u.pn * BM + wc * 32 + 8 * fq;
        asm volatile("" : "+v"(row0), "+v"(col0));
        const char* base = (const char*)R + ((size_t)row0 * ldg + col0) * 2;
        const size_t rstep = (size_t)ldg * 32;
        u32x4 rr[2][4][2];
#pragma unroll
        for (int ai = 0; ai < 2; ++ai)
#pragma unroll
            for (int m = 0; m < 4; ++m) { const char* p = base + (size_t)(ai * 8 + m) * rstep;
#pragma unroll
                for (int bj = 0; bj < 2; ++bj) rr[ai][m][bj] = *(const u32x4*)(p + bj * 256); }
        __builtin_amdgcn_sched_barrier(0);
#pragma unroll
        for (int ai = 0; ai < 2; ++ai)
#pragma unroll
            for (int m = 0; m < 4; ++m)
#pragma unroll
                for (int bj = 0; bj < 2; ++bj) { const u32x4 c = rr[ai][m][bj];
                    acc[ai][bj][m][0] *= (f32x4){ub0(c.x) * __builtin_amdgcn_rcpf(ub0(c.z)), ub1(c.x) * __builtin_amdgcn_rcpf(ub1(c.z)), ub2(c.x) * __builtin_amdgcn_rcpf(ub2(c.z)), ub3(c.x) * __builtin_amdgcn_rcpf(ub3(c.z))};
                    acc[ai][bj][m][1] *= (f32x4){ub0(c.y) * __builtin_amdgcn_rcpf(ub0(c.w)), ub1(c.y) * __builtin_amdgcn_rcpf(ub1(c.w)), ub2(c.y) * __builtin_amdgcn_rcpf(ub2(c.w)), ub3(c.y) * __builtin_amdgcn_rcpf(ub3(c.w))}; }
        __builtin_amdgcn_sched_barrier(0);
    }
};
struct EpiGateBf16 {
    static constexpr bool PERM = true, PREFETCH = false;
    bf16* O; int ldc; const bf16* G; int ldg;
    __device__ __forceinline__ void operator()(const f32x4 (&acc)[2][2][4][2], const Unit& u, int wr, int wc, int fr, int fq, LAS unsigned char* lds, int ui) const {
        const int row0 = u.pm * BM + wr * 64 + fr; const int col0 = u.pn * BM + wc * 32 + 8 * fq;
        u32x2 gg[2][4][2];
#pragma unroll
        for (int ai = 0; ai < 2; ++ai)
#pragma unroll
            for (int m = 0; m < 4; ++m)
#pragma unroll
                for (int bj = 0; bj < 2; ++bj) gg[ai][m][bj] = *(const u32x2*)((const char*)(G + (size_t)(row0 + ai * HALF + m * 16) * ldg + col0 + bj * HALF) + 8);
        __builtin_amdgcn_sched_barrier(0);
        const float k = 1.0f / 255.0f;
#pragma unroll
        for (int ai = 0; ai < 2; ++ai)
#pragma unroll
            for (int m = 0; m < 4; ++m) { const size_t r = (size_t)(row0 + ai * HALF + m * 16);
#pragma unroll
                for (int bj = 0; bj < 2; ++bj) { const u32x2 g = gg[ai][m][bj];
                    f32x4 v0 = acc[ai][bj][m][0] * k, v1 = acc[ai][bj][m][1] * k;
                    v0[0] *= ub0(g.x); v0[1] *= ub1(g.x); v0[2] *= ub2(g.x); v0[3] *= ub3(g.x);
                    v1[0] *= ub0(g.y); v1[1] *= ub1(g.y); v1[2] *= ub2(g.y); v1[3] *= ub3(g.y);
                    u32x4 w; w.x = cvt_pk_bf16(v0[0], v0[1]); w.y = cvt_pk_bf16(v0[2], v0[3]); w.z = cvt_pk_bf16(v1[0], v1[1]); w.w = cvt_pk_bf16(v1[2], v1[3]);
                    *(u32x4*)(O + r * ldc + col0 + bj * HALF) = w; } }
    }
};
struct EpiResBf16 {
    static constexpr bool PERM = true, PREFETCH = false;
    const bf16* X; bf16* XO; int ldc; float* SS;
    __device__ __forceinline__ void operator()(const f32x4 (&acc)[2][2][4][2], const Unit& u, int wr, int wc, int fr, int fq, LAS unsigned char* lds, int ui) const {
        const int row0 = u.pm * BM + wr * 64 + fr; const int col0 = u.pn * BM + wc * 32 + 8 * fq;
        LAS float* XT = (LAS float*)(lds + LDS_XT_OFF);
        u32x4 xx[2][4][2];
#pragma unroll
        for (int ai = 0; ai < 2; ++ai)
#pragma unroll
            for (int m = 0; m < 4; ++m)
#pragma unroll
                for (int bj = 0; bj < 2; ++bj) xx[ai][m][bj] = *(const u32x4*)(X + (size_t)(row0 + ai * HALF + m * 16) * ldc + col0 + bj * HALF);
        __builtin_amdgcn_sched_barrier(0);
#pragma unroll
        for (int ai = 0; ai < 2; ++ai)
#pragma unroll
            for (int m = 0; m < 4; ++m) { const size_t r = (size_t)(row0 + ai * HALF + m * 16); float ss = 0.f;
#pragma unroll
                for (int bj = 0; bj < 2; ++bj) { bf16* xp = XO + r * ldc + col0 + bj * HALF; const u32x4 xo = xx[ai][m][bj];
                    f32x4 v0 = acc[ai][bj][m][0], v1 = acc[ai][bj][m][1];
                    v0[0] += bf_lo(xo.x); v0[1] += bf_hi(xo.x); v0[2] += bf_lo(xo.y); v0[3] += bf_hi(xo.y);
                    v1[0] += bf_lo(xo.z); v1[1] += bf_hi(xo.z); v1[2] += bf_lo(xo.w); v1[3] += bf_hi(xo.w);
                    ss += ((v0[0] * v0[0] + v0[1] * v0[1]) + (v0[2] * v0[2] + v0[3] * v0[3])) + ((v1[0] * v1[0] + v1[1] * v1[1]) + (v1[2] * v1[2] + v1[3] * v1[3]));
                    u32x4 w; w.x = cvt_pk_bf16(v0[0], v0[1]); w.y = cvt_pk_bf16(v0[2], v0[3]); w.z = cvt_pk_bf16(v1[0], v1[1]); w.w = cvt_pk_bf16(v1[2], v1[3]);
                    *(u32x4*)xp = w; }
                ss += __shfl_xor(ss, 16); ss += __shfl_xor(ss, 32);
                if (fq == 0) XT[(ai * HALF + wr * 64 + m * 16 + fr) * 4 + wc] = ss; }
        asm volatile("s_waitcnt lgkmcnt(0)" ::: "memory"); __builtin_amdgcn_s_barrier(); asm volatile("" ::: "memory");
        const int t = fresh_tid();
        if (t < 256) { const f32x4 p = *(const LAS f32x4*)(XT + t * 4); SS[((size_t)u.pm * BM + t) * 8 + u.pn] = (p[0] + p[1]) + (p[2] + p[3]); }
        asm volatile("s_waitcnt lgkmcnt(0)" ::: "memory");
    }
};
struct EpiSwiGLU {
    static constexpr bool PERM = true, PREFETCH = true;
    bf16* O; long pstep; const float* SS;
    __device__ __forceinline__ void prefetch(LAS unsigned char* lds, const Unit& u, int ui, int wid, int lane) const { rs_prefetch(lds, SS, u, ui, wid, lane); }
    __device__ __forceinline__ void operator()(const f32x4 (&acc)[2][2][4][2], const Unit& u, int wr, int wc, int fr, int fq, LAS unsigned char* lds, int ui) const {
        bf16* tbase = O + (size_t)u.pm * pstep + ((size_t)(u.pn * 4 + wc) * BM + wr * 64 + fr) * 32 + 8 * fq;
        const int rl0 = wr * 64 + fr;
        RS_PIPE_BEGIN();
#pragma unroll
        for (int ai = 0; ai < 2; ++ai)
#pragma unroll
            for (int m = 0; m < 4; ++m) { RS_PIPE_STEP(rsc); bf16* rowp = tbase + (ai * HALF + m * 16) * 32;
                const float irs2 = rsc.msq();
                const float k1 = -1.4426950408889634f * __builtin_amdgcn_rsqf(irs2);
                f32x4 v0, v1;
#pragma unroll
                for (int e = 0; e < 4; ++e) { const float a0 = acc[ai][0][m][0][e], a1 = acc[ai][0][m][1][e];
                    const float d0 = __builtin_fmaf(__builtin_amdgcn_exp2f(a0 * k1), irs2, irs2), d1 = __builtin_fmaf(__builtin_amdgcn_exp2f(a1 * k1), irs2, irs2);
                    v0[e] = (a0 * acc[ai][1][m][0][e]) * __builtin_amdgcn_rcpf(d0); v1[e] = (a1 * acc[ai][1][m][1][e]) * __builtin_amdgcn_rcpf(d1); }
                u32x4 w; w.x = cvt_pk_bf16(v0[0], v0[1]); w.y = cvt_pk_bf16(v0[2], v0[3]); w.z = cvt_pk_bf16(v1[0], v1[1]); w.w = cvt_pk_bf16(v1[2], v1[3]);
                *(u32x4*)rowp = w; }
    }
};

struct NoMid { static constexpr bool ENABLED = false; __device__ __forceinline__ void operator()(f32x4 (&)[2][2][4][2], const Unit&, int, int, int, int) const {} };
template <class Epi, class Sched, bool ALIGN_EPI, class Mid = NoMid>
__device__ __forceinline__ void gemm_phase(LAS unsigned char* lds, const Gemm g, const Sched& S, const Epi& E, const Mid& MH = Mid()) {
    int tid = fresh_tid(); const int wid = __builtin_amdgcn_readfirstlane(tid >> 6); int lane = tid & 63; const int wr = wid >> 2, wc = wid & 3; int fr = lane & 15, fq = lane >> 4;
    const int K = g.K, nt = K / BK;
    unsigned voffA[2], voffB[2]; int aoff, boff;
#define PG8_LANE_CONSTS() do { _Pragma("unroll") for (int i_ = 0; i_ < 2; ++i_) { int R_, C_; stage_rc(tid * 16 + i_ * 8192, R_, C_); const int Rb_ = Epi::PERM ? ((R_ & ~31) + perm32(R_ & 31)) : R_; \
        voffA[i_] = g.splitA ? (unsigned)((C_ >> 5) * 256 * 32 + R_ * 32 + (C_ & 31)) * 2u : (unsigned)(R_ * g.lda + C_) * 2u; voffB[i_] = (unsigned)(Rb_ * g.ldb + C_) * 2u; } \
        aoff = lds_byte(wr * 64 + fr, fq * 8); boff = lds_byte(wc * 32 + fr, fq * 8); } while (0)
    PG8_LANE_CONSTS();
    const size_t kstep = (size_t)(BK * 2);
    const size_t kstepA = g.kstepA ? (size_t)g.kstepA : kstep;
    const size_t hstepA = g.splitA ? (size_t)HALF * 32 * 2 : (size_t)HALF * g.lda * 2, hstepB = (size_t)HALF * g.ldb * 2;
    const size_t tstepA = g.tstepA ? (size_t)g.tstepA : 2 * hstepA, tstepB = 2 * hstepB;
    const unsigned ldsw = (unsigned)wid * 1024u;
#define PG8_SA(b, h) (((b) * 2 + (h)) * HTB)
#define PG8_SB(b, h) ((4 + (b) * 2 + (h)) * HTB)
#define PG8_STAGE(bufoff, gbase, voff) do { _Pragma("unroll") for (int _i = 0; _i < 2; ++_i) \
        __builtin_amdgcn_global_load_lds((const unsigned*)((const char*)(gbase) + (voff)[_i]), (LAS unsigned*)(lds + (bufoff) + ldsw + _i * 8192), 16, 0, 0); } while (0)
#define PG8_LDA(dst, b, h) do { _Pragma("unroll") for (int m = 0; m < 4; ++m) _Pragma("unroll") for (int k = 0; k < 2; ++k) dst[m][k] = *(const LAS bf16x8*)(lds + PG8_SA(b, h) + aoff + m * 2048 + k * 1024); } while (0)
#define PG8_LDB(dst, b, h) do { _Pragma("unroll") for (int n = 0; n < 2; ++n) _Pragma("unroll") for (int k = 0; k < 2; ++k) dst[n][k] = *(const LAS bf16x8*)(lds + PG8_SB(b, h) + boff + n * 2048 + k * 1024); } while (0)
#define PG8_MMA(ai, bj, At, Bt) do { __builtin_amdgcn_s_setprio(1); _Pragma("unroll") for (int m = 0; m < 4; ++m) _Pragma("unroll") for (int n = 0; n < 2; ++n) _Pragma("unroll") for (int k = 0; k < 2; ++k) \
        acc[ai][bj][m][n] = __builtin_amdgcn_mfma_f32_16x16x32_bf16(Bt[n][k], At[m][k], acc[ai][bj][m][n], 0, 0, 0); __builtin_amdgcn_s_setprio(0); } while (0)
#define PG8_WAIT_V(n) asm volatile("s_waitcnt vmcnt(" #n ")" ::: "memory")
#define PG8_WAIT_L(n) asm volatile("s_waitcnt lgkmcnt(" #n ")" ::: "memory")
#define PG8_BAR __builtin_amdgcn_s_barrier()
#define PG8_SCHED __builtin_amdgcn_sched_barrier(0)
    Unit cur, nxt; int ui = 0;
    if (!S.next(0, cur)) return;
    const bool snake = g.snake;
    const size_t spanA = (size_t)(nt - 1) * kstepA, spanB = (size_t)(nt - 1) * kstep;
    long sA = snake ? -(long)kstepA : (long)kstepA, sB = snake ? -(long)kstep : (long)kstep;
    f32x4 acc[2][2][4][2];
#pragma unroll
    for (int a = 0; a < 2; ++a)
#pragma unroll
        for (int b = 0; b < 2; ++b)
#pragma unroll
            for (int m = 0; m < 4; ++m)
#pragma unroll
                for (int n = 0; n < 2; ++n) acc[a][b][m][n] = (f32x4){0.f, 0.f, 0.f, 0.f};
    bf16x8 At[4][2], B0[2][2], B1[2][2];
    const char* cA = (const char*)g.A + (size_t)cur.pm * tstepA + (snake ? spanA : 0); const char* cB = (const char*)g.Bt + (size_t)cur.pn * tstepB + (snake ? spanB : 0);
    if constexpr (Epi::PREFETCH) E.prefetch(lds, cur, 0, wid, lane);
    PG8_STAGE(PG8_SB(0, 0), cB, voffB); PG8_STAGE(PG8_SB(0, 1), cB + hstepB, voffB); PG8_STAGE(PG8_SA(0, 0), cA, voffA); PG8_STAGE(PG8_SA(0, 1), cA + hstepA, voffA);
    if (wr == 1) PG8_BAR;
    PG8_WAIT_V(2); PG8_BAR;
    PG8_STAGE(PG8_SB(1, 0), cB + sB, voffB); PG8_STAGE(PG8_SA(1, 0), cA + sA, voffA); PG8_STAGE(PG8_SB(1, 1), cB + hstepB + sB, voffB);
    PG8_WAIT_V(6); PG8_BAR;
    for (;;) {
        if (ui > 0) { tid = fresh_tid(); lane = tid & 63; fr = lane & 15; fq = lane >> 4; PG8_LANE_CONSTS(); }
        const bool has_next = S.next(ui + 1, nxt);
        const long nsA = has_next ? (snake ? -sA : sA) : 0, nsB = has_next ? (snake ? -sB : sB) : 0;
        const char* nA = has_next ? (const char*)g.A + (size_t)nxt.pm * tstepA + (nsA < 0 ? spanA : 0) : cA; const char* nB = has_next ? (const char*)g.Bt + (size_t)nxt.pn * tstepB + (nsB < 0 ? spanB : 0) : cB;
        for (int t = 0; t < nt; t += 2) {
            if constexpr (Mid::ENABLED) { if (t == (nt >> 1)) MH(acc, cur, wr, wc, fr, fq); }
            const bool last = (t == nt - 2);
            const char* a1 = cA + (long)(t + 1) * sA;
            const char* a2 = last ? nA : cA + (long)(t + 2) * sA; const char* b2 = last ? nB : cB + (long)(t + 2) * sB;
            const char* a3 = a2 + (last ? nsA : sA); const char* b3 = b2 + (last ? nsB : sB);
            PG8_LDB(B0, 0, 0); PG8_LDB(B1, 0, 1); PG8_SCHED; PG8_LDA(At, 0, 0); PG8_STAGE(PG8_SA(1, 1), a1 + hstepA, voffA);
            PG8_WAIT_V(8); PG8_WAIT_L(0); PG8_BAR; PG8_MMA(0, 0, At, B0); PG8_MMA(0, 1, At, B1); PG8_BAR; PG8_SCHED;
            PG8_LDA(At, 0, 1); PG8_STAGE(PG8_SB(0, 0), b2, voffB); PG8_STAGE(PG8_SB(0, 1), b2 + hstepB, voffB); PG8_STAGE(PG8_SA(0, 0), a2, voffA);
            PG8_WAIT_V(8); PG8_WAIT_L(0); PG8_BAR; PG8_MMA(1, 0, At, B0); PG8_MMA(1, 1, At, B1); PG8_BAR; PG8_SCHED;
            PG8_LDB(B0, 1, 0); PG8_LDB(B1, 1, 1); PG8_SCHED; PG8_LDA(At, 1, 0); PG8_STAGE(PG8_SA(0, 1), a2 + hstepA, voffA);
            PG8_WAIT_V(8); PG8_WAIT_L(0); PG8_BAR; PG8_MMA(0, 0, At, B0); PG8_MMA(0, 1, At, B1); PG8_BAR; PG8_SCHED;
            PG8_LDA(At, 1, 1); PG8_STAGE(PG8_SB(1, 0), b3, voffB); PG8_STAGE(PG8_SB(1, 1), b3 + hstepB, voffB); PG8_STAGE(PG8_SA(1, 0), a3, voffA);
            PG8_WAIT_V(8); PG8_WAIT_L(0); PG8_BAR; PG8_MMA(1, 0, At, B0); PG8_MMA(1, 1, At, B1); PG8_BAR; PG8_SCHED;
        }
        if constexpr (ALIGN_EPI) { if (wr == 0) PG8_BAR; }
        E(acc, cur, wr, wc, fr, fq, lds, ui);
        if (!has_next) break;
#pragma unroll
        for (int a = 0; a < 2; ++a)
#pragma unroll
            for (int b = 0; b < 2; ++b)
#pragma unroll
                for (int m = 0; m < 4; ++m)
#pragma unroll
                    for (int n = 0; n < 2; ++n) acc[a][b][m][n] = (f32x4){0.f, 0.f, 0.f, 0.f};
        cur = nxt; cA = nA; cB = nB; sA = nsA; sB = nsB; ++ui;
        if constexpr (Epi::PREFETCH) E.prefetch(lds, cur, ui, wid, lane);
        if constexpr (ALIGN_EPI) { if (wr == 1) PG8_BAR; }
    }
    PG8_WAIT_V(0);
    if constexpr (!ALIGN_EPI) { if (wr == 0) PG8_BAR; }
    PG8_BAR;
#undef PG8_LANE_CONSTS
#undef PG8_SA
#undef PG8_SB
#undef PG8_STAGE
#undef PG8_LDA
#undef PG8_LDB
#undef PG8_MMA
#undef PG8_WAIT_V
#undef PG8_WAIT_L
#undef PG8_BAR
#undef PG8_SCHED
}
}

namespace att {
constexpr int D = 128, NW = 8, QBLK = 32, KVBLK = 64, QB = NW * QBLK;
constexpr int PQ = INC;
constexpr int PO = 2048;
constexpr int SHM_V = KVBLK * D * 2, SHM_K = KVBLK * D * 2;
constexpr int LDS_WS = 2 * SHM_V + 2 * SHM_K;
constexpr int LDS_KM = LDS_WS + NW * 64 * 4;
constexpr int LDS_LUT = LDS_KM + 16 * 128 * 4;
constexpr int LDS_BYTES = LDS_LUT + 128 * 4;
constexpr float SCALE = 0.08838834764831845f;
constexpr float THR = 8.f;

#define KSWZ(row, colB) ((row) * 256 + ((colB) ^ (((row) & 15) << 4)))
#define SBAR() __builtin_amdgcn_sched_barrier(0)
__device__ __forceinline__ int v_st(int k, int c) { const int kk = (k & ~0xC) | ((k & 4) << 1) | ((k & 8) >> 1); return ((kk >> 3) * 4 + (c >> 5)) * 512 + ((kk & 7) * 32 + (c & 31)) * 2; }
__device__ __forceinline__ int v_rd_base(int lane) { return ((lane & 3) << 3) | (((lane >> 2) & 3) << 6) | (((lane >> 4) & 1) << 5) | (((lane >> 5) & 1) << 8); }
constexpr int v_rd_off(int d0, int ks, int half) { return d0 * 512 + ks * 4096 + half * 2048; }
__device__ __forceinline__ int crow(int r, int hi) { return (r & 3) + 8 * (r >> 2) + 4 * hi; }
__device__ __forceinline__ unsigned cvtpk(float lo, float hi) { unsigned r; asm volatile("v_cvt_pk_bf16_f32 %0, %1, %2" : "=v"(r) : "v"(lo), "v"(hi)); return r; }
__device__ __forceinline__ bf16x8 load8(const bf16* p) { return *reinterpret_cast<const bf16x8*>(p); }

__device__ __forceinline__ bool moba_mask(f32x16& p0, f32x16& p1, int kb, int ib, int qm, unsigned selmask, const float* LUT, int qlo) {
    const float NEG = -__builtin_inff();
    const int jb = kb >> 8;
    if (kb + 63 + 113 <= qlo) {
        return jb != ib && ((selmask >> jb) & 1u) == 0u;
    } else {
        const bool ok = (jb == ib) || ((selmask >> jb) & 1u);
        const int dq = qm - kb;
#pragma unroll
        for (int g = 0; g < 4; ++g) {
#pragma unroll
            for (int e = 0; e < 4; ++e) { const int r = 4 * g + e;
                const int c = (r & 3) + 8 * (r >> 2);
                const int d0 = dq - c, d1 = d0 - 32;
                const int i0 = d0 < 0 ? 0 : (d0 > 127 ? 127 : d0), i1 = d1 < 0 ? 0 : (d1 > 127 ? 127 : d1);
                const float b0 = LUT[i0], b1 = LUT[i1];
                p0[r] = (ok && d0 >= 0) ? p0[r] + b0 : NEG;
                p1[r] = (ok && d1 >= 0) ? p1[r] + b1 : NEG; }
            SBAR();
        }
    }
    return false;
}
__device__ __forceinline__ void partialSM(f32x16& p0, f32x16& p1, float& m_reg, float& mn, float& alpha, bool dead) {
    float pmax;
    { float ma = p0[0], mb = p1[0];
#pragma unroll
      for (int r = 1; r < 16; ++r) { ma = fmaxf(ma, p0[r]); mb = fmaxf(mb, p1[r]); }
      pmax = fmaxf(ma, mb); }
    { auto rr = __builtin_amdgcn_permlane32_swap(__float_as_uint(pmax), __float_as_uint(pmax), false, false);
      pmax = fmaxf(__uint_as_float(rr[0]), __uint_as_float(rr[1])); }
    constexpr float C2 = 1.4426950408889634f * SCALE;
    if (__builtin_expect(__all((pmax - m_reg) * SCALE <= THR), 1)) { mn = m_reg; alpha = 1.f; }
    else { mn = fmaxf(m_reg, pmax); alpha = __builtin_amdgcn_exp2f((m_reg - mn) * C2); m_reg = mn; }
    const float mnL = dead ? -__builtin_inff() : -mn * C2;
    for (int r = 0; r < 16; ++r) p0[r] = fmaf(p0[r], C2, mnL); for (int r = 0; r < 16; ++r) p1[r] = fmaf(p1[r], C2, mnL);
    for (int r = 0; r < 16; ++r) p0[r] = __builtin_amdgcn_exp2f(p0[r]);
}
__device__ __forceinline__ void finishSM(f32x16& p0, f32x16& p1, float alpha, float& l_reg, bf16x8& pa0, bf16x8& pa1, bf16x8& pa2, bf16x8& pa3) {
    for (int r = 0; r < 16; ++r) p1[r] = __builtin_amdgcn_exp2f(p1[r]);
    float ps;
    { float s0 = p0[0], s1 = p0[1], s2 = p0[2], s3 = p0[3];
#define ADDF(a_, b_) asm("v_add_f32 %0, %0, %1" : "+v"(a_) : "v"(b_))
#pragma unroll
      for (int r = 4; r < 16; r += 4) { ADDF(s0, p0[r]); ADDF(s1, p0[r + 1]); ADDF(s2, p0[r + 2]); ADDF(s3, p0[r + 3]); }
#pragma unroll
      for (int r = 0; r < 16; r += 4) { ADDF(s0, p1[r]); ADDF(s1, p1[r + 1]); ADDF(s2, p1[r + 2]); ADDF(s3, p1[r + 3]); }
      ADDF(s0, s1); ADDF(s2, s3); ADDF(s0, s2); ps = s0; }
#undef ADDF
    { auto rr = __builtin_amdgcn_permlane32_swap(__float_as_uint(ps), __float_as_uint(ps), false, false);
      ps = __uint_as_float(rr[0]) + __uint_as_float(rr[1]); }
    l_reg = l_reg * alpha + ps;
#define PK4(P, B_, OUT) do { unsigned a0 = cvtpk(P[B_+0], P[B_+1]), a1 = cvtpk(P[B_+2], P[B_+3]);                          \
        unsigned b0 = cvtpk(P[B_+4], P[B_+5]), b1 = cvtpk(P[B_+6], P[B_+7]);                                             \
        auto r0 = __builtin_amdgcn_permlane32_swap(a0, b0, false, false); auto r1 = __builtin_amdgcn_permlane32_swap(a1, b1, false, false); \
        u32x4 w = {r0[0], r1[0], r0[1], r1[1]}; OUT = *reinterpret_cast<bf16x8*>(&w); } while (0)
    PK4(p0, 0, pa0); PK4(p0, 8, pa1); PK4(p1, 0, pa2); PK4(p1, 8, pa3);
#undef PK4
}
template <int KB>
__device__ __forceinline__ void qkt(f32x16& p0, f32x16& p1, const char* K_lds, int r32, int hi, const bf16x8* qr) {
    p0 = f32x16{}; p1 = f32x16{};
    const int base = (int)(uintptr_t)K_lds;
    int ad[4];
#pragma unroll
    for (int dd = 0; dd < 4; ++dd) ad[dd] = base + KSWZ(r32, (dd * 16 + hi * 8) * 2);
    const int d47 = 128 - ((r32 & 8) << 5);
#define KRD(dst, addr, off) asm volatile("ds_read_b128 %0, %1 offset:%2" : "=&v"(dst) : "v"(addr), "i"(off) : "memory")
#define KWAIT(n, x, y) asm volatile("s_waitcnt lgkmcnt(" #n ")" : "+v"(x), "+v"(y) :: "memory")
    bf16x8 fa0, fb0, fa1, fb1;
    KRD(fa0, ad[0], KB * SHM_K); KRD(fb0, ad[0], KB * SHM_K + 32 * 256);
#define QK_STEP(d0, FA, FB, NA, NB) do {                                                                                        \
        if ((d0) < 7) { const int an_ = ad[((d0) + 1) & 3] + ((((d0) + 1) >> 2) ? d47 : 0); KRD(NA, an_, KB * SHM_K); KRD(NB, an_, KB * SHM_K + 32 * 256); KWAIT(2, FA, FB); } \
        else KWAIT(0, FA, FB);                                                                                                  \
        p0 = __builtin_amdgcn_mfma_f32_32x32x16_bf16(FA, qr[d0], p0, 0, 0, 0);                                                 \
        p1 = __builtin_amdgcn_mfma_f32_32x32x16_bf16(FB, qr[d0], p1, 0, 0, 0); } while (0)
    QK_STEP(0, fa0, fb0, fa1, fb1); QK_STEP(1, fa1, fb1, fa0, fb0); QK_STEP(2, fa0, fb0, fa1, fb1); QK_STEP(3, fa1, fb1, fa0, fb0);
    QK_STEP(4, fa0, fb0, fa1, fb1); QK_STEP(5, fa1, fb1, fa0, fb0); QK_STEP(6, fa0, fb0, fa1, fb1); QK_STEP(7, fa1, fb1, fa0, fb0);
#undef QK_STEP
#undef KRD
#undef KWAIT
}
template <int VB>
__device__ __forceinline__ void pv_tile(f32x16* o, int vb0, bf16x8 pa0, bf16x8 pa1, bf16x8 pa2, bf16x8 pa3) {
#define TRRD(dst, off) asm volatile("ds_read_b64_tr_b16 %0, %1 offset:%2" : "=&v"(dst) : "v"(vb0), "i"(off) : "memory")
#define PV_D0(d0) do { s16x4 l0, l1, l2, l3, h0, h1, h2, h3; constexpr int b_ = VB * SHM_V + v_rd_off(d0, 0, 0); \
        TRRD(l0, b_); TRRD(h0, b_ + 2048); TRRD(l1, b_ + 4096); TRRD(h1, b_ + 6144); TRRD(l2, b_ + 8192); TRRD(h2, b_ + 10240); TRRD(l3, b_ + 12288); TRRD(h3, b_ + 14336); \
        asm volatile("s_waitcnt lgkmcnt(0)" ::: "memory"); SBAR();   \
        o[d0] = __builtin_amdgcn_mfma_f32_32x32x16_bf16(pa0, (bf16x8){l0[0], l0[1], l0[2], l0[3], h0[0], h0[1], h0[2], h0[3]}, o[d0], 0, 0, 0);   \
        o[d0] = __builtin_amdgcn_mfma_f32_32x32x16_bf16(pa1, (bf16x8){l1[0], l1[1], l1[2], l1[3], h1[0], h1[1], h1[2], h1[3]}, o[d0], 0, 0, 0);   \
        o[d0] = __builtin_amdgcn_mfma_f32_32x32x16_bf16(pa2, (bf16x8){l2[0], l2[1], l2[2], l2[3], h2[0], h2[1], h2[2], h2[3]}, o[d0], 0, 0, 0);   \
        o[d0] = __builtin_amdgcn_mfma_f32_32x32x16_bf16(pa3, (bf16x8){l3[0], l3[1], l3[2], l3[3], h3[0], h3[1], h3[2], h3[3]}, o[d0], 0, 0, 0); } while (0)
    PV_D0(0); PV_D0(1); PV_D0(2); PV_D0(3);
#undef PV_D0
#undef TRRD
}

struct BlockRef { const bf16* Q; const bf16* K; const bf16* V; bf16* O; int P0; };
struct Seam { bf16x8 qr[8]; };
#define VMW() asm volatile("s_waitcnt vmcnt(0)" ::: "memory")
struct DmaMap { unsigned koff, voff; };
__device__ __forceinline__ DmaMap dma_map(int wid, int lane) {
    DmaMap d;
    { const int row = 4 * wid + (lane >> 4), g = (lane & 15) ^ (row & 15); d.koff = (unsigned)(row * PQ + g * 8); }
    { const int B = 2 * wid + (lane >> 5), kk = (B >> 2) * 8 + ((lane & 31) >> 2), c = (B & 3) * 32 + (lane & 3) * 8;
      const int k = (kk & ~0xC) | ((kk & 4) << 1) | ((kk & 8) >> 1); d.voff = (unsigned)(k * PQ + c); }
    return d;
}
#define DMA16(g_, l_) __builtin_amdgcn_global_load_lds((const unsigned*)(g_), (LAS unsigned*)(l_), 16, 0, 0)
#define DMA_K(bf, k0) do { const bf16* g_ = Kh + (size_t)(k0) * PQ + dm.koff; DMA16(g_, KL + (bf) * SHM_K + wid * 1024); DMA16(g_ + 32 * PQ, KL + (bf) * SHM_K + 8192 + wid * 1024); } while (0)
#define DMA_V(bf, k0) do { const bf16* g_ = Vh + (size_t)(k0) * PQ + dm.voff; DMA16(g_, VL + (bf) * SHM_V + wid * 1024); DMA16(g_ + 32 * PQ, VL + (bf) * SHM_V + 8192 + wid * 1024); } while (0)

__device__ __forceinline__ void moba_prime(const BlockRef& cur, char* lds, Seam& S, bool wait = true) {
    const int tid = fresh_tid(), wid = __builtin_amdgcn_readfirstlane(tid >> 6), lane = tid & 63, r32 = lane & 31, hi = lane >> 5;
    LAS unsigned char* VL = (LAS unsigned char*)(unsigned)(uintptr_t)lds; LAS unsigned char* KL = VL + 2 * SHM_V;
    const bf16* Kh = cur.K; const bf16* Vh = cur.V; const DmaMap dm = dma_map(wid, lane);
    DMA_K(0, 0); DMA_V(0, 0);
    for (int d0 = 0; d0 < 8; ++d0) S.qr[d0] = load8(cur.Q + (size_t)(wid * QBLK + r32) * PQ + d0 * 16 + hi * 8);
    if (wait) { VMW(); __syncthreads(); }
}
__device__ __forceinline__ unsigned moba_select(const bf16x8* qr, const float* KM, int nblk, int hi) {
    float qf[64];
#pragma unroll
    for (int d0 = 0; d0 < 8; ++d0)
#pragma unroll
        for (int e = 0; e < 8; ++e) qf[d0 * 8 + e] = __uint_as_float(((unsigned)(unsigned short)qr[d0][e]) << 16);
    float v0 = -__builtin_inff(), v1 = v0, v2 = v0; int i0 = -1, i1 = -1, i2 = -1;
    for (int j = 0; j < nblk; ++j) {
        const float* km = KM + j * 128 + hi * 8;
        float a0 = 0.f, a1 = 0.f, a2 = 0.f, a3 = 0.f;
#pragma unroll
        for (int d0 = 0; d0 < 8; ++d0) { const f32x4 k0 = *(const f32x4*)(km + d0 * 16), k1 = *(const f32x4*)(km + d0 * 16 + 4);
            a0 = fmaf(qf[d0 * 8 + 0], k0[0], a0); a1 = fmaf(qf[d0 * 8 + 1], k0[1], a1); a2 = fmaf(qf[d0 * 8 + 2], k0[2], a2); a3 = fmaf(qf[d0 * 8 + 3], k0[3], a3);
            a0 = fmaf(qf[d0 * 8 + 4], k1[0], a0); a1 = fmaf(qf[d0 * 8 + 5], k1[1], a1); a2 = fmaf(qf[d0 * 8 + 6], k1[2], a2); a3 = fmaf(qf[d0 * 8 + 7], k1[3], a3); }
        float a = (a0 + a1) + (a2 + a3);
        { auto rr = __builtin_amdgcn_permlane32_swap(__float_as_uint(a), __float_as_uint(a), false, false); a = __uint_as_float(rr[0]) + __uint_as_float(rr[1]); }
        if (a > v0) { v2 = v1; i2 = i1; v1 = v0; i1 = i0; v0 = a; i0 = j; }
        else if (a > v1) { v2 = v1; i2 = i1; v1 = a; i1 = j; }
        else if (a > v2) { v2 = a; i2 = j; }
    }
    unsigned msk = 0u;
    if (i0 >= 0) msk |= 1u << i0; if (i1 >= 0) msk |= 1u << i1; if (i2 >= 0) msk |= 1u << i2;
    return msk;
}
__device__ __forceinline__ void moba_block(const BlockRef& cur, char* lds, Seam& S) {
    const int tid = fresh_tid(), wid = __builtin_amdgcn_readfirstlane(tid >> 6), lane = tid & 63, r32 = lane & 31, hi = lane >> 5;
    const int NT = (cur.P0 + QB) / KVBLK;
    const int ib = cur.P0 >> 8;
    const int qlo = cur.P0 + wid * QBLK, qm = qlo + r32 - 4 * hi;
    char* V_lds = lds; char* K_lds = lds + 2 * SHM_V;
    LAS unsigned char* VL = (LAS unsigned char*)(unsigned)(uintptr_t)lds; LAS unsigned char* KL = VL + 2 * SHM_V;
    float* ws = (float*)(lds + LDS_WS) + wid * 64; float* li_l = ws, * al_l = ws + 32;
    const float* KM = (const float*)(lds + LDS_KM); const float* LUT = (const float*)(lds + LDS_LUT);
    float m_reg = -1e30f, l_reg = 0; f32x16 o[4] = {};
    const int vb0 = (int)(uintptr_t)V_lds + v_rd_base(lane);
    const bf16* Kh = cur.K; const bf16* Vh = cur.V; const DmaMap dm = dma_map(wid, lane);
#define RESC(a) do { if (__any((a) < 1.f)) { if (hi == 0) al_l[r32] = (a); asm volatile("s_waitcnt lgkmcnt(0)" ::: "memory");              \
                     for (int d_ = 0; d_ < 4; ++d_) for (int r = 0; r < 16; ++r) o[d_][r] *= al_l[crow(r, hi)]; } } while (0)
#define KBASE(t) ((t) * KVBLK)
#define MASKT(P0_, P1_, t) const bool dead_ = moba_mask(P0_, P1_, KBASE(t), ib, qm, selmask, LUT, qlo)
    f32x16 pA0, pA1, pB0, pB1; float mnA, mnB, alA, alB; bf16x8 pa0, pa1, pa2, pa3;
    SBAR(); DMA_K(1, KBASE(1)); SBAR();
    const unsigned selmask = ib <= 3 ? (1u << ib) - 1u : moba_select(S.qr, KM, ib, hi);
    SBAR(); qkt<0>(pA0, pA1, K_lds, r32, hi, S.qr);
    { MASKT(pA0, pA1, 0); partialSM(pA0, pA1, m_reg, mnA, alA, dead_); }
    VMW();
    __syncthreads();
    const int Tw = NT - 4 + (wid >> 1);
#define HALF_STEP(PX0, PX1, mnX, alX, PY0, PY1, alY, t, KB, VB) do {                                                          \
        SBAR(); DMA_K(VB, KBASE((t) + 1)); DMA_V(KB, KBASE(t)); SBAR();                                                       \
        if ((t) <= Tw) qkt<KB>(PX0, PX1, K_lds, r32, hi, S.qr);                                                               \
        if ((t) - 1 <= Tw) { finishSM(PY0, PY1, alY, l_reg, pa0, pa1, pa2, pa3); SBAR();                                      \
            pv_tile<VB>(o, vb0, pa0, pa1, pa2, pa3); }                                                                        \
        if ((t) <= Tw) { MASKT(PX0, PX1, (t)); partialSM(PX0, PX1, m_reg, mnX, alX, dead_); RESC(alX); }                      \
        VMW();                                                                                                                \
        __syncthreads(); } while (0)
    for (int t = 1; t + 1 < NT; t += 2) {
        HALF_STEP(pB0, pB1, mnB, alB, pA0, pA1, alA, t, 1, 0);
        HALF_STEP(pA0, pA1, mnA, alA, pB0, pB1, alB, t + 1, 0, 1);
    }
    SBAR(); DMA_V(1, KBASE(NT - 1)); SBAR();
    if (NT - 1 <= Tw) { qkt<1>(pB0, pB1, K_lds, r32, hi, S.qr); SBAR(); }
    if (NT - 2 <= Tw) { finishSM(pA0, pA1, alA, l_reg, pa0, pa1, pa2, pa3); SBAR();
        pv_tile<0>(o, vb0, pa0, pa1, pa2, pa3); }
    if (NT - 1 <= Tw) { MASKT(pB0, pB1, NT - 1); partialSM(pB0, pB1, m_reg, mnB, alB, dead_); RESC(alB); }
    VMW(); __syncthreads();
    if (NT - 1 <= Tw) { finishSM(pB0, pB1, alB, l_reg, pa0, pa1, pa2, pa3); SBAR(); pv_tile<1>(o, vb0, pa0, pa1, pa2, pa3); }
    SBAR();
    if (hi == 0) li_l[r32] = l_reg; asm volatile("s_waitcnt lgkmcnt(0)" ::: "memory");
    float rli[16];
#pragma unroll
    for (int r = 0; r < 16; ++r) rli[r] = __builtin_amdgcn_rcpf(li_l[crow(r, hi)]);
    bf16* Ow = cur.O + (size_t)(wid * QBLK) * PO;
#pragma unroll
    for (int r = 0; r < 16; ++r) { const int orow = crow(r, hi);
#pragma unroll
        for (int d0 = 0; d0 < 4; ++d0) { const float v = o[d0][r] * rli[r];
            const float vn = __shfl_xor(v, 1);
            if ((r32 & 1) == 0) *(unsigned*)(Ow + (size_t)orow * PO + d0 * 32 + r32) = cvtpk(v, vn); } }
    __syncthreads();
#undef RESC
#undef KBASE
#undef MASKT
#undef HALF_STEP
}
#undef VMW
#undef DMA16
#undef DMA_K
#undef DMA_V
#undef SBAR
#undef KSWZ
}

constexpr size_t MiB = 1u << 20;
constexpr size_t WS_CTL = 0, CTL_ZERO_BYTES = 64 * 1024;
constexpr size_t WO_IN = 0;
constexpr size_t WO_CA = 40 * MiB;
constexpr size_t WO_MIX = 48 * MiB;
constexpr size_t WO_GU = 56 * MiB;
constexpr size_t WO_DN = 100 * MiB;
constexpr size_t WSET_BYTES = 122 * MiB;
constexpr size_t WS_W0 = 2 * MiB, WS_W1 = 702 * MiB;
constexpr size_t WS_KPART = 124 * MiB;
constexpr size_t WS_SS = 126 * MiB;
constexpr size_t WS_XB2 = 128 * MiB;
constexpr size_t WS_XB = 254 * MiB;
constexpr size_t WS_PROJ = 318 * MiB;
constexpr size_t WS_GU = WS_PROJ;
constexpr size_t WS_UA = 638 * MiB;
constexpr size_t WS_MG = 830 * MiB;
constexpr size_t WS_END = 894 * MiB;
static_assert(WS_W1 + WSET_BYTES <= WS_MG, "weight set 1");
constexpr int CW_BAR = 4096;

constexpr int RING_OFF = 0, RING_BYTES = 131072;
constexpr int LDSCTL_OFF = RING_BYTES, MISC_OFF = LDSCTL_OFF + 320;
constexpr int LDS_BYTES = LDS_TOTAL;
static_assert(att::LDS_BYTES <= RING_BYTES && MISC_OFF + 128 <= LDS_RB_OFF, "LDS map");

#define XB_TMO      128
#define XB_XCNT(j)  (256  + 64 * (j))
#define XB_XSUB(j)  (1280 + 64 * (j))
#define XB_XGEN(j)  (2304 + 64 * (j))
#define XB_TOP      3328
#define XB_TOPGEN   3392
#define XCD_BAR_WORDS 3456
#define XB_SPIN_CAP (1u << 18)

__device__ __forceinline__ unsigned xb_ld(unsigned* p)              { return __hip_atomic_load(p, __ATOMIC_RELAXED, __HIP_MEMORY_SCOPE_AGENT); }
__device__ __forceinline__ unsigned xb_add(unsigned* p, unsigned v) { return __hip_atomic_fetch_add(p, v, __ATOMIC_RELAXED, __HIP_MEMORY_SCOPE_AGENT); }
__device__ __forceinline__ unsigned xb_xcc_id() { return (unsigned)__builtin_amdgcn_s_getreg((3 << 11) | 20) & 0xFu; }
#define XB_SPIN(cond, bar) do { unsigned _sp = 0; while (cond) { __builtin_amdgcn_s_sleep(1); \
    if ((++_sp & 255u) == 0u) { if (xb_ld(&(bar)[XB_TMO])) break; if (_sp > XB_SPIN_CAP) { atomicAdd(&(bar)[XB_TMO], 1u); break; } } } } while (0)

struct XcdBarrier { unsigned* bar; unsigned x; volatile LAS unsigned* st; };

__device__ __forceinline__ XcdBarrier xcd_barrier_post(unsigned* bar, volatile LAS unsigned* st) {
    XcdBarrier b; b.bar = bar; b.x = xb_xcc_id(); b.st = st;
    if (threadIdx.x == 0) (void)xb_add(&bar[XB_XCNT(b.x)], 1u);
    return b;
}
__device__ __forceinline__ void xcd_barrier_complete(unsigned* bar, unsigned x, unsigned& nloc, unsigned& nx) {
    const unsigned G = gridDim.x * gridDim.y * gridDim.z;
    unsigned sum, cnt, mine, sp = 0u;
    for (;;) {
        sum = 0u; cnt = 0u; mine = 0u;
#pragma unroll
        for (unsigned j = 0; j < 16; ++j) { const unsigned c = xb_ld(&bar[XB_XCNT(j)]); sum += c; cnt += (c > 0u) ? 1u : 0u; mine = (j == x) ? c : mine; }
        if (sum == G) break;
        __builtin_amdgcn_s_sleep(1);
        if ((++sp & 255u) == 0u) { if (xb_ld(&bar[XB_TMO])) break; if (sp > XB_SPIN_CAP) { atomicAdd(&bar[XB_TMO], 1u); break; } }
    }
    nloc = mine > 0u ? mine : 1u; nx = cnt > 0u ? cnt : 1u;
}
__device__ __forceinline__ void xcd_barrier(const XcdBarrier& b) {
    asm volatile("s_waitcnt vmcnt(0)" ::: "memory");
    __syncthreads();
    if (threadIdx.x == 0) {
        unsigned* bar = b.bar;
        __builtin_amdgcn_s_waitcnt(0);
        unsigned nloc = b.st[0], nx = b.st[1];
        if (nloc == 0u) { xcd_barrier_complete(bar, b.x, nloc, nx); b.st[0] = nloc; b.st[1] = nx; }
        const unsigned old = xb_add(&bar[XB_XSUB(b.x)], 1u);
        const unsigned gen = old / nloc;
        if (old + 1u == (gen + 1u) * nloc) {
            __builtin_amdgcn_fence(__ATOMIC_RELEASE, "agent");
            asm volatile("s_waitcnt vmcnt(0)" ::: "memory");
            const unsigned og = xb_add(&bar[XB_TOP], 1u);
            const unsigned tg = og / nx;
            if (og + 1u == (tg + 1u) * nx) xb_add(&bar[XB_TOPGEN], 1u);
            else XB_SPIN(xb_ld(&bar[XB_TOPGEN]) == tg, bar);
            __builtin_amdgcn_fence(__ATOMIC_ACQUIRE, "agent");
            asm volatile("s_waitcnt vmcnt(0)" ::: "memory");
            xb_add(&bar[XB_XGEN(b.x)], 1u);
            asm volatile("s_waitcnt vmcnt(0)" ::: "memory");
        } else {
            XB_SPIN(xb_ld(&bar[XB_XGEN(b.x)]) == gen, bar);
            asm volatile("buffer_inv sc0\n\ts_waitcnt vmcnt(0)" ::: "memory");
        }
    }
    __syncthreads();
}

__device__ __forceinline__ void panel_barrier(unsigned* cnt, unsigned target, unsigned* tmo, bool local) {
    asm volatile("s_waitcnt vmcnt(0)" ::: "memory");
    __syncthreads();
    if (threadIdx.x == 0) {
        if (!local) { __builtin_amdgcn_fence(__ATOMIC_RELEASE, "agent"); asm volatile("s_waitcnt vmcnt(0)" ::: "memory"); }
        (void)xb_add(cnt, 1u);
        unsigned sp = 0u;
        while (xb_ld(cnt) < target) { __builtin_amdgcn_s_sleep(1); if ((++sp & 255u) == 0u) { if (xb_ld(tmo)) break; if (sp > XB_SPIN_CAP) { atomicAdd(tmo, 1u); break; } } }
        if (!local) { __builtin_amdgcn_fence(__ATOMIC_ACQUIRE, "agent"); asm volatile("s_waitcnt vmcnt(0)" ::: "memory"); }
    }
    __syncthreads();
    if (local) asm volatile("buffer_inv sc0\n\ts_waitcnt vmcnt(0)" ::: "memory");
}
struct Args { const float* in[13]; float* out; unsigned char* ws; int ph_lo, ph_hi; };
struct Frame {
    LAS unsigned char* lds;
    int vcu, G;
    unsigned char* ws;
};

__device__ __forceinline__ float wave_sum(float v) {
#pragma unroll
    for (int o = 1; o < 64; o <<= 1) v += __shfl_xor(v, o);
    return v;
}
struct CvtItem { const float* src; size_t rs2; bf16* dst; int ldw; const float* gain; int has_gain; };
constexpr int CVT_I_IN = (DM / 64) * (INC / 32), CVT_NITEMS = CVT_I_IN + 2 * (CCH / 64) * (DM / 32) + (DM / 64) * (DM / 32) + 2 * (DM / 64) * (FF / 32) + (FF / 64) * (DM / 32);
__device__ __forceinline__ CvtItem cvt_decode(const Args& a, unsigned char* wset, int l, int r) {
    constexpr int I_IN = (DM / 64) * (INC / 32), I_CO = (CCH / 64) * (DM / 32), I_AO = (AW / 64) * (DM / 32), I_MIX = (DM / 64) * (DM / 32),
                  I_G = (DM / 64) * (FF / 32), I_U = I_G, I_DN = (FF / 64) * (DM / 32);
    static_assert(I_IN == CVT_I_IN && I_IN + I_CO + I_AO + I_MIX + I_G + I_U + I_DN == CVT_NITEMS, "item counts");
    const float* W; int N, ldw, k0, n0; bf16* WT; const float* gain = nullptr; int dcol = 0, rowmode = 0;
#define CVT_KN(NB) do { k0 = 64 * (r / (NB)); n0 = 32 * (r % (NB)); } while (0)
    if (r < I_IN) { W = a.in[1] + (size_t)l * DM * INC; N = INC; WT = (bf16*)(wset + WO_IN); ldw = DM; gain = a.in[7] + (size_t)l * DM; rowmode = 3; CVT_KN(INC / 32); }
    else if ((r -= I_IN) < I_CO) { W = a.in[3] + (size_t)l * CCH * DM; N = DM; WT = (bf16*)(wset + WO_CA); ldw = 2048; CVT_KN(DM / 32); }
    else if ((r -= I_CO) < I_AO) { W = a.in[4] + (size_t)l * AW * DM; N = DM; WT = (bf16*)(wset + WO_CA); ldw = 2048; dcol = 1024; CVT_KN(DM / 32); }
    else if ((r -= I_AO) < I_MIX) { W = a.in[5] + (size_t)l * DM * DM; N = DM; WT = (bf16*)(wset + WO_MIX); ldw = DM; CVT_KN(DM / 32); }
    else if ((r -= I_MIX) < I_G) { W = a.in[9] + (size_t)l * DM * FF; N = FF; WT = (bf16*)(wset + WO_GU); ldw = DM; gain = a.in[8] + (size_t)l * DM; rowmode = 1; CVT_KN(FF / 32); }
    else if ((r -= I_G) < I_U) { W = a.in[10] + (size_t)l * DM * FF; N = FF; WT = (bf16*)(wset + WO_GU); ldw = DM; gain = a.in[8] + (size_t)l * DM; rowmode = 2; CVT_KN(FF / 32); }
    else { r -= I_U; W = a.in[11] + (size_t)l * FF * DM; N = DM; WT = (bf16*)(wset + WO_DN); ldw = FF; CVT_KN(DM / 32); }
#undef CVT_KN
    int drow = rowmode == 0 ? n0 : 256 * (n0 / 128) + (n0 % 128) + (rowmode == 2 ? 128 : 0);
    if (rowmode == 3) { const int isatt = n0 >= C_GA, gcol = n0 - (isatt ? C_GA : C_GC);
        drow = n0 < C_GC ? n0 : C_GC + 256 * (gcol / 128) + (gcol % 128) + (isatt ? 128 : 0);
        if (n0 < C_B || (n0 >= C_C && n0 < C_Q)) { const int isc = n0 >= C_C, ch = n0 - (isc ? C_C : 0), k = ch / 128, pk = k < 4 ? k : 4 + k;
            drow = 256 * pk + (ch % 128) + (isc ? 128 : 0); } }
    CvtItem c; c.src = W + (size_t)k0 * N + n0; c.rs2 = (size_t)2 * N; c.dst = WT + (size_t)drow * ldw + dcol + k0; c.ldw = ldw; c.gain = (gain ? gain : a.in[7]) + k0; c.has_gain = gain != nullptr;
    return c;
}
__device__ __forceinline__ void cvt_load(const CvtItem& c, int lane, f32x4 (&wv)[8], f32x4 (&gv)[2]) {
    const float* wp = c.src + (size_t)(lane >> 3) * (c.rs2 >> 1) + 4 * (lane & 7);
#pragma unroll
    for (int i = 0; i < 8; ++i) wv[i] = *(const GAS f32x4*)(wp + (size_t)i * 4 * c.rs2);
    gv[0] = *(const f32x4*)(c.gain + 8 * (lane & 7)); gv[1] = *(const f32x4*)(c.gain + 8 * (lane & 7) + 4);
}
__device__ __forceinline__ void cvt_store(const CvtItem& c, int lane, const f32x4 (&wv)[8], const f32x4 (&gv)[2], LAS float* scr) {
    const int ch = lane & 7;
    LAS float* wp = scr + (lane >> 3) * 33 + 4 * (lane & 7);
#pragma unroll
    for (int i = 0; i < 8; ++i)
#pragma unroll
        for (int q = 0; q < 4; ++q) wp[i * 8 * 33 + q] = wv[i][q];
    f32x4 g0 = gv[0], g1 = gv[1];
    if (!c.has_gain) { g0 = (f32x4){1.f, 1.f, 1.f, 1.f}; g1 = g0; }
    LDS_WAIT(); asm volatile("" ::: "memory");
    float t[4][8];
#pragma unroll
    for (int j = 0; j < 4; ++j) { const LAS float* sp = scr + (8 * ch) * 33 + (lane >> 3) + 8 * j;
#pragma unroll
        for (int e = 0; e < 8; ++e) t[j][e] = sp[e * 33]; }
    __builtin_amdgcn_sched_barrier(0);
    LDS_WAIT();
#pragma unroll
    for (int j = 0; j < 4; ++j) { const int n = (lane >> 3) + 8 * j;
        v4u o; o.x = cvt_pk_bf16(t[j][0] * g0[0], t[j][1] * g0[1]); o.y = cvt_pk_bf16(t[j][2] * g0[2], t[j][3] * g0[3]); o.z = cvt_pk_bf16(t[j][4] * g1[0], t[j][5] * g1[1]); o.w = cvt_pk_bf16(t[j][6] * g1[2], t[j][7] * g1[3]);
        *(GAS v4u*)(c.dst + (size_t)n * c.ldw + 8 * ch) = o; }
    asm volatile("" ::: "memory");
}
__device__ __forceinline__ void phase_convert_weights(Frame& F, const Args& a, int l, int it_lo, int it_hi) {
    const int tid = fresh_tid(), lane = tid & 63, wave = __builtin_amdgcn_readfirstlane(tid >> 6);
    LAS float* scr = (LAS float*)(F.lds + RING_OFF + wave * 8448);
    const int gw = F.vcu * NWAVES + wave, NGW = F.G * NWAVES;
    unsigned char* wset = F.ws + ((l & 1) ? WS_W1 : WS_W0);
    const int first = it_lo + gw;
    if (first >= it_hi) return;
    const int n = (it_hi - first + NGW - 1) / NGW;
#define CVT_ITEM(j) cvt_decode(a, wset, l, first + ((j) < n ? (j) : n - 1) * NGW)
    f32x4 wA[8], wB[8], wC[8], wD[8], gA[2], gB[2], gC[2], gD[2];
    CvtItem cA = CVT_ITEM(0), cB = CVT_ITEM(1), cC = CVT_ITEM(2), cD = cA;
    cvt_load(cA, lane, wA, gA); cvt_load(cB, lane, wB, gB); cvt_load(cC, lane, wC, gC);
    for (int j = 0;; j += 4) {
        cD = CVT_ITEM(j + 3); cvt_load(cD, lane, wD, gD); __builtin_amdgcn_sched_barrier(0); cvt_store(cA, lane, wA, gA, scr); if (j + 1 >= n) break;
        cA = CVT_ITEM(j + 4); cvt_load(cA, lane, wA, gA); __builtin_amdgcn_sched_barrier(0); cvt_store(cB, lane, wB, gB, scr); if (j + 2 >= n) break;
        cB = CVT_ITEM(j + 5); cvt_load(cB, lane, wB, gB); __builtin_amdgcn_sched_barrier(0); cvt_store(cC, lane, wC, gC, scr); if (j + 3 >= n) break;
        cC = CVT_ITEM(j + 6); cvt_load(cC, lane, wC, gC); __builtin_amdgcn_sched_barrier(0); cvt_store(cD, lane, wD, gD, scr); if (j + 4 >= n) break;
    }
#undef CVT_ITEM
}
__device__ __forceinline__ void phase_x_to_bf16(Frame& F, const float* x) {
    const int tid = fresh_tid(), lane = tid & 63, wave = __builtin_amdgcn_readfirstlane(tid >> 6);
    const int gw = F.vcu * NWAVES + wave, NGW = F.G * NWAVES;
    bf16* XB = (bf16*)(F.ws + WS_XB); float* SS = (float*)(F.ws + WS_SS);
    for (int m = gw; m < M; m += 2 * NGW) {
        const GAS f32x4* xr0 = (const GAS f32x4*)(x + (size_t)m * DM) + lane; const bool two = m + NGW < M; const GAS f32x4* xr1 = (const GAS f32x4*)(x + (size_t)(two ? m + NGW : m) * DM) + lane;
        f32x4 v0[8], v1[8];
#pragma unroll
        for (int j = 0; j < 8; ++j) v0[j] = __builtin_nontemporal_load(xr0 + 64 * j);
#pragma unroll
        for (int j = 0; j < 8; ++j) v1[j] = __builtin_nontemporal_load(xr1 + 64 * j);
        __builtin_amdgcn_sched_barrier(0);
#pragma unroll
        for (int h = 0; h < 2; ++h) { if (h && !two) break; const int mm = m + h * NGW; float s = 0.f;
            GAS u32x2* o8 = (GAS u32x2*)(XB + (size_t)mm * DM) + lane;
#pragma unroll
            for (int j = 0; j < 8; ++j) { const f32x4 v = h ? v1[j] : v0[j]; s += (v.x * v.x + v.y * v.y) + (v.z * v.z + v.w * v.w);
                u32x2 w; w.x = cvt_pk_bf16(v.x, v.y); w.y = cvt_pk_bf16(v.z, v.w); o8[64 * j] = w; }
            s = wave_sum(s);
            if (lane < 8) SS[(size_t)mm * 8 + lane] = lane == 0 ? s : 0.f; }
    }
}
__device__ __forceinline__ void phase_final_norm(Frame& F, const float* gain, float* out, int pm, int mi) {
    const int tid = fresh_tid(), lane = tid & 63, wave = __builtin_amdgcn_readfirstlane(tid >> 6);
    const int gw = pm >= 0 ? wave : F.vcu * NWAVES + wave, NGW = pm >= 0 ? NWAVES : F.G * NWAVES;
    const int mlo = pm >= 0 ? pm * 256 + mi * 64 : 0, mhi = pm >= 0 ? mlo + 64 : M;
    const bf16* XB = (const bf16*)(F.ws + WS_XB); const float* SS = (const float*)(F.ws + WS_SS);
    for (int m = mlo + gw; m < mhi; m += NGW) {
        float s = lane < 8 ? SS[(size_t)m * 8 + lane] : 0.f; s = wave_sum(s);
        const float r = __builtin_amdgcn_rsqf(s * (1.0f / DM) + RMS_EPS);
#pragma unroll
        for (int j = 0; j < 4; ++j) { const int c = 8 * (lane + 64 * j); const u32x4 w = __builtin_nontemporal_load((const GAS u32x4*)(XB + (size_t)m * DM + c));
            const f32x4 g0 = *(const f32x4*)(gain + c), g1 = *(const f32x4*)(gain + c + 4);
            f32x4 o0, o1; o0[0] = bf_lo(w.x) * r * g0[0]; o0[1] = bf_hi(w.x) * r * g0[1]; o0[2] = bf_lo(w.y) * r * g0[2]; o0[3] = bf_hi(w.y) * r * g0[3];
            o1[0] = bf_lo(w.z) * r * g1[0]; o1[1] = bf_hi(w.z) * r * g1[1]; o1[2] = bf_lo(w.w) * r * g1[2]; o1[3] = bf_hi(w.w) * r * g1[3];
            __builtin_nontemporal_store(o0, (GAS f32x4*)(out + (size_t)m * DM + c)); __builtin_nontemporal_store(o1, (GAS f32x4*)(out + (size_t)m * DM + c + 4)); }
    }
}
__device__ __forceinline__ void unpack8(const u32x4 w, float (&f)[8]) {
    f[0] = bf_lo(w.x); f[1] = bf_hi(w.x); f[2] = bf_lo(w.y); f[3] = bf_hi(w.y); f[4] = bf_lo(w.z); f[5] = bf_hi(w.z); f[6] = bf_lo(w.w); f[7] = bf_hi(w.w);
}
__device__ __forceinline__ void phase_conv(Frame& F, const float* conv_w  ) {
    const bf16* PROJ = (const bf16*)(F.ws + WS_PROJ); bf16* UA = (bf16*)(F.ws + WS_UA);
    const int tid = fresh_tid(), lane = tid & 63, wave = __builtin_amdgcn_readfirstlane(tid >> 6);
    const int gw = F.vcu * NWAVES + wave, NGW = F.G * NWAVES;
    for (int it = gw; it < (M / 16) * 2; it += NGW) {
        const int half = it & 1, rr = it >> 1, m0 = rr * 16, t0 = m0 % SEQ, c0 = half * 512 + lane * 8;
        float w0[8], w1[8], w2[8];
        { const f32x4 a0 = *(const f32x4*)(conv_w + c0), a1 = *(const f32x4*)(conv_w + c0 + 4), b0 = *(const f32x4*)(conv_w + CCH + c0), b1 = *(const f32x4*)(conv_w + CCH + c0 + 4),
                      d0 = *(const f32x4*)(conv_w + 2 * CCH + c0), d1 = *(const f32x4*)(conv_w + 2 * CCH + c0 + 4);
#pragma unroll
          for (int e = 0; e < 4; ++e) { w0[e] = a0[e]; w0[4 + e] = a1[e]; w1[e] = b0[e]; w1[4 + e] = b1[e]; w2[e] = d0[e]; w2[4 + e] = d1[e]; } }
        float p2[8], p1[8];
#pragma unroll
        for (int e = 0; e < 8; ++e) { p2[e] = 0.f; p1[e] = 0.f; }
        if (t0 != 0) {
            unpack8(*(const u32x4*)(PROJ + (size_t)(m0 - 2) * INC + C_H + c0), p2);
            unpack8(*(const u32x4*)(PROJ + (size_t)(m0 - 1) * INC + C_H + c0), p1);
        }
#pragma unroll 16
        for (int r = 0; r < 16; ++r) {
            const size_t m = (size_t)(m0 + r);
            float ch[8], b[8], y[8];
            unpack8(__builtin_nontemporal_load((const GAS u32x4*)(PROJ + m * INC + C_H + c0)), ch); unpack8(__builtin_nontemporal_load((const GAS u32x4*)(PROJ + m * INC + C_B + c0)), b);
#pragma unroll
            for (int e = 0; e < 8; ++e) { const float cu = ch[e]; float acc = w0[e] * p2[e]; acc = acc + w1[e] * p1[e]; acc = acc + w2[e] * cu; y[e] = b[e] * acc; p2[e] = p1[e]; p1[e] = cu; }
            u32x4 w; w.x = cvt_pk_bf16(y[0], y[1]); w.y = cvt_pk_bf16(y[2], y[3]); w.z = cvt_pk_bf16(y[4], y[5]); w.w = cvt_pk_bf16(y[6], y[7]);
            *(u32x4*)(UA + m * 2048 + c0) = w;
        }
    }
}
__device__ __forceinline__ int t5_bucket(int n) {
    if (n < 16) return n;
    int b = 16;
    b += (n >= 19); b += (n >= 21); b += (n >= 24); b += (n >= 27); b += (n >= 31); b += (n >= 35); b += (n >= 40); b += (n >= 46);
    b += (n >= 52); b += (n >= 59); b += (n >= 67); b += (n >= 77); b += (n >= 87); b += (n >= 99); b += (n >= 113);
    return b;
}
__device__ __forceinline__ void mixer_stream_work(Frame& F, const Args& a, int l) {
    for (int rep = 0; rep < REP_MISC; ++rep) {
        phase_conv(F, a.in[2] + (size_t)l * 3 * CCH);
        if (l == 0) phase_convert_weights(F, a, 0, CVT_I_IN, CVT_NITEMS);
        if (l + 1 < DEPTH) phase_convert_weights(F, a, l + 1, 0, CVT_NITEMS);
    }
}
__device__ __forceinline__ void phase_attention(Frame& F, char* lds, const float* rel_bias, const Args& a, int l) {
    const bf16* PROJ = (const bf16*)(F.ws + WS_PROJ); bf16* UA = (bf16*)(F.ws + WS_UA); const float* KPART = (const float*)(F.ws + WS_KPART);
    float* KM = (float*)(lds + att::LDS_KM); float* LUT = (float*)(lds + att::LDS_LUT);
    bool streamed = false;
    for (int L = F.vcu; L < BATCH * NH * 8; L += F.G) {
        const int tid = fresh_tid();
        const int bh = L >> 3, x = L & 7, b = bh / NH, h = bh % NH;
        const int qbA = (bh & 1) ? 15 - x : x, qbB = 15 - qbA;
        att::BlockRef bA, bB;
        { const size_t row0 = (size_t)b * SEQ + (size_t)qbA * 256; bA.Q = PROJ + row0 * INC + C_Q + h * HD; bA.O = UA + row0 * 2048 + 1024 + h * HD; bA.P0 = qbA * 256; }
        { const size_t row0 = (size_t)b * SEQ + (size_t)qbB * 256; bB.Q = PROJ + row0 * INC + C_Q + h * HD; bB.O = UA + row0 * 2048 + 1024 + h * HD; bB.P0 = qbB * 256; }
        bA.K = bB.K = PROJ + (size_t)b * SEQ * INC + C_K + h * HD; bA.V = bB.V = PROJ + (size_t)b * SEQ * INC + C_V + h * HD;
        att::Seam S;
        att::moba_prime(bA, lds, S, false);
        for (int idx = tid; idx < 16 * 128; idx += NWAVES * 64) { const int j = idx >> 7, d = idx & 127; float s = 0.f;
            s = KPART[(size_t)((b * 16 + j) * 2 + 0) * 1024 + h * 128 + d] + KPART[(size_t)((b * 16 + j) * 2 + 1) * 1024 + h * 128 + d];
            KM[idx] = s * (1.0f / 256.0f); }
        if (tid < 128) LUT[tid] = (rel_bias[t5_bucket(tid) * NH + h] - rel_bias[31 * NH + h]) * (1.0f / att::SCALE);
        asm volatile("s_waitcnt vmcnt(0)" ::: "memory"); __syncthreads();
        for (int rep = 0; rep < REP_ATT; ++rep) {
        if (rep > 0) att::moba_prime(bA, lds, S);
        att::moba_block(bA, lds, S);
        __syncthreads();
        if (!streamed) { mixer_stream_work(F, a, l); streamed = true; __syncthreads(); }
        att::moba_prime(bB, lds, S);
        att::moba_block(bB, lds, S);
        __syncthreads();
        }
    }
    if (!streamed) mixer_stream_work(F, a, l);
}
constexpr int PH_PER_LAYER = 6, N_PHASES = DEPTH * PH_PER_LAYER + 2;

__global__ void __launch_bounds__(NWAVES * 64, 2) trunk_fwd(Args args) {
    extern __shared__ __attribute__((aligned(16))) unsigned char lds[];
    Frame F;
    F.lds = (LAS unsigned char*)lds;
    volatile LAS unsigned* MISC = (volatile LAS unsigned*)(F.lds + MISC_OFF);
    F.G = gridDim.x; { const int bx = blockIdx.x; F.vcu = (F.G % 8 == 0) ? (bx % 8) * (F.G / 8) + bx / 8 : bx; }
    F.ws = args.ws;
    unsigned* ctl = (unsigned*)(F.ws + WS_CTL);
    for (int u = threadIdx.x; u < (LDS_BYTES - LDSCTL_OFF) / 4; u += NWAVES * 64) ((LAS unsigned*)(F.lds + LDSCTL_OFF))[u] = 0u;
    __syncthreads();
    const int lo = args.ph_lo, hi = args.ph_hi;
    const bool use_bar = (hi - lo) > 1;
    XcdBarrier bar; bar.bar = ctl + CW_BAR; bar.x = 0; bar.st = MISC + 8;
    if (use_bar) bar = xcd_barrier_post(ctl + CW_BAR, MISC + 8);
#define IN(k) (lo <= (k) && (k) < hi)
#define SEAM(k) do { if ((k) + 1 < hi) xcd_barrier(bar); } while (0)
    const bool paneled = (F.G == 256) && use_bar;
    const int my_pm = 8 * ((int)blockIdx.x % 8) + ((int)blockIdx.x / 8) % 8, my_mi = (int)blockIdx.x / 64;
    unsigned pb_epoch = 0u; bool pb_local = false;
    if (paneled && threadIdx.x == 0) __hip_atomic_store(ctl + 12288 + blockIdx.x, 0x100u | xb_xcc_id(), __ATOMIC_RELAXED, __HIP_MEMORY_SCOPE_AGENT);
#define SEAMG(k) do { if ((k) + 1 < hi) { if (paneled) { pb_epoch += 4u; panel_barrier(ctl + 8192 + 64 * my_pm, pb_epoch, ctl + CW_BAR + XB_TMO, pb_local); } else xcd_barrier(bar); } } while (0)

    bf16* XB = (bf16*)(F.ws + WS_XB); bf16* XB2 = (bf16*)(F.ws + WS_XB2); float* SS = (float*)(F.ws + WS_SS); bf16* PROJ = (bf16*)(F.ws + WS_PROJ); bf16* GU = (bf16*)(F.ws + WS_GU);
    bf16* UA = (bf16*)(F.ws + WS_UA); bf16* MG = (bf16*)(F.ws + WS_MG); float* KP = (float*)(F.ws + WS_KPART);

    if (IN(0)) { phase_convert_weights(F, args, 0, 0, CVT_I_IN); phase_x_to_bf16(F, args.in[0]); SEAM(0); }
    if (paneled && lo == 0) {
        const unsigned b0 = (unsigned)blockIdx.x % 64u;
        const unsigned i0 = xb_ld(ctl + 12288 + b0), i1 = xb_ld(ctl + 12288 + b0 + 64), i2 = xb_ld(ctl + 12288 + b0 + 128), i3 = xb_ld(ctl + 12288 + b0 + 192);
        pb_local = (i0 & 0x100u) && i0 == i1 && i0 == i2 && i0 == i3;
    }
    for (int l = 0; l < DEPTH; ++l) {
        const int pb = 1 + l * PH_PER_LAYER;
        unsigned char* wset = F.ws + ((l & 1) ? WS_W1 : WS_W0);
        bf16* WIN = (bf16*)(wset + WO_IN); bf16* WCA = (bf16*)(wset + WO_CA); bf16* WMIX = (bf16*)(wset + WO_MIX); bf16* WGU = (bf16*)(wset + WO_GU); bf16* WDN = (bf16*)(wset + WO_DN);
        if (IN(pb + 0)) {
            pg8::Gemm g{XB, WIN, M, INC, DM, DM, DM}; pg8::WrapOrder S; S.init(M, INC * REP_IN, F.G, fresh_bid()); S.wrapN = INC / 256;
            pg8::EpiProj E{PROJ, INC, C_GC, SS, KP};
#if SPLIT_IN
            for (int hf = 0; hf < 2; ++hf) { S.i0 = hf * 5; S.i1 = hf * 5 + 5; pg8::gemm_phase<pg8::EpiProj, pg8::WrapOrder, true>(F.lds + RING_OFF, g, S, E); if (hf == 0) xcd_barrier(bar); }
#else
            pg8::gemm_phase<pg8::EpiProj, pg8::WrapOrder, true>(F.lds + RING_OFF, g, S, E);
#endif
            SEAM(pb + 0);
        }
        if (IN(pb + 1)) {
            phase_attention(F, (char*)lds + RING_OFF, args.in[6], args, l);
            SEAM(pb + 1);
        }
        if (IN(pb + 2)) {
            pg8::Gemm g{UA, WCA, M, DM, 2048, 2048, 2048}; pg8::WrapOrder S; S.init(M, DM * REP_EF, F.G, fresh_bid()); S.wrapN = DM / 256;
            pg8::EpiGateBf16 E{MG, DM, PROJ + C_GC, INC}; pg8::MidGateRatio MH{PROJ + C_GC, INC};
            pg8::gemm_phase<pg8::EpiGateBf16, pg8::WrapOrder, true, pg8::MidGateRatio>(F.lds + RING_OFF, g, S, E, MH);
            SEAMG(pb + 2);
        }
        if (IN(pb + 3)) {
            pg8::Gemm g{MG, WMIX, M, DM, DM, DM, DM}; pg8::WrapOrder S; S.init(M, DM * REP_G, F.G, fresh_bid()); S.wrapN = DM / 256;
            pg8::EpiResBf16 E{XB, XB2, DM, SS};
            pg8::gemm_phase<pg8::EpiResBf16, pg8::WrapOrder, true>(F.lds + RING_OFF, g, S, E);
            SEAMG(pb + 3);
        }
        if (IN(pb + 4)) {
            pg8::Gemm g{XB2, WGU, M, 2 * FF, DM, DM, DM}; pg8::WrapOrder S; S.init(M, 2 * FF * REP_GU, F.G, fresh_bid()); S.wrapN = 2 * FF / 256;
            pg8::EpiSwiGLU E{GU, (long)256 * INC, SS};
            pg8::gemm_phase<pg8::EpiSwiGLU, pg8::WrapOrder, true>(F.lds + RING_OFF, g, S, E);
            SEAMG(pb + 4);
        }
        if (IN(pb + 5)) {
            pg8::Gemm g{GU, WDN, M, DM, FF, 64, FF, 256 * 64 * 2, (long)256 * INC * 2, true, true};       pg8::WrapOrder S; S.init(M, DM * REP_J, F.G, fresh_bid()); S.wrapN = DM / 256;
            pg8::EpiResBf16 E{XB2, XB, DM, SS};
            pg8::gemm_phase<pg8::EpiResBf16, pg8::WrapOrder, true>(F.lds + RING_OFF, g, S, E);
            SEAMG(pb + 5);
        }
    }
    if (IN(1 + DEPTH * PH_PER_LAYER)) phase_final_norm(F, args.in[12], args.out, paneled ? my_pm : -1, my_mi);
#undef IN
#undef SEAM
#undef SEAMG
}

#ifndef MK_PER_PHASE
#define MK_PER_PHASE 0
#endif
extern "C" void kernel_launch(void* const* d_in, const int* in_sizes, int n_in, void* d_out, int out_size, void* d_ws, size_t ws_size, hipStream_t stream) {
    static int grid = 0;
    if (grid == 0) {
        if (n_in != 13 || in_sizes[0] != M * DM || out_size != M * DM || ws_size < WS_END) {
            fprintf(stderr, "kernel_launch: unexpected shapes (n_in %d, in0 %d, out %d, ws %zu); nothing launched\n", n_in, n_in > 0 ? in_sizes[0] : -1, out_size, ws_size); grid = -1; return; }
        int dev = 0, cus = 0;
        if (hipGetDevice(&dev) != hipSuccess || hipDeviceGetAttribute(&cus, hipDeviceAttributeMultiprocessorCount, dev) != hipSuccess) { grid = -1; return; }
        if (hipFuncSetAttribute((const void*)trunk_fwd, hipFuncAttributeMaxDynamicSharedMemorySize, LDS_BYTES) != hipSuccess) { fprintf(stderr, "kernel_launch: hipFuncSetAttribute failed\n"); grid = -1; return; }
        int per_cu = 0;
        if (hipOccupancyMaxActiveBlocksPerMultiprocessor(&per_cu, (const void*)trunk_fwd, NWAVES * 64, LDS_BYTES) != hipSuccess || per_cu < 1)
            fprintf(stderr, "kernel_launch: note: occupancy query reports %d workgroups per CU\n", per_cu);
        (void)hipGetLastError();
        grid = cus;
    }
    if (grid < 0) return;
    if (hipMemsetAsync((char*)d_ws + WS_CTL, 0, CTL_ZERO_BYTES, stream) != hipSuccess) { fprintf(stderr, "kernel_launch: hipMemsetAsync failed\n"); return; }
    Args a{};
    for (int i = 0; i < 13; ++i) a.in[i] = (const float*)d_in[i];
    a.out = (float*)d_out; a.ws = (unsigned char*)d_ws;
#if MK_PER_PHASE
    for (int p = 0; p < N_PHASES; ++p) { a.ph_lo = p; a.ph_hi = p + 1; hipLaunchKernelGGL(trunk_fwd, dim3(grid), dim3(NWAVES * 64), LDS_BYTES, stream, a); }
#else
    a.ph_lo = 0; a.ph_hi = N_PHASES;
    hipLaunchKernelGGL(trunk_fwd, dim3(grid), dim3(NWAVES * 64), LDS_BYTES, stream, a);
#endif
    const hipError_t le = hipPeekAtLastError();
    if (le != hipSuccess) fprintf(stderr, "kernel_launch: launch failed: %s\n", hipGetErrorName(le));
}
```
